# Optimizing an MI355X kernel written in HIP

```python
import jax, jax.numpy as jnp
from jax import lax
import numpy as np

D_MODEL = 2048
BATCH = 4
SEQ = 4096
DEPTH = 4

N_A = DEPTH // 2
N_B = DEPTH - N_A
POOL_WINDOWS = (2, 4, 8, 16)
N_POOL_GROUPS = len(POOL_WINDOWS)
POOL_GROUP_DIM = D_MODEL // N_POOL_GROUPS
QK_NOPE_DIM = 128
QK_ROPE_DIM = 64
V_HEAD_DIM = 128
N_HEADS = D_MODEL // V_HEAD_DIM
KV_LORA_RANK = D_MODEL // 4
Q_LORA_RANK = ((1536 * D_MODEL // 7168 + 127) // 128) * 128
Q_HEAD_DIM = QK_NOPE_DIM + QK_ROPE_DIM
SM_SCALE = Q_HEAD_DIM ** -0.5
ROPE_THETA = 10000.0
Q_BLOCK = 128
FFN_DIM = ((8 * D_MODEL // 3 + 255) // 256) * 256
N_MOD = 6
EPS = 1e-6

kernel_name = "yoco_pool_mla_adaln_trunk"


def rmsnorm(x, g):
    x32 = x.astype(jnp.float32)
    y = x32 * lax.rsqrt(jnp.mean(x32 * x32, axis=-1, keepdims=True) + EPS)
    return (y * g.astype(jnp.float32)).astype(x.dtype)


def modulate(h, shift, scale):
    return h * (1.0 + scale[:, None, :]) + shift[:, None, :]


def rope_tables(positions):
    inv_freq = 1.0 / (ROPE_THETA ** (jnp.arange(0, QK_ROPE_DIM, 2, dtype=jnp.float32) / QK_ROPE_DIM))
    ang = positions.astype(jnp.float32)[..., None] * inv_freq
    return jnp.cos(ang), jnp.sin(ang)


def apply_rope(t, cos, sin):
    half = t.shape[-1] // 2
    t1, t2 = t[..., :half], t[..., half:]
    return jnp.concatenate([t1 * cos - t2 * sin, t2 * cos + t1 * sin], axis=-1).astype(t.dtype)


def pool_mixer(h, w_grp, scale):
    B, S, D = h.shape
    hf = h.astype(jnp.float32)
    csum = jnp.cumsum(hf, axis=1)
    t = jnp.arange(S)
    outs = []
    for g, w in enumerate(POOL_WINDOWS):
        lo, hi = g * POOL_GROUP_DIM, (g + 1) * POOL_GROUP_DIM
        cs = csum[..., lo:hi]
        lag = jnp.pad(cs, ((0, 0), (w, 0), (0, 0)))[:, :S]
        cnt = jnp.minimum(t + 1, w).astype(jnp.float32)[None, :, None]
        outs.append((cs - lag) / cnt - hf[..., lo:hi])
    d = jnp.stack(outs, axis=2).astype(h.dtype)
    y = jnp.einsum('bsgc,gcd->bsgd', d, w_grp).reshape(B, S, D)
    return y * scale


def swiglu(h, w_gate, w_up, w_down):
    return (jax.nn.silu(h @ w_gate) * (h @ w_up)) @ w_down


def shared_kv(h, w_dkv, kv_norm, w_uk, w_uv, w_kr, cos, sin):
    B, S, _ = h.shape
    ckv = rmsnorm(h @ w_dkv, kv_norm)
    k_nope = (ckv @ w_uk).reshape(B, S, N_HEADS, QK_NOPE_DIM)
    v = (ckv @ w_uv).reshape(B, S, N_HEADS, V_HEAD_DIM)
    k_rope = apply_rope(h @ w_kr, cos, sin)
    return k_nope, k_rope, v


def causal_mla_attention(q_nope, q_rope, k_nope, k_rope, v):
    B, S, H, _ = q_nope.shape
    nblk = S // Q_BLOCK
    key_idx = jnp.arange(S)

    def to_blocks(t):
        return jnp.moveaxis(t.reshape((B, nblk, Q_BLOCK) + t.shape[2:]), 1, 0)

    def one_block(args):
        qn, qr, blk = args
        s = (jnp.einsum('bqhd,bkhd->bhqk', qn, k_nope, preferred_element_type=jnp.float32)
             + jnp.einsum('bqhr,bkr->bhqk', qr, k_rope, preferred_element_type=jnp.float32))
        q_idx = blk * Q_BLOCK + jnp.arange(Q_BLOCK)
        mask = key_idx[None, :] <= q_idx[:, None]
        p = jax.nn.softmax(jnp.where(mask, s * SM_SCALE, -jnp.inf), axis=-1)
        return jnp.einsum('bhqk,bkhd->bqhd', p.astype(v.dtype), v)

    o = lax.map(one_block, (to_blocks(q_nope), to_blocks(q_rope), jnp.arange(nblk)))
    return jnp.moveaxis(o, 0, 1).reshape(B, S, H * V_HEAD_DIM)


def mla_mixer(h, kv, w_dq, q_norm, w_uq, w_o, cos, sin):
    B, S, _ = h.shape
    cq = rmsnorm(h @ w_dq, q_norm)
    q = (cq @ w_uq).reshape(B, S, N_HEADS, Q_HEAD_DIM)
    q_nope = q[..., :QK_NOPE_DIM]
    q_rope = apply_rope(q[..., QK_NOPE_DIM:], cos[:, :, None, :], sin[:, :, None, :])
    k_nope, k_rope, v = kv
    o = causal_mla_attention(q_nope, q_rope, k_nope, k_rope, v)
    return o @ w_o


def setup_inputs(seed: int = 0) -> dict:
    key = jax.random.key(seed)
    ks = jax.random.split(key, 32)
    f32 = jnp.float32

    def nrm(k, shape, std):
        return jax.random.normal(k, shape, f32) * std

    def gain(k, shape):
        return 1.0 + 0.02 * jax.random.normal(k, shape, f32)

    D, F, H = D_MODEL, FFN_DIM, N_HEADS
    positions = (jax.random.randint(ks[2], (BATCH, 1), 0, 1024, dtype=jnp.int32)
                 + jnp.arange(SEQ, dtype=jnp.int32)[None, :])
    return {
        "x": nrm(ks[0], (BATCH, SEQ, D), 1.0),
        "c": nrm(ks[1], (BATCH, D), 1.0),
        "positions": positions,
        "mod_w": nrm(ks[3], (DEPTH, D, N_MOD * D), 0.5 * D ** -0.5),
        "mod_b": nrm(ks[4], (DEPTH, N_MOD * D), 0.02),
        "norm_mix": gain(ks[5], (DEPTH, D)),
        "norm_ffn": gain(ks[6], (DEPTH, D)),
        "pool_w": nrm(ks[7], (N_A, N_POOL_GROUPS, POOL_GROUP_DIM, POOL_GROUP_DIM), POOL_GROUP_DIM ** -0.5),
        "pool_scale": gain(ks[8], (N_A, D)),
        "kv_mod_w": nrm(ks[9], (D, 2 * D), 0.5 * D ** -0.5),
        "kv_mod_b": nrm(ks[10], (2 * D,), 0.02),
        "kv_in_norm": gain(ks[11], (D,)),
        "w_dkv": nrm(ks[12], (D, KV_LORA_RANK), D ** -0.5),
        "kv_norm": gain(ks[13], (KV_LORA_RANK,)),
        "w_uk": nrm(ks[14], (KV_LORA_RANK, H * QK_NOPE_DIM), KV_LORA_RANK ** -0.5),
        "w_uv": nrm(ks[15], (KV_LORA_RANK, H * V_HEAD_DIM), KV_LORA_RANK ** -0.5),
        "w_kr": nrm(ks[16], (D, QK_ROPE_DIM), D ** -0.5),
        "w_dq": nrm(ks[17], (N_B, D, Q_LORA_RANK), D ** -0.5),
        "q_norm": gain(ks[18], (N_B, Q_LORA_RANK)),
        "w_uq": nrm(ks[19], (N_B, Q_LORA_RANK, H * Q_HEAD_DIM), Q_LORA_RANK ** -0.5),
        "w_o": nrm(ks[20], (N_B, H * V_HEAD_DIM, D), (H * V_HEAD_DIM) ** -0.5),
        "ffn_gate": nrm(ks[21], (DEPTH, D, F), D ** -0.5),
        "ffn_up": nrm(ks[22], (DEPTH, D, F), D ** -0.5),
        "ffn_down": nrm(ks[23], (DEPTH, F, D), F ** -0.5),
        "final_norm": gain(ks[24], (D,)),
    }


def reference(x, c, positions, mod_w, mod_b, norm_mix, norm_ffn, pool_w, pool_scale,
              kv_mod_w, kv_mod_b, kv_in_norm, w_dkv, kv_norm, w_uk, w_uv, w_kr,
              w_dq, q_norm, w_uq, w_o, ffn_gate, ffn_up, ffn_down, final_norm):
    cos, sin = rope_tables(positions)
    sc = jax.nn.silu(c)
    kv = None
    for i in range(DEPTH):
        shift_m, scale_m, gate_m, shift_f, scale_f, gate_f = jnp.split(sc @ mod_w[i] + mod_b[i], N_MOD, axis=-1)
        if i == N_A:
            kv_shift, kv_scale = jnp.split(sc @ kv_mod_w + kv_mod_b, 2, axis=-1)
            h_kv = modulate(rmsnorm(x, kv_in_norm), kv_shift, kv_scale)
            kv = shared_kv(h_kv, w_dkv, kv_norm, w_uk, w_uv, w_kr, cos, sin)
        h = modulate(rmsnorm(x, norm_mix[i]), shift_m, scale_m)
        if i < N_A:
            y = pool_mixer(h, pool_w[i], pool_scale[i])
        else:
            j = i - N_A
            y = mla_mixer(h, kv, w_dq[j], q_norm[j], w_uq[j], w_o[j], cos, sin)
        x = x + gate_m[:, None, :] * y
        h = modulate(rmsnorm(x, norm_ffn[i]), shift_f, scale_f)
        x = x + gate_f[:, None, :] * swiglu(h, ffn_gate[i], ffn_up[i], ffn_down[i])
    return rmsnorm(x, final_norm)
```

```cpp
#include <hip/hip_runtime.h>
#include <cstdio>
#include <cstdint>
#ifndef MODE
#define MODE 2
#define PROBE_REP 0
#endif
#define GAS __attribute__((address_space(1)))
#define LAS __attribute__((address_space(3)))
typedef unsigned short bf16_t;
typedef short bf16x8 __attribute__((ext_vector_type(8)));
typedef short s16x4 __attribute__((ext_vector_type(4)));
typedef float f32x4 __attribute__((ext_vector_type(4)));
typedef float f32x16 __attribute__((ext_vector_type(16)));
typedef unsigned u32x4 __attribute__((ext_vector_type(4)));
typedef unsigned u32x2 __attribute__((ext_vector_type(2)));
typedef GAS unsigned gu32;

#ifndef NT_LOADS0
#define NT_LOADS0 0
#endif
#ifndef NT_STORES
#define NT_STORES 0
#endif
#ifndef XBF16
#define XBF16 2
#endif
constexpr int NWAVES = 8;
constexpr int BATCH = 4, SEQ = 4096, DM = 2048, MROWS = BATCH * SEQ, FF = 5632, NH = 16;
constexpr float EPS = 1e-6f;
constexpr size_t MiB = 1u << 20;

constexpr size_t WS_CTL = 0, CTL_ZERO_BYTES = 4 * MiB;
constexpr int CW_TMO = 0;
constexpr int CW_BAR = 4096;
constexpr int CW_RS = 16384;
constexpr int RS_F0 = 0, RS_M2 = 4, RS_M3 = 5, RS_KV = 6, RS_Q2 = 7, RS_Q3 = 8;
constexpr int CW_MODV = CW_RS + 12 * 16384;
constexpr int CW_KVMOD = CW_MODV + 4 * 4 * 12288;
constexpr int CW_END = CW_KVMOD + 4 * 4096;
static_assert((size_t)CW_END * 4 <= CTL_ZERO_BYTES, "CTL region");
constexpr size_t WS_DV = 4 * MiB;
constexpr int DV_GM = 0;
constexpr int DV_GF = DV_GM + 4 * 4 * 2048;
constexpr int DV_GKV = DV_GF + 4 * 4 * 2048;
constexpr int DV_GATEM = DV_GKV + 4 * 2048;
constexpr int DV_GATEF = DV_GATEM + 4 * 4 * 2048;
constexpr int DV_BFFN = DV_GATEF + 4 * 4 * 2048;
constexpr int DV_BD2 = DV_BFFN + 4 * 4 * 11264;
constexpr int DV_BD3 = DV_BD2 + 4 * 1280;
constexpr int DV_END = DV_BD3 + 4 * 512;
static_assert((size_t)DV_END * 4 <= 2 * MiB, "DV region");
constexpr size_t WS_TAB = 6 * MiB;
constexpr size_t WS_WFFN1 = 10 * MiB;
constexpr size_t SZ_WFFN1 = (size_t)11264 * 2048 * 2;
constexpr size_t WS_WFFN2 = WS_WFFN1 + 4 * SZ_WFFN1;
constexpr size_t SZ_WFFN2 = (size_t)2048 * 5632 * 2;
constexpr size_t WS_WPOOL = WS_WFFN2 + 4 * SZ_WFFN2;
constexpr size_t SZ_WPOOL = (size_t)2048 * 512 * 2;
constexpr size_t WS_WD2 = WS_WPOOL + 2 * SZ_WPOOL;
constexpr size_t WS_WD3 = WS_WD2 + (size_t)1280 * 2048 * 2;
constexpr size_t WS_WU2 = WS_WD3 + (size_t)512 * 2048 * 2;
constexpr size_t WS_WU3 = WS_WU2 + (size_t)7168 * 512 * 2;
constexpr size_t WS_WO = WS_WU3 + (size_t)3072 * 512 * 2;
constexpr size_t SZ_WO = (size_t)2048 * 2048 * 2;
constexpr size_t WS_WEND = WS_WO + 2 * SZ_WO;
constexpr size_t SZ_MD = (size_t)MROWS * DM * 2;
constexpr size_t WS_AQ = (WS_WEND + MiB - 1) / MiB * MiB;
constexpr size_t WS_AKV = WS_AQ + SZ_MD;
constexpr size_t WS_KN = WS_AKV + SZ_MD;
constexpr size_t WS_V = WS_KN + SZ_MD;
constexpr size_t WS_KR = WS_V + SZ_MD;
constexpr size_t WS_CKV = WS_KR + (size_t)MROWS * 64 * 2;
constexpr size_t WS_CQ = WS_CKV + (size_t)MROWS * 512 * 2;
constexpr size_t WS_ACT = WS_CQ + (size_t)MROWS * 512 * 2;
constexpr size_t WS_QN = WS_ACT, WS_QR = WS_QN + SZ_MD, WS_O = WS_QR + (size_t)MROWS * 1024 * 2;
constexpr size_t WS_XB = WS_ACT + (size_t)MROWS * FF * 2;
constexpr size_t WS_XL = WS_XB + SZ_MD;
constexpr size_t WS_FAST_END = WS_XL + SZ_MD / 2;
static_assert(WS_O + SZ_MD <= WS_XB, "attention overlays inside act");

constexpr int RING_BYTES = 131072;
constexpr int LDS_BYTES = 147456;
constexpr int MISC_OFF = LDS_BYTES - 256;

#define RLX_AGENT __ATOMIC_RELAXED, __HIP_MEMORY_SCOPE_AGENT
#define LDS_WAIT() asm volatile("s_waitcnt lgkmcnt(0)" ::: "memory")
#define VM_WAIT() asm volatile("s_waitcnt vmcnt(0)" ::: "memory")
__device__ __forceinline__ unsigned f2bf(float f) { unsigned u = __builtin_bit_cast(unsigned, f); return (u + 0x7fffu + ((u >> 16) & 1u)) >> 16; }
__device__ __forceinline__ unsigned pk2(float lo, float hi) { return f2bf(lo) | (f2bf(hi) << 16); }
__device__ __forceinline__ float bf2f(unsigned short b) { return __builtin_bit_cast(float, (unsigned)b << 16); }
__device__ __forceinline__ unsigned cvt_pk_bf16(float lo, float hi) { unsigned r; asm volatile("v_cvt_pk_bf16_f32 %0, %1, %2" : "=v"(r) : "v"(lo), "v"(hi)); return r; }
__device__ __forceinline__ int opaque_lane() { int l; asm volatile("v_mbcnt_lo_u32_b32 %0, -1, 0\n\tv_mbcnt_hi_u32_b32 %0, -1, %0" : "=v"(l)); return l; }
__device__ __forceinline__ int opaque_tid() { int t = threadIdx.x; asm volatile("" : "+v"(t)); return t; }
__device__ __forceinline__ void x8_unpack16(const u32x4 h, f32x4& a, f32x4& b) {
    a = (f32x4){__builtin_bit_cast(float, h.x << 16), __builtin_bit_cast(float, h.x & 0xffff0000u), __builtin_bit_cast(float, h.y << 16), __builtin_bit_cast(float, h.y & 0xffff0000u)};
    b = (f32x4){__builtin_bit_cast(float, h.z << 16), __builtin_bit_cast(float, h.z & 0xffff0000u), __builtin_bit_cast(float, h.w << 16), __builtin_bit_cast(float, h.w & 0xffff0000u)}; }
__device__ __forceinline__ void x8_unpack24(const u32x4 h, const u32x2 l, f32x4& a, f32x4& b) {
    a = (f32x4){__builtin_bit_cast(float, (h.x << 16) | ((l.x << 8) & 0xff00u)), __builtin_bit_cast(float, (h.x & 0xffff0000u) | (l.x & 0xff00u)),
                __builtin_bit_cast(float, (h.y << 16) | ((l.x >> 8) & 0xff00u)), __builtin_bit_cast(float, (h.y & 0xffff0000u) | ((l.x >> 16) & 0xff00u))};
    b = (f32x4){__builtin_bit_cast(float, (h.z << 16) | ((l.y << 8) & 0xff00u)), __builtin_bit_cast(float, (h.z & 0xffff0000u) | (l.y & 0xff00u)),
                __builtin_bit_cast(float, (h.w << 16) | ((l.y >> 8) & 0xff00u)), __builtin_bit_cast(float, (h.w & 0xffff0000u) | ((l.y >> 16) & 0xff00u))}; }
__device__ __forceinline__ void x8_pack24(const f32x4 a, const f32x4 b, u32x4& h, u32x2& l) {
    unsigned t[8];
#pragma unroll
    for (int i = 0; i < 4; ++i) { const float fa = a[i], fb = b[i];
        t[i] = (__builtin_bit_cast(unsigned, fa) + 0x80u) >> 8; t[4 + i] = (__builtin_bit_cast(unsigned, fb) + 0x80u) >> 8; }
    h.x = (t[0] >> 8) | ((t[1] << 8) & 0xffff0000u); h.y = (t[2] >> 8) | ((t[3] << 8) & 0xffff0000u); h.z = (t[4] >> 8) | ((t[5] << 8) & 0xffff0000u); h.w = (t[6] >> 8) | ((t[7] << 8) & 0xffff0000u);
    l.x = (t[0] & 0xffu) | ((t[1] & 0xffu) << 8) | ((t[2] & 0xffu) << 16) | (t[3] << 24); l.y = (t[4] & 0xffu) | ((t[5] & 0xffu) << 8) | ((t[6] & 0xffu) << 16) | (t[7] << 24); }
template <class T> __device__ __forceinline__ void st_stream(T* p, const T& v) { if (NT_STORES) __builtin_nontemporal_store(v, p); else *p = v; }
__device__ __forceinline__ float dpp_xor1(float v) { return __builtin_bit_cast(float, __builtin_amdgcn_mov_dpp(__builtin_bit_cast(int, v), 0xB1, 0xF, 0xF, true)); }
__device__ __forceinline__ float dpp_xor2(float v) { return __builtin_bit_cast(float, __builtin_amdgcn_mov_dpp(__builtin_bit_cast(int, v), 0x4E, 0xF, 0xF, true)); }
__device__ __forceinline__ float dpp_hmirror(float v) { return __builtin_bit_cast(float, __builtin_amdgcn_mov_dpp(__builtin_bit_cast(int, v), 0x141, 0xF, 0xF, true)); }
__device__ __forceinline__ float dpp_mirror(float v) { return __builtin_bit_cast(float, __builtin_amdgcn_mov_dpp(__builtin_bit_cast(int, v), 0x140, 0xF, 0xF, true)); }
__device__ __forceinline__ float swz_xor16(float v) { return __builtin_bit_cast(float, __builtin_amdgcn_ds_swizzle(__builtin_bit_cast(int, v), 0x401F)); }
__device__ __forceinline__ float add_xor32(float v) {
    auto rr = __builtin_amdgcn_permlane32_swap(__builtin_bit_cast(unsigned, v), __builtin_bit_cast(unsigned, v), false, false);
    const unsigned a = rr[0], b = rr[1];
    return __builtin_bit_cast(float, a) + __builtin_bit_cast(float, b); }
__device__ __forceinline__ float wave_sum(float v) {
    v += dpp_xor1(v); v += dpp_xor2(v); v += dpp_hmirror(v); v += dpp_mirror(v); v += swz_xor16(v); return add_xor32(v);
}

#define XB_TMO      128
#define XB_XCNT(j)  (256  + 64 * (j))
#define XB_XSUB(j)  (1280 + 64 * (j))
#define XB_XGEN(j)  (2304 + 64 * (j))
#define XB_TOP      3328
#define XB_TOPGEN   3392
#define XCD_BAR_WORDS 3456
#define XB_SPIN_CAP (1u << 18)
__device__ __forceinline__ unsigned xb_ld(unsigned* p)              { return __hip_atomic_load(p, __ATOMIC_RELAXED, __HIP_MEMORY_SCOPE_AGENT); }
__device__ __forceinline__ unsigned xb_add(unsigned* p, unsigned v) { return __hip_atomic_fetch_add(p, v, __ATOMIC_RELAXED, __HIP_MEMORY_SCOPE_AGENT); }
__device__ __forceinline__ unsigned xb_xcc_id() { return (unsigned)__builtin_amdgcn_s_getreg((3 << 11) | 20) & 0xFu; }
#define XB_SPIN(cond, bar) do { unsigned _sp = 0; while (cond) { __builtin_amdgcn_s_sleep(1); \
    if ((++_sp & 255u) == 0u) { if (xb_ld(&(bar)[XB_TMO])) break; if (_sp > XB_SPIN_CAP) { atomicAdd(&(bar)[XB_TMO], 1u); break; } } } } while (0)
struct XcdBarrier { unsigned* bar; unsigned x; volatile LAS unsigned* st; };
__device__ __forceinline__ XcdBarrier xcd_barrier_post(unsigned* bar, volatile LAS unsigned* st) {
    XcdBarrier b; b.bar = bar; b.x = xb_xcc_id(); b.st = st;
    if (threadIdx.x == 0) (void)xb_add(&bar[XB_XCNT(b.x)], 1u);
    return b;
}
__device__ __forceinline__ void xcd_barrier_complete(unsigned* bar, unsigned x, unsigned& nloc, unsigned& nx) {
    const unsigned G = gridDim.x * gridDim.y * gridDim.z;
    unsigned sum, cnt, mine, sp = 0u;
    for (;;) {
        sum = 0u; cnt = 0u; mine = 0u;
#pragma unroll
        for (unsigned j = 0; j < 16; ++j) { const unsigned c = xb_ld(&bar[XB_XCNT(j)]); sum += c; cnt += (c > 0u) ? 1u : 0u; mine = (j == x) ? c : mine; }
        if (sum == G) break;
        __builtin_amdgcn_s_sleep(1);
        if ((++sp & 255u) == 0u) { if (xb_ld(&bar[XB_TMO])) break; if (sp > XB_SPIN_CAP) { atomicAdd(&bar[XB_TMO], 1u); break; } }
    }
    nloc = mine > 0u ? mine : 1u; nx = cnt > 0u ? cnt : 1u;
}
__device__ __forceinline__ void xcd_barrier(const XcdBarrier& b) {
    asm volatile("s_waitcnt vmcnt(0)" ::: "memory");
    __syncthreads();
    if (threadIdx.x == 0) {
        unsigned* bar = b.bar;
        __builtin_amdgcn_s_waitcnt(0);
        unsigned nloc = b.st[0], nx = b.st[1];
        if (nloc == 0u) { xcd_barrier_complete(bar, b.x, nloc, nx); b.st[0] = nloc; b.st[1] = nx; }
        const unsigned old = xb_add(&bar[XB_XSUB(b.x)], 1u);
        const unsigned gen = old / nloc;
        if (old + 1u == (gen + 1u) * nloc) {
            __builtin_amdgcn_fence(__ATOMIC_RELEASE, "agent");
            asm volatile("s_waitcnt vmcnt(0)" ::: "memory");
            const unsigned og = xb_add(&bar[XB_TOP], 1u);
            const unsigned tg = og / nx;
            if (og + 1u == (tg + 1u) * nx) xb_add(&bar[XB_TOPGEN], 1u);
            else XB_SPIN(xb_ld(&bar[XB_TOPGEN]) == tg, bar);
            __builtin_amdgcn_fence(__ATOMIC_ACQUIRE, "agent");
            xb_add(&bar[XB_XGEN(b.x)], 1u);
            asm volatile("s_waitcnt vmcnt(0)" ::: "memory");
        } else {
            XB_SPIN(xb_ld(&bar[XB_XGEN(b.x)]) == gen, bar);
            __builtin_amdgcn_fence(__ATOMIC_ACQUIRE, "agent");
            asm volatile("s_waitcnt vmcnt(0)" ::: "memory");
        }
    }
    __syncthreads();
}
#ifndef PG8_L2PF_DEFAULT
#define PG8_L2PF_DEFAULT false
#endif
namespace pg8 {
constexpr int BM = 256, BK = 64, HALF = 128, HTB = HALF * BK * 2, NXCD = 8;
__host__ __device__ __forceinline__ int lds_byte(int r, int c) { const int st = (r >> 4) * 2 + (c >> 5), rr = r & 15, cc = c & 31, ob = rr * 64 + cc * 2; return st * 1024 + (ob ^ (((ob >> 9) & 1) << 5)); }
__host__ __device__ __forceinline__ void stage_rc(int b, int& R, int& C) { const int st = b / 1024, sb = b % 1024, swz = sb ^ (((sb >> 9) & 1) << 5); R = (st >> 1) * 16 + swz / 64; C = (st & 1) * 32 + (swz % 64) / 2; }
__host__ __device__ __forceinline__ int perm32(int rho) { const int n = rho >> 4, i = rho & 15; return 8 * (i >> 2) + 4 * n + (i & 3); }

struct Unit { int pm, pn; };
struct Gemm { const bf16_t* A0; const bf16_t* A1; int pn_split; int lda; int grouped; const bf16_t* Bt; int ldb; int K; int nM, nN; };
__device__ __forceinline__ const char* a_ptr(const Gemm& g, const Unit& u) {
    const bf16_t* a = (u.pn < g.pn_split) ? g.A0 : g.A1;
    return (const char*)(a + (size_t)u.pm * BM * g.lda + (g.grouped ? (u.pn >> 1) * 512 : 0));
}
__device__ __forceinline__ const char* b_ptr(const Gemm& g, const Unit& u) { return (const char*)(g.Bt + (size_t)u.pn * BM * g.ldb); }

struct StaticOrder {
    int nM, nN, nwg, G, c, WGM;
    __device__ void init(int nM_, int nN_, int G_, int c_, int wgm = 8) { nM = nM_; nN = nN_; nwg = nM * nN; G = G_; c = c_; WGM = wgm; }
    __device__ bool next(int i, Unit& u) const {
        const long L = (long)i * G + c; if (L >= nwg) return false;
        int wgid = (int)L; { const int q = nwg / NXCD, r = nwg % NXCD, xcd = wgid % NXCD, off = wgid / NXCD; wgid = (xcd < r ? xcd * (q + 1) : r * (q + 1) + (xcd - r) * q) + off; }
        const int nig = WGM * nN, gid = wgid / nig, fm = gid * WGM, gsz = (nM - fm) < WGM ? (nM - fm) : WGM;
        u.pm = fm + ((wgid % nig) % gsz); u.pn = (wgid % nig) / gsz; return true;
    }
};

template <class Epi, bool ALIGN_EPI = true, bool SP2 = true, bool STAGE_IN_MMA = false, bool L2PF = PG8_L2PF_DEFAULT>
__device__ __forceinline__ void gemm_phase(LAS unsigned char* lds, const Gemm g, const StaticOrder& S, const Epi& E) {
    const int tid = opaque_tid(), wid = __builtin_amdgcn_readfirstlane(tid >> 6), lane = tid & 63, wr = wid >> 2, wc = wid & 3, fr = lane & 15, fq = lane >> 4;
    const int K = g.K, nt = K / BK;
    unsigned voffA[2], voffB[2];
#pragma unroll
    for (int i = 0; i < 2; ++i) { int R, C; stage_rc(tid * 16 + i * 8192, R, C); const int Rb = (R & ~31) + perm32(R & 31);
        voffA[i] = (unsigned)(R * g.lda + C) * 2u; voffB[i] = (unsigned)(Rb * g.ldb + C) * 2u; }
    const size_t kstep = (size_t)(BK * 2);
    const size_t hstepA = (size_t)HALF * g.lda * 2, hstepB = (size_t)HALF * g.ldb * 2;
    const unsigned ldsw = (unsigned)wid * 1024u;
    const int wu = __builtin_amdgcn_readfirstlane(wid);
    const int aoff = lds_byte(wr * 64 + fr, fq * 8), boff = lds_byte(wc * 32 + fr, fq * 8);
#define PG8_SA(b, h) (((b) * 2 + (h)) * HTB)
#define PG8_SB(b, h) ((4 + (b) * 2 + (h)) * HTB)
#ifndef PG8_ASM_STAGE
#define PG8_ASM_STAGE 1
#endif
#if PG8_ASM_STAGE
    const unsigned ldsb = (unsigned)(size_t)lds + (unsigned)wu * 1024u;
#define PG8_STAGE(bufoff, gbase, voff) do { _Pragma("unroll") for (int _i = 0; _i < 2; ++_i) { const unsigned m0v_ = ldsb + (unsigned)(bufoff) + (unsigned)(_i * 8192); \
        asm volatile("s_mov_b32 m0, %0\n\ts_nop 0\n\tglobal_load_lds_dwordx4 %1, %2" :: "s"(m0v_), "v"((voff)[_i]), "s"((const char*)(gbase)) : "memory", "m0"); } } while (0)
#else
#define PG8_STAGE(bufoff, gbase, voff) do { _Pragma("unroll") for (int _i = 0; _i < 2; ++_i) \
        __builtin_amdgcn_global_load_lds((const unsigned*)((const char*)(gbase) + (voff)[_i]), (LAS unsigned*)(lds + (bufoff) + ldsw + _i * 8192), 16, 0, 0); } while (0)
#endif
#define PG8_LDA(dst, b, h) do { _Pragma("unroll") for (int m = 0; m < 4; ++m) _Pragma("unroll") for (int k = 0; k < 2; ++k) dst[m][k] = *(const LAS bf16x8*)(lds + PG8_SA(b, h) + aoff + m * 2048 + k * 1024); } while (0)
#define PG8_LDB(dst, b, h) do { _Pragma("unroll") for (int n = 0; n < 2; ++n) _Pragma("unroll") for (int k = 0; k < 2; ++k) dst[n][k] = *(const LAS bf16x8*)(lds + PG8_SB(b, h) + boff + n * 2048 + k * 1024); } while (0)
#ifndef PG8_STAGE_FIRST
#define PG8_STAGE_FIRST 0
#endif
#ifndef PG8_PRIO
#define PG8_PRIO 1
#endif
#define PG8_MMA(ai, bj, At, Bt) do { if (PG8_PRIO) __builtin_amdgcn_s_setprio(1); _Pragma("unroll") for (int m = 0; m < 4; ++m) _Pragma("unroll") for (int n = 0; n < 2; ++n) _Pragma("unroll") for (int k = 0; k < 2; ++k) \
        acc[ai][bj][m][n] = __builtin_amdgcn_mfma_f32_16x16x32_bf16(Bt[n][k], At[m][k], acc[ai][bj][m][n], 0, 0, 0); if (PG8_PRIO) __builtin_amdgcn_s_setprio(0); } while (0)
#define PG8_WAIT_V(n) asm volatile("s_waitcnt vmcnt(" #n ")" ::: "memory")
#define PG8_WAIT_L(n) asm volatile("s_waitcnt lgkmcnt(" #n ")" ::: "memory")
#define PG8_BAR __builtin_amdgcn_s_barrier()
#define PG8_SCHED __builtin_amdgcn_sched_barrier(0)
    Unit cur, nxt; int ui = 0;
    if (!S.next(0, cur)) return;
    f32x4 acc[2][2][4][2];
#pragma unroll
    for (int a = 0; a < 2; ++a)
#pragma unroll
        for (int b = 0; b < 2; ++b)
#pragma unroll
            for (int m = 0; m < 4; ++m)
#pragma unroll
                for (int n = 0; n < 2; ++n) acc[a][b][m][n] = (f32x4){0.f, 0.f, 0.f, 0.f};
    bf16x8 At[4][2], B0[2][2], B1[2][2];
    const char* cA = a_ptr(g, cur); const char* cB = b_ptr(g, cur);
    if constexpr (SP2) {
    PG8_STAGE(PG8_SB(0, 0), cB, voffB); PG8_STAGE(PG8_SB(0, 1), cB + hstepB, voffB); PG8_STAGE(PG8_SA(0, 0), cA, voffA); PG8_STAGE(PG8_SA(0, 1), cA + hstepA, voffA);
    if (wr == 1) PG8_BAR;
    PG8_WAIT_V(2); PG8_BAR;
    PG8_STAGE(PG8_SB(1, 0), cB + kstep, voffB); PG8_STAGE(PG8_SA(1, 0), cA + kstep, voffA); PG8_STAGE(PG8_SB(1, 1), cB + hstepB + kstep, voffB);
    PG8_WAIT_V(6); PG8_BAR;
    } else {
    PG8_STAGE(PG8_SB(0, 0), cB, voffB); PG8_STAGE(PG8_SA(0, 0), cA, voffA); PG8_STAGE(PG8_SB(0, 1), cB + hstepB, voffB); PG8_STAGE(PG8_SA(0, 1), cA + hstepA, voffA);
    if (wr == 1) PG8_BAR;
    PG8_WAIT_V(4); PG8_BAR;
    PG8_STAGE(PG8_SB(1, 0), cB + kstep, voffB); PG8_STAGE(PG8_SA(1, 0), cA + kstep, voffA); PG8_STAGE(PG8_SB(1, 1), cB + hstepB + kstep, voffB);
    PG8_WAIT_V(6); PG8_BAR;
    }
    for (;;) {
        const bool has_next = S.next(ui + 1, nxt);
        const char* nA = has_next ? a_ptr(g, nxt) : cA; const char* nB = has_next ? b_ptr(g, nxt) : cB;
        int pf_id = 0; const int pf_sh = (S.WGM == 8) ? (wu < 4 ? 6 : 5) : (wu < 4 ? 5 : 6);
        if constexpr (L2PF) pf_id = (S.WGM == 8) ? (wu < 4 ? (cur.pn & 3) : (cur.pm & 7)) : (wu < 4 ? (cur.pn & 7) : (cur.pm & 3));
        for (int t = 0; t < nt; t += 2) {
            const bool last = (t == nt - 2);
            const char* a1 = cA + (size_t)(t + 1) * kstep;
            const char* a2 = last ? nA : cA + (size_t)(t + 2) * kstep; const char* b2 = last ? nB : cB + (size_t)(t + 2) * kstep;
            const char* a3 = a2 + kstep; const char* b3 = b2 + kstep;
            if constexpr (!SP2) {
            PG8_LDB(B0, 0, 0); PG8_SCHED; PG8_LDA(At, 0, 0); PG8_STAGE(PG8_SA(1, 1), a1 + hstepA, voffA);
            PG8_WAIT_L(8); PG8_BAR; PG8_WAIT_L(0); PG8_MMA(0, 0, At, B0); PG8_BAR; PG8_SCHED;
            PG8_LDB(B1, 0, 1); PG8_STAGE(PG8_SB(0, 0), b2, voffB);
            PG8_BAR; PG8_WAIT_L(0); PG8_MMA(0, 1, At, B1); PG8_BAR;
            PG8_LDA(At, 0, 1); PG8_STAGE(PG8_SA(0, 0), a2, voffA);
            PG8_BAR; PG8_WAIT_L(0); PG8_MMA(1, 0, At, B0); PG8_BAR; PG8_SCHED;
            PG8_STAGE(PG8_SB(0, 1), b2 + hstepB, voffB);
            PG8_WAIT_V(6); PG8_BAR; PG8_MMA(1, 1, At, B1); PG8_BAR;
            PG8_LDB(B0, 1, 0); PG8_SCHED; PG8_LDA(At, 1, 0); PG8_STAGE(PG8_SA(0, 1), a2 + hstepA, voffA);
            PG8_WAIT_L(8); PG8_BAR; PG8_WAIT_L(0); PG8_MMA(0, 0, At, B0); PG8_BAR; PG8_SCHED;
            PG8_LDB(B1, 1, 1); PG8_STAGE(PG8_SB(1, 0), b3, voffB);
            PG8_BAR; PG8_WAIT_L(0); PG8_MMA(0, 1, At, B1); PG8_BAR;
            PG8_LDA(At, 1, 1); PG8_STAGE(PG8_SA(1, 0), a3, voffA);
            PG8_BAR; PG8_WAIT_L(0); PG8_MMA(1, 0, At, B0); PG8_BAR; PG8_SCHED;
            PG8_STAGE(PG8_SB(1, 1), b3 + hstepB, voffB);
            PG8_WAIT_V(6); PG8_BAR; PG8_MMA(1, 1, At, B1); PG8_BAR;
            } else if constexpr (STAGE_IN_MMA) {
            PG8_LDB(B0, 0, 0); PG8_LDB(B1, 0, 1); PG8_SCHED; PG8_LDA(At, 0, 0);
            PG8_WAIT_V(6); PG8_WAIT_L(0); PG8_BAR; PG8_MMA(0, 0, At, B0); PG8_STAGE(PG8_SA(1, 1), a1 + hstepA, voffA); PG8_MMA(0, 1, At, B1); PG8_BAR; PG8_SCHED;
            PG8_LDA(At, 0, 1);
            PG8_WAIT_V(2); PG8_WAIT_L(0); PG8_BAR; PG8_MMA(1, 0, At, B0); PG8_STAGE(PG8_SB(0, 0), b2, voffB); PG8_STAGE(PG8_SB(0, 1), b2 + hstepB, voffB); PG8_STAGE(PG8_SA(0, 0), a2, voffA); PG8_MMA(1, 1, At, B1); PG8_BAR; PG8_SCHED;
            PG8_LDB(B0, 1, 0); PG8_LDB(B1, 1, 1); PG8_SCHED; PG8_LDA(At, 1, 0);
            PG8_WAIT_V(6); PG8_WAIT_L(0); PG8_BAR; PG8_MMA(0, 0, At, B0); PG8_STAGE(PG8_SA(0, 1), a2 + hstepA, voffA); PG8_MMA(0, 1, At, B1); PG8_BAR; PG8_SCHED;
            PG8_LDA(At, 1, 1);
            PG8_WAIT_V(2); PG8_WAIT_L(0); PG8_BAR; PG8_MMA(1, 0, At, B0); PG8_STAGE(PG8_SB(1, 0), b3, voffB); PG8_STAGE(PG8_SB(1, 1), b3 + hstepB, voffB); PG8_STAGE(PG8_SA(1, 0), a3, voffA); PG8_MMA(1, 1, At, B1); PG8_BAR; PG8_SCHED;
            } else {
#if PG8_STAGE_FIRST
            PG8_STAGE(PG8_SA(1, 1), a1 + hstepA, voffA); PG8_SCHED; PG8_LDB(B0, 0, 0); PG8_LDB(B1, 0, 1); PG8_SCHED; PG8_LDA(At, 0, 0);
            PG8_WAIT_V(8); PG8_WAIT_L(0); PG8_BAR; PG8_MMA(0, 0, At, B0); PG8_MMA(0, 1, At, B1); PG8_BAR; PG8_SCHED;
            PG8_STAGE(PG8_SB(0, 0), b2, voffB); PG8_STAGE(PG8_SB(0, 1), b2 + hstepB, voffB); PG8_STAGE(PG8_SA(0, 0), a2, voffA); PG8_SCHED; PG8_LDA(At, 0, 1);
            PG8_WAIT_V(8); PG8_WAIT_L(0); PG8_BAR; PG8_MMA(1, 0, At, B0); PG8_MMA(1, 1, At, B1); PG8_BAR; PG8_SCHED;
            PG8_STAGE(PG8_SA(0, 1), a2 + hstepA, voffA); PG8_SCHED; PG8_LDB(B0, 1, 0); PG8_LDB(B1, 1, 1); PG8_SCHED; PG8_LDA(At, 1, 0);
            PG8_WAIT_V(8); PG8_WAIT_L(0); PG8_BAR; PG8_MMA(0, 0, At, B0); PG8_MMA(0, 1, At, B1); PG8_BAR; PG8_SCHED;
            PG8_STAGE(PG8_SB(1, 0), b3, voffB); PG8_STAGE(PG8_SB(1, 1), b3 + hstepB, voffB); PG8_STAGE(PG8_SA(1, 0), a3, voffA); PG8_SCHED; PG8_LDA(At, 1, 1);
            PG8_WAIT_V(8); PG8_WAIT_L(0); PG8_BAR; PG8_MMA(1, 0, At, B0); PG8_MMA(1, 1, At, B1); PG8_BAR; PG8_SCHED;
#else
#define PG8_PF(tt) do { if constexpr (L2PF) { const int tp_ = (tt) + 4 < nt ? (tt) + 4 : nt - 1; const bool isA_ = wu < 4; \
                const int r_ = (wu & 3) * 64 + opaque_lane(); const unsigned o_ = ((r_ >> pf_sh) == pf_id) ? (unsigned)r_ * ((unsigned)(isA_ ? g.lda : g.ldb) * 2u) : 0u; \
                const unsigned m0v_ = (unsigned)(size_t)lds + 131072u + (unsigned)wu * 256u; \
                asm volatile("s_mov_b32 m0, %0\n\ts_nop 0\n\tglobal_load_lds_dword %1, %2" :: "s"(m0v_), "v"(o_), "s"((isA_ ? cA : cB) + (size_t)tp_ * kstep) : "memory", "m0"); } } while (0)
#define PG8_WAIT_VP() do { if constexpr (L2PF) PG8_WAIT_V(9); else PG8_WAIT_V(8); } while (0)
            PG8_PF(t); PG8_SCHED; PG8_LDB(B0, 0, 0); PG8_LDB(B1, 0, 1); PG8_SCHED; PG8_LDA(At, 0, 0); PG8_STAGE(PG8_SA(1, 1), a1 + hstepA, voffA);
            PG8_WAIT_VP(); PG8_WAIT_L(0); PG8_BAR; PG8_MMA(0, 0, At, B0); PG8_MMA(0, 1, At, B1); PG8_BAR; PG8_SCHED;
            PG8_LDA(At, 0, 1); PG8_STAGE(PG8_SB(0, 0), b2, voffB); PG8_STAGE(PG8_SB(0, 1), b2 + hstepB, voffB); PG8_STAGE(PG8_SA(0, 0), a2, voffA);
            PG8_WAIT_VP(); PG8_WAIT_L(0); PG8_BAR; PG8_MMA(1, 0, At, B0); PG8_MMA(1, 1, At, B1); PG8_BAR; PG8_SCHED;
            PG8_PF(t + 1); PG8_SCHED; PG8_LDB(B0, 1, 0); PG8_LDB(B1, 1, 1); PG8_SCHED; PG8_LDA(At, 1, 0); PG8_STAGE(PG8_SA(0, 1), a2 + hstepA, voffA);
            PG8_WAIT_VP(); PG8_WAIT_L(0); PG8_BAR; PG8_MMA(0, 0, At, B0); PG8_MMA(0, 1, At, B1); PG8_BAR; PG8_SCHED;
            PG8_LDA(At, 1, 1); PG8_STAGE(PG8_SB(1, 0), b3, voffB); PG8_STAGE(PG8_SB(1, 1), b3 + hstepB, voffB); PG8_STAGE(PG8_SA(1, 0), a3, voffA);
            PG8_WAIT_VP(); PG8_WAIT_L(0); PG8_BAR; PG8_MMA(1, 0, At, B0); PG8_MMA(1, 1, At, B1); PG8_BAR; PG8_SCHED;
#undef PG8_PF
#undef PG8_WAIT_VP
#endif
            }
        }
        if constexpr (ALIGN_EPI) { if (wr == 0) PG8_BAR; }
        { const int te = opaque_tid(); E(acc, cur, wr, wc, te & 15, (te >> 4) & 3); }
        if (!has_next) break;
#pragma unroll
        for (int a = 0; a < 2; ++a)
#pragma unroll
            for (int b = 0; b < 2; ++b)
#pragma unroll
                for (int m = 0; m < 4; ++m)
#pragma unroll
                    for (int n = 0; n < 2; ++n) acc[a][b][m][n] = (f32x4){0.f, 0.f, 0.f, 0.f};
        cur = nxt; cA = nA; cB = nB; ++ui;
        if constexpr (ALIGN_EPI) { if (wr == 1) PG8_BAR; }
    }
    PG8_WAIT_V(0);
    if constexpr (!ALIGN_EPI) { if (wr == 0) PG8_BAR; }
    PG8_BAR;
#undef PG8_SA
#undef PG8_SB
#undef PG8_STAGE
#undef PG8_LDA
#undef PG8_LDB
#undef PG8_MMA
#undef PG8_WAIT_V
#undef PG8_WAIT_L
#undef PG8_BAR
#undef PG8_SCHED
}

__device__ __forceinline__ u32x4 pack8bf(const f32x4& a, const f32x4& b) { u32x4 w; w.x = cvt_pk_bf16(a[0], a[1]); w.y = cvt_pk_bf16(a[2], a[3]); w.z = cvt_pk_bf16(b[0], b[1]); w.w = cvt_pk_bf16(b[2], b[3]); return w; }
__device__ __forceinline__ float sumsq4(const f32x4& a) { return (a[0] * a[0] + a[1] * a[1]) + (a[2] * a[2] + a[3] * a[3]); }

struct EpiRes {
    const float* xin32; const bf16_t* xin16; float* xout32; bf16_t* xout16; unsigned char* xlo; const float* gate; const float* gm0; bf16_t* a0; const float* gm1; bf16_t* a1; float* rowss;
    __device__ __forceinline__ void operator()(const f32x4 (&acc)[2][2][4][2], const Unit& u, int wr, int wc, int fr, int fq) const {
        const int b = u.pm >> 4; const int row0 = u.pm * BM + wr * 64 + fr;
        float ss[2][4];
#pragma unroll
        for (int ai = 0; ai < 2; ++ai)
#pragma unroll
            for (int m = 0; m < 4; ++m) ss[ai][m] = 0.f;
#pragma unroll
        for (int bj = 0; bj < 2; ++bj) {
            const int col = u.pn * BM + bj * HALF + wc * 32 + 8 * fq; const int vo = b * DM + col;
            const f32x4 g0 = *(const f32x4*)(gate + vo), g1 = *(const f32x4*)(gate + vo + 4);
            f32x4 m00 = {0, 0, 0, 0}, m01 = {0, 0, 0, 0}, m10 = {0, 0, 0, 0}, m11 = {0, 0, 0, 0};
            if (a0) { m00 = *(const f32x4*)(gm0 + vo); m01 = *(const f32x4*)(gm0 + vo + 4); }
            if (a1) { m10 = *(const f32x4*)(gm1 + vo); m11 = *(const f32x4*)(gm1 + vo + 4); }
#pragma unroll
            for (int ai = 0; ai < 2; ++ai) {
                f32x4 xv[4][2];
                if (xin32) {
#pragma unroll
                    for (int m = 0; m < 4; ++m) { const size_t off = (size_t)(row0 + ai * HALF + m * 16) * DM + col; xv[m][0] = *(const f32x4*)(xin32 + off); xv[m][1] = *(const f32x4*)(xin32 + off + 4); }
                } else {
                    u32x4 xr[4]; u32x2 xl[4];
#pragma unroll
                    for (int m = 0; m < 4; ++m) { const size_t off = (size_t)(row0 + ai * HALF + m * 16) * DM + col; xr[m] = *(const u32x4*)(xin16 + off);
                        if (XBF16 == 2) xl[m] = *(const u32x2*)(xlo + off); }
#pragma unroll
                    for (int m = 0; m < 4; ++m) { if (XBF16 == 2) x8_unpack24(xr[m], xl[m], xv[m][0], xv[m][1]); else x8_unpack16(xr[m], xv[m][0], xv[m][1]); }
                }
#pragma unroll
                for (int m = 0; m < 4; ++m) {
                    const size_t off = (size_t)(row0 + ai * HALF + m * 16) * DM + col;
                    const f32x4 v0 = xv[m][0] + g0 * acc[ai][bj][m][0], v1 = xv[m][1] + g1 * acc[ai][bj][m][1];
                    if (xout32) { *(f32x4*)(xout32 + off) = v0; *(f32x4*)(xout32 + off + 4) = v1; }
                    else if (XBF16 == 2) { u32x4 hh; u32x2 ll; x8_pack24(v0, v1, hh, ll); st_stream((u32x4*)(xout16 + off), hh); st_stream((u32x2*)(xlo + off), ll); }
                    else *(u32x4*)(xout16 + off) = pack8bf(v0, v1);
                    ss[ai][m] += sumsq4(v0) + sumsq4(v1);
                    if (a0) *(u32x4*)(a0 + off) = pack8bf(v0 * m00, v1 * m01);
                    if (a1) *(u32x4*)(a1 + off) = pack8bf(v0 * m10, v1 * m11);
                }
            }
        }
        if (rowss) {
#pragma unroll
            for (int ai = 0; ai < 2; ++ai)
#pragma unroll
                for (int m = 0; m < 4; ++m) { float s = ss[ai][m]; s += swz_xor16(s); s = add_xor32(s); if (fq == 0) atomicAdd(rowss + row0 + ai * HALF + m * 16, s); }
        }
    }
};

struct EpiNull { float* sink;
    __device__ __forceinline__ void operator()(const f32x4 (&acc)[2][2][4][2], const Unit& u, int wr, int wc, int fr, int fq) const {
        f32x4 t = {0.f, 0.f, 0.f, 0.f};
#pragma unroll
        for (int ai = 0; ai < 2; ++ai)
#pragma unroll
            for (int bj = 0; bj < 2; ++bj)
#pragma unroll
                for (int m = 0; m < 4; ++m) t += acc[ai][bj][m][0] + acc[ai][bj][m][1];
        *(f32x4*)(sink + ((size_t)(blockIdx.x * 512 + threadIdx.x) * 4)) = t;
    }
};

struct EpiSwi {
    const float* rowss; const float* bias; bf16_t* act;
    __device__ __forceinline__ void operator()(const f32x4 (&acc)[2][2][4][2], const Unit& u, int wr, int wc, int fr, int fq) const {
        const int b = u.pm >> 4; const int row0 = u.pm * BM + wr * 64 + fr;
        const int vc = u.pn * BM + wc * 32 + 8 * fq; const int ac = u.pn * HALF + wc * 32 + 8 * fq;
        const float* bp = bias + (size_t)b * 11264 + vc;
        const f32x4 bg0 = *(const f32x4*)bp, bg1 = *(const f32x4*)(bp + 4), bu0 = *(const f32x4*)(bp + HALF), bu1 = *(const f32x4*)(bp + HALF + 4);
        float rsv[8];
#pragma unroll
        for (int r = 0; r < 8; ++r) rsv[r] = rowss[row0 + (r >> 2) * HALF + (r & 3) * 16];
#pragma unroll
        for (int ai = 0; ai < 2; ++ai)
#pragma unroll
            for (int m = 0; m < 4; ++m) {
                const int row = row0 + ai * HALF + m * 16;
                const float rstd = rsqrtf(rsv[ai * 4 + m] * (1.f / DM) + EPS);
                f32x4 r0, r1;
#pragma unroll
                for (int j = 0; j < 4; ++j) {
                    const float ga = acc[ai][0][m][0][j] * rstd + bg0[j], ua = acc[ai][1][m][0][j] * rstd + bu0[j];
                    const float gb = acc[ai][0][m][1][j] * rstd + bg1[j], ub = acc[ai][1][m][1][j] * rstd + bu1[j];
                    r0[j] = ga * ua * __builtin_amdgcn_rcpf(1.f + __builtin_amdgcn_exp2f(-1.4426950408889634f * ga));
                    r1[j] = gb * ub * __builtin_amdgcn_rcpf(1.f + __builtin_amdgcn_exp2f(-1.4426950408889634f * gb));
                }
                st_stream((u32x4*)(act + (size_t)row * FF + ac), pack8bf(r0, r1));
            }
    }
};

struct EpiDown {
    const float* rowss1; const float* bias; int ldbias; int pn_q0;
    unsigned char* ws; float* rsb; int rsq;
    const float2* tab;
    __device__ __forceinline__ void operator()(const f32x4 (&acc)[2][2][4][2], const Unit& u, int wr, int wc, int fr, int fq) const {
        const int b = u.pm >> 4; const int row0 = u.pm * BM + wr * 64 + fr;
        const float* bp = bias + (size_t)b * ldbias + u.pn * BM + wc * 32 + 8 * fq;
        const f32x4 b00 = *(const f32x4*)bp, b01 = *(const f32x4*)(bp + 4), b10 = *(const f32x4*)(bp + HALF), b11 = *(const f32x4*)(bp + HALF + 4);
        const bool is_q = u.pn >= pn_q0;
        if (is_q || u.pn < 2) {
            bf16_t* dst = (bf16_t*)(ws + (is_q ? WS_CQ : WS_CKV)); float* rs = rsb + (size_t)(is_q ? rsq : RS_KV) * 16384;
            const int col = (is_q ? (u.pn - pn_q0) : u.pn) * BM + wc * 32 + 8 * fq;
#pragma unroll
            for (int ai = 0; ai < 2; ++ai)
#pragma unroll
                for (int m = 0; m < 4; ++m) {
                    const int row = row0 + ai * HALF + m * 16;
                    const float rstd = rsqrtf(rowss1[row] * (1.f / DM) + EPS);
                    const f32x4 v00 = acc[ai][0][m][0] * rstd + b00, v01 = acc[ai][0][m][1] * rstd + b01, v10 = acc[ai][1][m][0] * rstd + b10, v11 = acc[ai][1][m][1] * rstd + b11;
                    *(u32x4*)(dst + (size_t)row * 512 + col) = pack8bf(v00, v01);
                    *(u32x4*)(dst + (size_t)row * 512 + col + HALF) = pack8bf(v10, v11);
                    float s = (sumsq4(v00) + sumsq4(v01)) + (sumsq4(v10) + sumsq4(v11));
                    s += swz_xor16(s); s = add_xor32(s); if (fq == 0) atomicAdd(rs + row, s);
                }
        } else if (wc == 0) {
            bf16_t* kr = (bf16_t*)(ws + WS_KR);
#pragma unroll
            for (int ai = 0; ai < 2; ++ai)
#pragma unroll
                for (int m = 0; m < 4; ++m) {
                    const int row = row0 + ai * HALF + m * 16;
                    const float rstd = rsqrtf(rowss1[row] * (1.f / DM) + EPS);
                    const f32x4 t10 = acc[ai][0][m][0] * rstd + b00, t11 = acc[ai][0][m][1] * rstd + b01, t20 = acc[ai][1][m][0] * rstd + b10, t21 = acc[ai][1][m][1] * rstd + b11;
                    const float2* tp = tab + (size_t)row * 32 + 8 * fq;
                    f32x4 o10, o11, o20, o21;
#pragma unroll
                    for (int j = 0; j < 4; ++j) { const float2 ca = tp[j], cb = tp[4 + j];
                        o10[j] = t10[j] * ca.x - t20[j] * ca.y; o20[j] = t20[j] * ca.x + t10[j] * ca.y;
                        o11[j] = t11[j] * cb.x - t21[j] * cb.y; o21[j] = t21[j] * cb.x + t11[j] * cb.y; }
                    *(u32x4*)(kr + (size_t)row * 64 + 8 * fq) = pack8bf(o10, o11);
                    *(u32x4*)(kr + (size_t)row * 64 + 32 + 8 * fq) = pack8bf(o20, o21);
                }
        }
    }
};

struct EpiUp {
    unsigned char* ws; const float* rsb; int rsq; int pn_q0; const float2* tab;
    __device__ __forceinline__ void operator()(const f32x4 (&acc)[2][2][4][2], const Unit& u, int wr, int wc, int fr, int fq) const {
        const int row0 = u.pm * BM + wr * 64 + fr;
        const bool is_q = u.pn >= pn_q0; const int p = is_q ? u.pn - pn_q0 : u.pn;
        const float* rs = rsb + (size_t)(is_q ? rsq : RS_KV) * 16384;
        if (!(is_q && p >= 8)) {
            bf16_t* dst = (bf16_t*)(ws + (is_q ? WS_QN : (p < 8 ? WS_KN : WS_V)));
            const int col = (p & 7) * BM + wc * 32 + 8 * fq;
#pragma unroll
            for (int ai = 0; ai < 2; ++ai)
#pragma unroll
                for (int m = 0; m < 4; ++m) {
                    const int row = row0 + ai * HALF + m * 16;
                    const float rstd = rsqrtf(rs[row] * (1.f / 512.f) + EPS);
                    st_stream((u32x4*)(dst + (size_t)row * DM + col), pack8bf(acc[ai][0][m][0] * rstd, acc[ai][0][m][1] * rstd));
                    st_stream((u32x4*)(dst + (size_t)row * DM + col + HALF), pack8bf(acc[ai][1][m][0] * rstd, acc[ai][1][m][1] * rstd));
                }
        } else {
            bf16_t* qr = (bf16_t*)(ws + WS_QR);
            const int hh = 4 * (p - 8) + wc;
#pragma unroll
            for (int ai = 0; ai < 2; ++ai)
#pragma unroll
                for (int m = 0; m < 4; ++m) {
                    const int row = row0 + ai * HALF + m * 16;
                    const float rstd = rsqrtf(rs[row] * (1.f / 512.f) + EPS);
                    const f32x4 t10 = acc[ai][0][m][0] * rstd, t11 = acc[ai][0][m][1] * rstd, t20 = acc[ai][1][m][0] * rstd, t21 = acc[ai][1][m][1] * rstd;
                    const float2* tp = tab + (size_t)row * 32 + 8 * fq;
                    f32x4 o10, o11, o20, o21;
#pragma unroll
                    for (int j = 0; j < 4; ++j) { const float2 ca = tp[j], cb = tp[4 + j];
                        o10[j] = t10[j] * ca.x - t20[j] * ca.y; o20[j] = t20[j] * ca.x + t10[j] * ca.y;
                        o11[j] = t11[j] * cb.x - t21[j] * cb.y; o21[j] = t21[j] * cb.x + t11[j] * cb.y; }
                    st_stream((u32x4*)(qr + (size_t)row * 1024 + hh * 64 + 8 * fq), pack8bf(o10, o11));
                    st_stream((u32x4*)(qr + (size_t)row * 1024 + hh * 64 + 32 + 8 * fq), pack8bf(o20, o21));
                }
        }
    }
};
}
namespace att {
constexpr int D = 128, DQK = 192, NW = 8, QBLK = 32, KVBLK = 64, QB = NW * QBLK;
constexpr int LDQ = 2048, LDQR = 1024, LDKR = 64;
constexpr float SCALE = 0.07216878364870322f;
constexpr float THR = 8.f;
constexpr int KROW = 400;
constexpr int SHM_V = KVBLK * D * 2, SHM_K = KVBLK * KROW;
constexpr int NVS = 3;
constexpr int K_LDS_OFF = NVS * SHM_V, WS_LDS_OFF = K_LDS_OFF + 2 * SHM_K;
constexpr int QR_LDS_OFF = WS_LDS_OFF + NW * 64 * 4;
constexpr int ATT_LDS_BYTES = QR_LDS_OFF + NW * 4096;
static_assert(ATT_LDS_BYTES <= MISC_OFF, "attention LDS map");
#define SBAR() __builtin_amdgcn_sched_barrier(0)
__device__ __forceinline__ int v_st(int k, int c) { const int kk = (k & ~0xC) | ((k & 4) << 1) | ((k & 8) >> 1); return ((kk >> 3) * 4 + (c >> 5)) * 512 + ((kk & 7) * 32 + (c & 31)) * 2; }
__device__ __forceinline__ int v_rd_base(int lane) { return ((lane & 3) << 3) | (((lane >> 2) & 3) << 6) | (((lane >> 4) & 1) << 5) | (((lane >> 5) & 1) << 8); }
constexpr int v_rd_off(int d0, int ks, int half) { return d0 * 512 + ks * 4096 + half * 2048; }
__device__ __forceinline__ int crow(int r, int hi) { return (r & 3) + 8 * (r >> 2) + 4 * hi; }
__device__ __forceinline__ unsigned cvtpk(float lo, float hi) { unsigned r; asm volatile("v_cvt_pk_bf16_f32 %0, %1, %2" : "=v"(r) : "v"(lo), "v"(hi)); return r; }
__device__ __forceinline__ bf16x8 load8(const bf16_t* p) { return *reinterpret_cast<const bf16x8*>(p); }
__device__ __forceinline__ void mask_tile(f32x16& p0, f32x16& p1, int dq) {
    const float NEG = -__builtin_inff();
#pragma unroll
    for (int r = 0; r < 16; ++r) {
        const int c = (r & 3) + 8 * (r >> 2);
        if (dq - c < 0) p0[r] = NEG;
        if (dq - c - 32 < 0) p1[r] = NEG;
    }
}
__device__ __forceinline__ void partialSM(f32x16& p0, f32x16& p1, float& m_reg, float& mn, float& alpha) {
    float pmax = p0[0]; for (int r = 1; r < 16; ++r) pmax = fmaxf(pmax, p0[r]); for (int r = 0; r < 16; ++r) pmax = fmaxf(pmax, p1[r]);
    { auto rr = __builtin_amdgcn_permlane32_swap(__float_as_uint(pmax), __float_as_uint(pmax), false, false);
      pmax = fmaxf(__uint_as_float(rr[0]), __uint_as_float(rr[1])); }
    constexpr float C2 = 1.4426950408889634f * SCALE;
    if (__builtin_expect(__all((pmax - m_reg) * SCALE <= THR), 1)) { mn = m_reg; alpha = 1.f; }
    else { mn = fmaxf(m_reg, pmax); alpha = __builtin_amdgcn_exp2f((m_reg - mn) * C2); m_reg = mn; }
    const float mnL = -mn * C2;
    for (int r = 0; r < 16; ++r) p0[r] = fmaf(p0[r], C2, mnL); for (int r = 0; r < 16; ++r) p1[r] = fmaf(p1[r], C2, mnL);
    for (int r = 0; r < 16; ++r) p0[r] = __builtin_amdgcn_exp2f(p0[r]);
}
__device__ __forceinline__ void finishSM(f32x16& p0, f32x16& p1, float alpha, float& l_reg, bf16x8& pa0, bf16x8& pa1, bf16x8& pa2, bf16x8& pa3) {
    for (int r = 0; r < 16; ++r) p1[r] = __builtin_amdgcn_exp2f(p1[r]);
    float ps = 0; for (int r = 0; r < 16; ++r) ps += p0[r]; for (int r = 0; r < 16; ++r) ps += p1[r];
    { auto rr = __builtin_amdgcn_permlane32_swap(__float_as_uint(ps), __float_as_uint(ps), false, false);
      ps = __uint_as_float(rr[0]) + __uint_as_float(rr[1]); }
    l_reg = l_reg * alpha + ps;
#define PK4(P, B_, OUT) do { unsigned a0 = cvtpk(P[B_+0], P[B_+1]), a1 = cvtpk(P[B_+2], P[B_+3]);                          \
        unsigned b0 = cvtpk(P[B_+4], P[B_+5]), b1 = cvtpk(P[B_+6], P[B_+7]);                                             \
        auto r0 = __builtin_amdgcn_permlane32_swap(a0, b0, false, false); auto r1 = __builtin_amdgcn_permlane32_swap(a1, b1, false, false); \
        u32x4 w = {r0[0], r1[0], r0[1], r1[1]}; OUT = *reinterpret_cast<bf16x8*>(&w); } while (0)
    PK4(p0, 0, pa0); PK4(p0, 8, pa1); PK4(p1, 0, pa2); PK4(p1, 8, pa3);
#undef PK4
}
template <int KB>
__device__ __forceinline__ void qkt(f32x16& p0, f32x16& p1, const char* K_lds, int r32, int hi, const bf16x8* qr, const char* qrl) {
    p0 = f32x16{}; p1 = f32x16{};
    const int kb0 = (int)(uintptr_t)K_lds + r32 * KROW + hi * 16;
    const int qb = (int)(uintptr_t)qrl;
    bf16x8 ka[12], kc[12], qq[4];
#define QK_LDR(dst, base, off) asm volatile("ds_read_b128 %0, %1 offset:%2" : "=&v"(dst) : "v"(base), "i"(off) : "memory")
#define QK_RD(d0) do { QK_LDR(ka[d0], kb0, KB * SHM_K + (d0) * 32); QK_LDR(kc[d0], kb0, KB * SHM_K + (d0) * 32 + 32 * KROW); \
        if ((d0) >= 8) QK_LDR(qq[(d0) >= 8 ? (d0) - 8 : 0], qb, ((d0) >= 8 ? (d0) - 8 : 0) * 1024); } while (0)
#define QK_N1(j) ((j) <= 11 ? 2 + ((j) >= 8 ? 1 : 0) : 0)
#define QK_STEP(d0) do { if ((d0) + 3 < 12) QK_RD((d0) + 3 < 12 ? (d0) + 3 : 0); \
        if ((d0) >= 8) asm volatile("s_waitcnt lgkmcnt(%3)" : "+v"(ka[d0]), "+v"(kc[d0]), "+v"(qq[(d0) >= 8 ? (d0) - 8 : 0]) : "i"(QK_N1((d0) + 1) + QK_N1((d0) + 2) + QK_N1((d0) + 3)) : "memory"); \
        else asm volatile("s_waitcnt lgkmcnt(%2)" : "+v"(ka[d0]), "+v"(kc[d0]) : "i"(QK_N1((d0) + 1) + QK_N1((d0) + 2) + QK_N1((d0) + 3)) : "memory"); \
        { const bf16x8 q = (d0) < 8 ? qr[(d0) < 8 ? (d0) : 0] : qq[(d0) >= 8 ? (d0) - 8 : 0]; \
          p0 = __builtin_amdgcn_mfma_f32_32x32x16_bf16(ka[d0], q, p0, 0, 0, 0); p1 = __builtin_amdgcn_mfma_f32_32x32x16_bf16(kc[d0], q, p1, 0, 0, 0); } } while (0)
    QK_RD(0); QK_RD(1); QK_RD(2);
    QK_STEP(0); QK_STEP(1); QK_STEP(2); QK_STEP(3); QK_STEP(4); QK_STEP(5); QK_STEP(6); QK_STEP(7); QK_STEP(8); QK_STEP(9); QK_STEP(10); QK_STEP(11);
#undef QK_STEP
#undef QK_N1
#undef QK_RD
#undef QK_LDR
}
__device__ __forceinline__ void pv_tile(f32x16* o, int vb, bf16x8 pa0, bf16x8 pa1, bf16x8 pa2, bf16x8 pa3) {
#define TRRD(dst, off) asm volatile("ds_read_b64_tr_b16 %0, %1 offset:%2" : "=&v"(dst) : "v"(vb), "i"(off) : "memory")
#define PV_RD(d0, S_) do { constexpr int b_ = v_rd_off(d0, 0, 0); \
        TRRD(S_##l0, b_); TRRD(S_##h0, b_ + 2048); TRRD(S_##l1, b_ + 4096); TRRD(S_##h1, b_ + 6144); TRRD(S_##l2, b_ + 8192); TRRD(S_##h2, b_ + 10240); TRRD(S_##l3, b_ + 12288); TRRD(S_##h3, b_ + 14336); } while (0)
#define PV_MM(d0, S_) do { \
        o[d0] = __builtin_amdgcn_mfma_f32_32x32x16_bf16(pa0, (bf16x8){S_##l0[0], S_##l0[1], S_##l0[2], S_##l0[3], S_##h0[0], S_##h0[1], S_##h0[2], S_##h0[3]}, o[d0], 0, 0, 0);   \
        o[d0] = __builtin_amdgcn_mfma_f32_32x32x16_bf16(pa1, (bf16x8){S_##l1[0], S_##l1[1], S_##l1[2], S_##l1[3], S_##h1[0], S_##h1[1], S_##h1[2], S_##h1[3]}, o[d0], 0, 0, 0);   \
        o[d0] = __builtin_amdgcn_mfma_f32_32x32x16_bf16(pa2, (bf16x8){S_##l2[0], S_##l2[1], S_##l2[2], S_##l2[3], S_##h2[0], S_##h2[1], S_##h2[2], S_##h2[3]}, o[d0], 0, 0, 0);   \
        o[d0] = __builtin_amdgcn_mfma_f32_32x32x16_bf16(pa3, (bf16x8){S_##l3[0], S_##l3[1], S_##l3[2], S_##l3[3], S_##h3[0], S_##h3[1], S_##h3[2], S_##h3[3]}, o[d0], 0, 0, 0); } while (0)
#define PV_WAIT(n, S_) asm volatile("s_waitcnt lgkmcnt(%8)" : "+v"(S_##l0), "+v"(S_##h0), "+v"(S_##l1), "+v"(S_##h1), "+v"(S_##l2), "+v"(S_##h2), "+v"(S_##l3), "+v"(S_##h3) : "i"(n) : "memory")
    s16x4 Al0, Al1, Al2, Al3, Ah0, Ah1, Ah2, Ah3, Bl0, Bl1, Bl2, Bl3, Bh0, Bh1, Bh2, Bh3;
    PV_RD(0, A); PV_RD(1, B); PV_WAIT(8, A); PV_MM(0, A);
    PV_RD(2, A); PV_WAIT(8, B); PV_MM(1, B);
    PV_RD(3, B); PV_WAIT(8, A); PV_MM(2, A);
    PV_WAIT(0, B); PV_MM(3, B);
#undef PV_WAIT
#undef PV_MM
#undef PV_RD
#undef TRRD
}

struct BlockRef { unsigned char* wsb; int tok0, row0, h, P0; };
#define T_QN(R_) ((const bf16_t*)((R_).wsb + WS_QN) + (size_t)(R_).row0 * LDQ + (R_).h * 128)
#define T_QR(R_) ((const bf16_t*)((R_).wsb + WS_QR) + (size_t)(R_).row0 * LDQR + (R_).h * 64)
#define T_KN(R_) ((const bf16_t*)((R_).wsb + WS_KN) + (size_t)(R_).tok0 * LDQ + (R_).h * 128)
#define T_KR(R_) ((const bf16_t*)((R_).wsb + WS_KR) + (size_t)(R_).tok0 * LDKR)
#define T_V(R_)  ((const bf16_t*)((R_).wsb + WS_V) + (size_t)(R_).tok0 * LDQ + (R_).h * 128)
#define T_O(R_)  ((bf16_t*)((R_).wsb + WS_O) + (size_t)(R_).row0 * LDQ + (R_).h * 128)
struct Seam { bf16x8 qr[8]; };
#define VMW() asm volatile("s_waitcnt vmcnt(0)" ::: "memory")
#define DMA_TILE(k0, kbf, vslot) do { _Pragma("unroll") for (int i_ = 0; i_ < 4; ++i_) if (i_ < 3 || wid == 0) \
            __builtin_amdgcn_global_load_lds((const unsigned*)(cur.wsb + (size_t)kdo[i_] + (size_t)(k0) * kds[i_]), (LAS unsigned*)(lds + K_LDS_OFF + (kbf) * SHM_K + (wid + 8 * i_) * 1024), 16, 0, 0); \
        _Pragma("unroll") for (int i_ = 0; i_ < 2; ++i_) \
            __builtin_amdgcn_global_load_lds((const unsigned*)(cur.wsb + (size_t)vdo[i_] + (size_t)(k0) * 4096), (LAS unsigned*)(lds + (vslot) * SHM_V + (wid * 2 + i_) * 1024), 16, 0, 0); } while (0)
#define QLOAD(R_) do { _Pragma("unroll") for (int d0 = 0; d0 < 8; ++d0) S.qr[d0] = load8(T_QN(R_) + (size_t)(wid * QBLK + r32) * LDQ + d0 * 16 + hi * 8); \
                       _Pragma("unroll") for (int d0 = 0; d0 < 4; ++d0) *(bf16x8*)(qrl + d0 * 1024) = load8(T_QR(R_) + (size_t)(wid * QBLK + r32) * LDQR + d0 * 16 + hi * 8); } while (0)

__device__ __forceinline__ void block(const BlockRef& cur, char* lds) {
    const int tid = opaque_tid(), wid = __builtin_amdgcn_readfirstlane(tid >> 6), lane = tid & 63, r32 = lane & 31, hi = lane >> 5;
    const int NT = cur.P0 / KVBLK + QB / KVBLK;
    const int qlo = cur.P0 + wid * QBLK, qm = qlo + r32 - 4 * hi;
    char* V_lds = lds; char* K_lds = lds + K_LDS_OFF;
    float* ws = (float*)(lds + WS_LDS_OFF) + wid * 64; float* li_l = ws, * al_l = ws + 32;
    Seam S;
    unsigned kdo[4], kds[4], vdo[2];
#pragma unroll
    for (int i = 0; i < 4; ++i) { const int L = (wid + 8 * i) * 1024 + lane * 16, row = (L / KROW) & 63, pos = L % KROW, c = pos < 384 ? pos >> 4 : 0;
        const bool rope = c >= 16;
        kdo[i] = rope ? (unsigned)(WS_KR + ((size_t)(cur.tok0 + row) * LDKR + (c - 16) * 8) * 2) : (unsigned)(WS_KN + ((size_t)(cur.tok0 + row) * LDQ + cur.h * 128 + c * 8) * 2);
        kds[i] = rope ? (unsigned)(LDKR * 2) : (unsigned)(LDQ * 2); }
#pragma unroll
    for (int i = 0; i < 2; ++i) { const int L = (wid * 2 + i) * 1024 + lane * 16, st = L >> 9, in = L & 511, kk = (st >> 2) * 8 + (in >> 6), k = (kk & ~0xC) | ((kk & 4) << 1) | ((kk & 8) >> 1), col = (st & 3) * 32 + ((in & 63) >> 1);
        vdo[i] = (unsigned)(WS_V + ((size_t)(cur.tok0 + k) * LDQ + cur.h * 128 + col) * 2); }
    const int vb0 = (int)(uintptr_t)V_lds + v_rd_base(lane);
    char* qrl = lds + QR_LDS_OFF + wid * 4096 + lane * 16;
    if (wid >= 4) __builtin_amdgcn_s_setprio(1);
    QLOAD(cur);
    DMA_TILE(0, 0, 0);
    __syncthreads();
    float m_reg = -1e30f, l_reg = 0; f32x16 o[4] = {};
    f32x16 pA0, pA1, pB0, pB1; float mnA, mnB, alA, alB; bf16x8 pa0, pa1, pa2, pa3;
#define RESC(a) do { if (__any((a) < 1.f)) { if (hi == 0) al_l[r32] = (a); asm volatile("s_waitcnt lgkmcnt(0)" ::: "memory");              \
                     for (int d_ = 0; d_ < 4; ++d_) for (int r = 0; r < 16; ++r) o[d_][r] *= al_l[crow(r, hi)]; } } while (0)
#define KBASE(t) ((t) * KVBLK)
#define MASKT(P0_, P1_, t) do { const int kb_ = KBASE(t); if (kb_ + KVBLK - 1 > qlo) mask_tile(P0_, P1_, qm - kb_); } while (0)
    int vs_prev = 0, vs_cur = 1, vs_next = 2;
    DMA_TILE(KBASE(1), 1, 1);
    qkt<0>(pA0, pA1, K_lds, r32, hi, S.qr, qrl);
    MASKT(pA0, pA1, 0); partialSM(pA0, pA1, m_reg, mnA, alA);
    __syncthreads();
#define HALF_STEP(PX0, PX1, mnX, alX, PY0, PY1, alY, t, KB) do {                                                             \
        if ((t) + 1 < NT) DMA_TILE(KBASE((t) + 1), (KB) ^ 1, vs_next);                                                         \
        qkt<KB>(PX0, PX1, K_lds, r32, hi, S.qr, qrl);                                                                           \
        finishSM(PY0, PY1, alY, l_reg, pa0, pa1, pa2, pa3);                                                                      \
        pv_tile(o, vb0 + vs_prev * SHM_V, pa0, pa1, pa2, pa3);                                                                   \
        MASKT(PX0, PX1, (t)); partialSM(PX0, PX1, m_reg, mnX, alX); RESC(alX);                                                   \
        { const int tmp_ = vs_prev; vs_prev = vs_cur; vs_cur = vs_next; vs_next = tmp_; }                                        \
        __syncthreads(); } while (0)
    for (int t = 1; t + 1 < NT; t += 2) {
        HALF_STEP(pB0, pB1, mnB, alB, pA0, pA1, alA, t, 1);
        HALF_STEP(pA0, pA1, mnA, alA, pB0, pB1, alB, t + 1, 0);
    }
    HALF_STEP(pB0, pB1, mnB, alB, pA0, pA1, alA, NT - 1, 1);
    finishSM(pB0, pB1, alB, l_reg, pa0, pa1, pa2, pa3);
    pv_tile(o, vb0 + vs_prev * SHM_V, pa0, pa1, pa2, pa3);
#undef HALF_STEP
    if (hi == 0) li_l[r32] = l_reg; asm volatile("s_waitcnt lgkmcnt(0)" ::: "memory");
    float rli[16];
#pragma unroll
    for (int r = 0; r < 16; ++r) rli[r] = __builtin_amdgcn_rcpf(li_l[crow(r, hi)]);
    bf16_t* Ow = T_O(cur) + (size_t)(wid * QBLK) * LDQ;
    char* ost = lds + QR_LDS_OFF + wid * 4096;
#pragma unroll
    for (int pass = 0; pass < 2; ++pass) {
#pragma unroll
        for (int r8 = 0; r8 < 8; ++r8) { const int r = pass * 8 + r8, rl = crow(r, hi) - 16 * pass;
#pragma unroll
            for (int d0 = 0; d0 < 4; ++d0) { const float v = o[d0][r] * rli[r]; const float vn = dpp_xor1(v);
                if ((r32 & 1) == 0) *(unsigned*)(ost + rl * 256 + (d0 * 32 + r32) * 2) = cvtpk(v, vn); } }
        asm volatile("s_waitcnt lgkmcnt(0)" ::: "memory");
#pragma unroll
        for (int i = 0; i < 4; ++i) { const int c = lane + 64 * i; const u32x4 w = *(const u32x4*)(ost + c * 16);
            *(u32x4*)(Ow + (size_t)(16 * pass + (c >> 4)) * LDQ + (c & 15) * 8) = w; }
        asm volatile("s_waitcnt lgkmcnt(0)" ::: "memory");
    }
    __builtin_amdgcn_s_setprio(0);
    __syncthreads();
#undef RESC
#undef KBASE
#undef MASKT
}
#undef VMW
#undef QLOAD
#undef DMA_TILE

__device__ __forceinline__ void attn_phase(char* lds, unsigned char* wsb, int vcu, int G) {
    constexpr int total = 512;
    for (int L = vcu; L < total; L += G) {
        for (int pass = 0; pass < 2; ++pass) {
            const int bh = L >> 3, x = L & 7, b = bh >> 4, h = bh & 15, qb = pass ? 15 - x : x;
            BlockRef cur; cur.wsb = wsb; cur.tok0 = b * 4096; cur.row0 = b * 4096 + qb * QB; cur.h = h; cur.P0 = qb * QB;
            block(cur, lds);
        }
    }
}
#undef T_QN
#undef T_QR
#undef T_KN
#undef T_KR
#undef T_V
#undef T_O
#undef SBAR
}
#ifndef PROBE_REP
#define PROBE_REP 0
#endif
#ifndef L2PF_FFN1
#define L2PF_FFN1 true
#endif
#ifndef L2PF_FFN2
#define L2PF_FFN2 false
#endif
#ifndef FFN1_SIM
#define FFN1_SIM false
#endif
#ifndef FFN1_SP2
#define FFN1_SP2 true
#endif
#ifndef EPI_ALIGN_RES
#define EPI_ALIGN_RES true
#endif
struct Args { const void* in[25]; float* out; unsigned char* ws; int ph_lo, ph_hi; };
struct Frame {
    LAS unsigned char* lds; volatile LAS unsigned* MISC; gu32* ctl; unsigned char* ws;
    int vcu, G;
    const Args* a;
    float* xw;
    float* rs;
    float* modv; float* kvmod;
    float* dv; float2* tab;
};
__device__ const double kInvFreqTurns[32] = {
1.59154943091895346e-01, 1.19349370211248862e-01, 8.94994016088910133e-02, 6.71150830052272551e-02, 5.03292121044870353e-02, 3.77415847174197711e-02, 2.83021958306233987e-02, 2.12236527647776604e-02,
1.59154943091895339e-02, 1.19349370211248862e-02, 8.94994016088910237e-03, 6.71150830052272534e-03, 5.03292121044870370e-03, 3.77415847174197719e-03, 2.83021958306233987e-03, 2.12236527647776622e-03,
1.59154943091895356e-03, 1.19349370211248849e-03, 8.94994016088910237e-04, 6.71150830052272599e-04, 5.03292121044870326e-04, 3.77415847174197741e-04, 2.83021958306233954e-04, 2.12236527647776605e-04,
1.59154943091895351e-04, 1.19349370211248862e-04, 8.94994016088910182e-05, 6.71150830052272545e-05, 5.03292121044870354e-05, 3.77415847174197768e-05, 2.83021958306233961e-05, 2.12236527647776592e-05};

__device__ __forceinline__ void tr_item(const float* W, int ldw, int col0, int k0, bf16_t* dst, int ldd, int drow0, const float* kscale, LAS float* scr, int lane) {
#pragma unroll 8
    for (int i = 0; i < 32; ++i) { const int kk = 2 * i + (lane >> 5); const float* wp_ = W + (size_t)(k0 + kk) * ldw + col0 + (lane & 31); float v = NT_LOADS0 ? __builtin_nontemporal_load(wp_) : *wp_; if (kscale) v *= kscale[k0 + kk]; scr[kk * 33 + (lane & 31)] = v; }
    LDS_WAIT(); asm volatile("" ::: "memory");
    const int c = lane & 7;
#pragma unroll
    for (int j = 0; j < 4; ++j) { const int n = (lane >> 3) + 8 * j; const LAS float* s = scr + (8 * c) * 33 + n;
        u32x4 o; o.x = pk2(s[0 * 33], s[1 * 33]); o.y = pk2(s[2 * 33], s[3 * 33]); o.z = pk2(s[4 * 33], s[5 * 33]); o.w = pk2(s[6 * 33], s[7 * 33]);
        *(GAS u32x4*)(dst + (size_t)(drow0 + n) * ldd + k0 + 8 * c) = o; }
    LDS_WAIT(); asm volatile("" ::: "memory");
}
__device__ __forceinline__ void modgemv_item(const float* c, const float* W, int N, const float* bias, float* out, int n0, int kc, LAS float* scr, int lane) {
    const int kb = kc * 256;
#pragma unroll
    for (int j = 0; j < 16; ++j) { const int e = lane + 64 * j; const int b = e >> 8, kk = e & 255; const float v = c[b * 2048 + kb + kk]; scr[e] = v / (1.f + __expf(-v)); }
    LDS_WAIT(); asm volatile("" ::: "memory");
    f32x4 a0 = {0, 0, 0, 0}, a1 = a0, a2 = a0, a3 = a0;
    const float* wp = W + (size_t)kb * N + n0 + 4 * lane;
#pragma unroll 8
    for (int kk = 0; kk < 256; ++kk) { const f32x4 w = NT_LOADS0 ? __builtin_nontemporal_load((const f32x4*)(wp + (size_t)kk * N)) : *(const f32x4*)(wp + (size_t)kk * N);
        a0 += w * scr[kk]; a1 += w * scr[256 + kk]; a2 += w * scr[512 + kk]; a3 += w * scr[768 + kk]; }
    if (kc == 0) { const f32x4 bb = *(const f32x4*)(bias + n0 + 4 * lane); a0 += bb; a1 += bb; a2 += bb; a3 += bb; }
    float* o = out + n0 + 4 * lane;
#pragma unroll
    for (int j = 0; j < 4; ++j) { atomicAdd(o + j, a0[j]); atomicAdd(o + N + j, a1[j]); atomicAdd(o + 2 * N + j, a2[j]); atomicAdd(o + 3 * N + j, a3[j]); }
    LDS_WAIT(); asm volatile("" ::: "memory");
}
__device__ __forceinline__ void ph0_prologue(Frame& F) {
    const int tid = opaque_tid(), lane = tid & 63, wave = __builtin_amdgcn_readfirstlane(tid >> 6);
    LAS float* scr = (LAS float*)(F.lds + wave * 16384);
    const int gw = F.vcu * NWAVES + wave, NGW = F.G * NWAVES;
    unsigned char* ws = F.ws;
    constexpr int N_MG = 208 * 8, N_F1 = 32 * 352, N_F2 = 88 * 64, N_PL = 128, N_DKV = 512, N_KR = 64, N_DQ = 512, N_UK = 512, N_UQ = 768, N_WO = 2048, N_Z = 192, N_R = 8192;
    constexpr int NITEMS = N_MG + 4 * N_F1 + 4 * N_F2 + 8 * N_PL + N_DKV + N_KR + 2 * N_DQ + 2 * N_UK + 2 * N_UQ + 2 * N_WO + N_Z + N_R;
    for (int rep0 = 0; rep0 < (PROBE_REP == 7 ? 2 : 1); ++rep0)
    for (int it = gw; it < NITEMS; it += NGW) {
        int r = it;
        if (rep0 == 1 && (r < N_MG || r >= NITEMS - N_R)) continue;
        if (r < N_MG) { const int cb = r >> 3, kc = r & 7;
            if (cb < 192) { const int l = cb / 48, n0 = (cb % 48) * 256; modgemv_item(((const float*)F.a->in[1]), ((const float*)F.a->in[3]) + (size_t)l * 2048 * 12288, 12288, ((const float*)F.a->in[4]) + l * 12288, F.modv + (size_t)l * 4 * 12288, n0, kc, scr, lane); }
            else { const int n0 = (cb - 192) * 256; modgemv_item(((const float*)F.a->in[1]), ((const float*)F.a->in[9]), 4096, ((const float*)F.a->in[10]), F.kvmod, n0, kc, scr, lane); }
            continue; } r -= N_MG;
        if (r < 4 * N_F1) { const int l = r / N_F1, q = r % N_F1, kb = q / 352, nb = q % 352, tile = nb >> 3, qq = nb & 7;
            const float* src = ((qq >> 2) ? ((const float*)F.a->in[22]) : ((const float*)F.a->in[21])) + (size_t)l * 2048 * 5632;
            tr_item(src, 5632, tile * 128 + (qq & 3) * 32, kb * 64, (bf16_t*)(ws + WS_WFFN1 + l * SZ_WFFN1), 2048, nb * 32, nullptr, scr, lane); continue; } r -= 4 * N_F1;
        if (r < 4 * N_F2) { const int l = r / N_F2, q = r % N_F2, kb = q / 64, nb = q % 64;
            tr_item(((const float*)F.a->in[23]) + (size_t)l * 5632 * 2048, 2048, nb * 32, kb * 64, (bf16_t*)(ws + WS_WFFN2 + l * SZ_WFFN2), 5632, nb * 32, nullptr, scr, lane); continue; } r -= 4 * N_F2;
        if (r < 8 * N_PL) { const int lg = r / N_PL, q = r % N_PL, kb = q / 16, nb = q % 16, l = lg >> 2, g = lg & 3;
            tr_item(((const float*)F.a->in[7]) + (size_t)lg * 512 * 512, 512, nb * 32, kb * 64, (bf16_t*)(ws + WS_WPOOL + l * SZ_WPOOL), 512, g * 512 + nb * 32, nullptr, scr, lane); continue; } r -= 8 * N_PL;
        if (r < N_DKV) { const int kb = r / 16, nb = r % 16; tr_item(((const float*)F.a->in[12]), 512, nb * 32, kb * 64, (bf16_t*)(ws + WS_WD2), 2048, nb * 32, nullptr, scr, lane); continue; } r -= N_DKV;
        if (r < N_KR) { const int kb = r / 2, nb = r % 2; tr_item(((const float*)F.a->in[16]), 64, nb * 32, kb * 64, (bf16_t*)(ws + WS_WD2), 2048, 512 + nb * 128, nullptr, scr, lane); continue; } r -= N_KR;
        if (r < 2 * N_DQ) { const int j = r / N_DQ, q = r % N_DQ, kb = q / 16, nb = q % 16;
            tr_item(((const float*)F.a->in[17]) + (size_t)j * 2048 * 512, 512, nb * 32, kb * 64, (bf16_t*)(ws + (j ? WS_WD3 : WS_WD2)), 2048, (j ? 0 : 768) + nb * 32, nullptr, scr, lane); continue; } r -= 2 * N_DQ;
        if (r < 2 * N_UK) { const int j = r / N_UK, q = r % N_UK, kb = q / 64, nb = q % 64;
            tr_item(j ? ((const float*)F.a->in[15]) : ((const float*)F.a->in[14]), 2048, nb * 32, kb * 64, (bf16_t*)(ws + WS_WU2), 512, j * 2048 + nb * 32, ((const float*)F.a->in[13]), scr, lane); continue; } r -= 2 * N_UK;
        if (r < 2 * N_UQ) { const int j = r / N_UQ, q = r % N_UQ, kb = q / 96, db = q % 96; int col0, drow;
            if (db < 64) { col0 = (db >> 2) * 192 + (db & 3) * 32; drow = db * 32; }
            else { const int e = db - 64, tt = e >> 3, r8 = e & 7, bj = r8 >> 2, wcp = r8 & 3; col0 = (4 * tt + wcp) * 192 + 128 + bj * 32; drow = 2048 + e * 32; }
            tr_item(((const float*)F.a->in[19]) + (size_t)j * 512 * 3072, 3072, col0, kb * 64, (bf16_t*)(ws + (j ? WS_WU3 : WS_WU2)), 512, (j ? 0 : 4096) + drow, ((const float*)F.a->in[18]) + j * 512, scr, lane); continue; } r -= 2 * N_UQ;
        if (r < 2 * N_WO) { const int j = r / N_WO, q = r % N_WO, kb = q / 64, nb = q % 64;
            tr_item(((const float*)F.a->in[20]) + (size_t)j * 2048 * 2048, 2048, nb * 32, kb * 64, (bf16_t*)(ws + WS_WO + j * SZ_WO), 2048, nb * 32, nullptr, scr, lane); continue; } r -= 2 * N_WO;
        if (r < N_Z) { const int row = r < 96 ? 544 + r : 672 + (r - 96); GAS u32x4* p = (GAS u32x4*)((bf16_t*)(ws + WS_WD2) + (size_t)row * 2048);
#pragma unroll
            for (int j = 0; j < 4; ++j) p[lane + 64 * j] = (u32x4){0u, 0u, 0u, 0u};
            continue; } r -= N_Z;
        { const int row = r * 2 + (lane >> 5), i = lane & 31;
          const double t = (double)((const int*)F.a->in[2])[row] * kInvFreqTurns[i]; const double fr = t - __builtin_rint(t);
          const float a = (float)(fr * 6.283185307179586476925);
          F.tab[(size_t)row * 32 + i] = make_float2(cosf(a), sinf(a)); }
    }
}

typedef float f32x2 __attribute__((ext_vector_type(2)));
template <int W, bool XB>
__device__ __forceinline__ void pool_cols(const void* xcv, const unsigned char* xlv, const LAS float* rsl, const f32x2 gm, int tb, int start, bf16_t* dp) {
    f32x2 hp[16], hc[16];
    auto ldx = [&](int pos) -> f32x2 { if constexpr (XB) { const unsigned r = *(const unsigned*)((const bf16_t*)xcv + (size_t)pos * DM); unsigned lo = 0u; if (XBF16 == 2) lo = *(const unsigned short*)(xlv + (size_t)pos * DM); return (f32x2){__builtin_bit_cast(float, (r << 16) | ((lo << 8) & 0xff00u)), __builtin_bit_cast(float, (r & 0xffff0000u) | (lo & 0xff00u))}; } else return *(const f32x2*)((const float*)xcv + (size_t)pos * DM); };
#pragma unroll
    for (int i = 0; i < 16; ++i) hp[i] = (f32x2){0.f, 0.f};
    if (tb > 0) {
#pragma unroll
        for (int i = 0; i < 16; ++i) hp[i] = ldx(tb - 16 + i);
#pragma unroll
        for (int i = 0; i < 16; ++i) hp[i] = hp[i] * (gm * rsl[tb - 16 + i - start]);
    }
    f32x2 S = {0.f, 0.f};
#pragma unroll
    for (int i = 16 - W; i < 16; ++i) S += hp[i];
    for (int ch = 0; ch < 4; ++ch) {
        const int p0 = tb + ch * 16;
#pragma unroll
        for (int i = 0; i < 16; ++i) hc[i] = ldx(p0 + i);
#pragma unroll
        for (int i = 0; i < 16; ++i) hc[i] = hc[i] * (gm * rsl[p0 + i - start]);
#pragma unroll
        for (int i = 0; i < 16; ++i) {
            const int pos = p0 + i;
            S += hc[i]; S -= (i >= W) ? hc[i - W] : hp[16 + i - W];
            const float inv = 1.f / (float)(pos + 1 < W ? pos + 1 : W);
            const f32x2 d = S * inv - hc[i];
            *(GAS unsigned*)(dp + (size_t)pos * DM) = cvt_pk_bf16(d[0], d[1]);
        }
#pragma unroll
        for (int i = 0; i < 16; ++i) hp[i] = hc[i];
    }
}
template <bool XB>
__device__ __forceinline__ void pool_unit(Frame& F, const void* xsrc, const float* gnorm, const float* scale_m  , int unit, bf16_t* Dout) {
    LAS float* rsl = (LAS float*)F.lds;
    const int tid = opaque_tid(), lane = tid & 63, wave = __builtin_amdgcn_readfirstlane(tid >> 6);
    const int t0 = unit * 64, b = t0 >> 12, tb = t0 & 4095;
    const int start = tb >= 16 ? tb - 16 : 0, nrows = tb + 64 - start;
    const size_t xboff = (size_t)b * 4096 * DM;
    for (int ri = wave; ri < nrows; ri += 2 * NWAVES) {
        const int r2 = ri + NWAVES < nrows ? ri + NWAVES : ri;
        float sa = 0.f, sb = 0.f;
        if constexpr (XB) {
            const GAS u32x4* xa = (const GAS u32x4*)((const bf16_t*)xsrc + xboff + (size_t)(start + ri) * DM) + lane; const GAS u32x4* xq = (const GAS u32x4*)((const bf16_t*)xsrc + xboff + (size_t)(start + r2) * DM) + lane;
            const GAS u32x2* la = (const GAS u32x2*)(F.ws + WS_XL + xboff + (size_t)(start + ri) * DM) + lane; const GAS u32x2* lq = (const GAS u32x2*)(F.ws + WS_XL + xboff + (size_t)(start + r2) * DM) + lane;
            u32x4 va[4], vb[4]; u32x2 wa[4], wb[4];
#pragma unroll
            for (int j = 0; j < 4; ++j) { va[j] = xa[64 * j]; vb[j] = xq[64 * j]; if (XBF16 == 2) { wa[j] = la[64 * j]; wb[j] = lq[64 * j]; } }
#pragma unroll
            for (int j = 0; j < 4; ++j) { f32x4 a0, a1, b0, b1;
                if (XBF16 == 2) { x8_unpack24(va[j], wa[j], a0, a1); x8_unpack24(vb[j], wb[j], b0, b1); } else { x8_unpack16(va[j], a0, a1); x8_unpack16(vb[j], b0, b1); }
                sa += (a0[0] * a0[0] + a0[1] * a0[1]) + (a0[2] * a0[2] + a0[3] * a0[3]) + (a1[0] * a1[0] + a1[1] * a1[1]) + (a1[2] * a1[2] + a1[3] * a1[3]);
                sb += (b0[0] * b0[0] + b0[1] * b0[1]) + (b0[2] * b0[2] + b0[3] * b0[3]) + (b1[0] * b1[0] + b1[1] * b1[1]) + (b1[2] * b1[2] + b1[3] * b1[3]); }
        } else {
            const GAS f32x4* xa = (const GAS f32x4*)((const float*)xsrc + xboff + (size_t)(start + ri) * DM) + lane; const GAS f32x4* xq = (const GAS f32x4*)((const float*)xsrc + xboff + (size_t)(start + r2) * DM) + lane;
            f32x4 va[8], vb[8];
#pragma unroll
            for (int j = 0; j < 8; ++j) { va[j] = xa[64 * j]; vb[j] = xq[64 * j]; }
#pragma unroll
            for (int j = 0; j < 8; ++j) { sa += (va[j][0] * va[j][0] + va[j][1] * va[j][1]) + (va[j][2] * va[j][2] + va[j][3] * va[j][3]); sb += (vb[j][0] * vb[j][0] + vb[j][1] * vb[j][1]) + (vb[j][2] * vb[j][2] + vb[j][3] * vb[j][3]); }
        }
        sa = wave_sum(sa); sb = wave_sum(sb);
        if (lane == 0) { rsl[ri] = rsqrtf(sa * (1.f / DM) + EPS); rsl[r2] = rsqrtf(sb * (1.f / DM) + EPS); }
    }
    __syncthreads();
    for (int pass = 0; pass < 2; ++pass) {
        const int c = pass * 1024 + 2 * tid, g = pass * 2 + __builtin_amdgcn_readfirstlane(tid >> 8);
        f32x2 gm = *(const f32x2*)(gnorm + c); { const f32x2 sm = *(const f32x2*)(scale_m + (size_t)b * 12288 + c); gm = gm * (sm + 1.f); }
        const void* xc = XB ? (const void*)((const bf16_t*)xsrc + xboff + c) : (const void*)((const float*)xsrc + xboff + c); bf16_t* dp = Dout + (size_t)b * 4096 * DM + c; const unsigned char* xl = F.ws + WS_XL + xboff + c;
        if (g == 0) pool_cols<2, XB>(xc, xl, rsl, gm, tb, start, dp);
        else if (g == 1) pool_cols<4, XB>(xc, xl, rsl, gm, tb, start, dp);
        else if (g == 2) pool_cols<8, XB>(xc, xl, rsl, gm, tb, start, dp);
        else pool_cols<16, XB>(xc, xl, rsl, gm, tb, start, dp);
    }
    __syncthreads();
}
__device__ __forceinline__ void bias_rows(const bf16_t* W, int nrows, const float* shift, int sstride, float* out, int ostride, int w0, int nw, int lane) {
    if (w0 >= nrows) return;
    f32x4 sh[4][4][2];
#pragma unroll
    for (int bb = 0; bb < 4; ++bb)
#pragma unroll
        for (int j = 0; j < 4; ++j) { const float* sp = shift + (size_t)bb * sstride + (lane + 64 * j) * 8; sh[bb][j][0] = *(const f32x4*)sp; sh[bb][j][1] = *(const f32x4*)(sp + 4); }
    for (int n = w0; n < nrows; n += nw) {
        const bf16_t* wrow = W + (size_t)n * 2048;
        bf16x8 wv[4];
#pragma unroll
        for (int j = 0; j < 4; ++j) wv[j] = *(const bf16x8*)(wrow + (lane + 64 * j) * 8);
        float a[4] = {0.f, 0.f, 0.f, 0.f};
#pragma unroll
        for (int j = 0; j < 4; ++j)
#pragma unroll
            for (int e = 0; e < 8; ++e) { const float w = bf2f((unsigned short)wv[j][e]);
#pragma unroll
                for (int bb = 0; bb < 4; ++bb) a[bb] += sh[bb][j][e >> 2][e & 3] * w; }
#pragma unroll
        for (int bb = 0; bb < 4; ++bb) a[bb] = wave_sum(a[bb]);
        if (lane == 0) { out[n] = a[0]; out[ostride + n] = a[1]; out[2 * ostride + n] = a[2]; out[3 * ostride + n] = a[3]; }
    }
}
__device__ __forceinline__ void ph1_prologue(Frame& F) {
    for (int u = F.vcu; u < 256; u += F.G) pool_unit<false>(F, ((const float*)F.a->in[0]), ((const float*)F.a->in[5]), F.modv + 2048, u, (bf16_t*)(F.ws + WS_AKV));
    const int tid = opaque_tid(), lane = tid & 63, wave = __builtin_amdgcn_readfirstlane(tid >> 6);
    const int gt = F.vcu * NWAVES * 64 + tid, NGT = F.G * NWAVES * 64;
    for (int i = gt; i < 4 * 4 * 2048; i += NGT) { const int col = i & 2047, lb = i >> 11, l = lb >> 2;
        const float* mv = F.modv + (size_t)lb * 12288;
        F.dv[DV_GM + i] = ((const float*)F.a->in[5])[l * 2048 + col] * (1.f + mv[2048 + col]);
        F.dv[DV_GF + i] = ((const float*)F.a->in[6])[l * 2048 + col] * (1.f + mv[8192 + col]);
        F.dv[DV_GATEM + i] = mv[4096 + col] * (l < 2 ? ((const float*)F.a->in[8])[l * 2048 + col] : 1.f);
        F.dv[DV_GATEF + i] = mv[10240 + col];
        if (i < 4 * 2048) F.dv[DV_GKV + i] = ((const float*)F.a->in[11])[col] * (1.f + F.kvmod[(size_t)lb * 4096 + 2048 + col]); }
    const int gw = F.vcu * NWAVES + wave, NGW = F.G * NWAVES;
    for (int l = 0; l < 4; ++l)
        bias_rows((const bf16_t*)(F.ws + WS_WFFN1 + l * SZ_WFFN1), 11264, F.modv + (size_t)l * 4 * 12288 + 6144, 12288, F.dv + DV_BFFN + (size_t)l * 4 * 11264, 11264, gw, NGW, lane);
    bias_rows((const bf16_t*)(F.ws + WS_WD2), 768, F.kvmod, 4096, F.dv + DV_BD2, 1280, gw, NGW, lane);
    bias_rows((const bf16_t*)(F.ws + WS_WD2) + (size_t)768 * 2048, 512, F.modv + (size_t)2 * 4 * 12288, 12288, F.dv + DV_BD2 + 768, 1280, gw, NGW, lane);
    bias_rows((const bf16_t*)(F.ws + WS_WD3), 512, F.modv + (size_t)3 * 4 * 12288, 12288, F.dv + DV_BD3, 512, gw, NGW, lane);
}
__device__ __forceinline__ void final_norm_phase(Frame& F) {
    const int tid = opaque_tid(), lane = tid & 63, wave = __builtin_amdgcn_readfirstlane(tid >> 6);
    const int gw = F.vcu * NWAVES + wave, NGW = F.G * NWAVES;
    f32x4 g[8];
#pragma unroll
    for (int j = 0; j < 8; ++j) g[j] = *((const GAS f32x4*)((const float*)F.a->in[24]) + lane + 64 * j);
    for (int m = gw; m < MROWS; m += NGW) {
        GAS f32x4* xr = (GAS f32x4*)(F.xw + (size_t)m * DM) + lane; f32x4 v[8]; float s = 0.f;
#if XBF16
        const GAS u32x2* xb = (const GAS u32x2*)((const bf16_t*)(F.ws + WS_XB) + (size_t)m * DM) + lane;
        const GAS unsigned* xlw = (const GAS unsigned*)(F.ws + WS_XL + (size_t)m * DM) + lane;
#pragma unroll
        for (int j = 0; j < 8; ++j) { const u32x2 r = xb[64 * j]; unsigned lo = 0u; if (XBF16 == 2) lo = xlw[64 * j];
            v[j] = (f32x4){__builtin_bit_cast(float, (r.x << 16) | ((lo << 8) & 0xff00u)), __builtin_bit_cast(float, (r.x & 0xffff0000u) | (lo & 0xff00u)),
                           __builtin_bit_cast(float, (r.y << 16) | ((lo >> 8) & 0xff00u)), __builtin_bit_cast(float, (r.y & 0xffff0000u) | ((lo >> 16) & 0xff00u))}; }
#else
#pragma unroll
        for (int j = 0; j < 8; ++j) v[j] = xr[64 * j];
#endif
#pragma unroll
        for (int j = 0; j < 8; ++j) s += (v[j][0] * v[j][0] + v[j][1] * v[j][1]) + (v[j][2] * v[j][2] + v[j][3] * v[j][3]);
        const float rstd = rsqrtf(wave_sum(s) * (1.f / DM) + EPS);
#pragma unroll
        for (int j = 0; j < 8; ++j) xr[64 * j] = v[j] * rstd * g[j];
    }
}

constexpr int NPHASES = 27;
__global__ void __launch_bounds__(NWAVES * 64, 2) fwd_kernel(Args args) {
    extern __shared__ __attribute__((aligned(16))) unsigned char lds_raw[];
    Frame F;
    F.lds = (LAS unsigned char*)lds_raw; F.MISC = (volatile LAS unsigned*)(F.lds + MISC_OFF);
    F.G = gridDim.x; { const int bx = blockIdx.x; F.vcu = (F.G % 8 == 0) ? (bx % 8) * (F.G / 8) + bx / 8 : bx; }
    unsigned char* const ws0_ = args.ws; float* const xw0_ = args.out;
    F.a = &args;
#define FRAME_PTRS(w_) do { F.ws = (w_); F.ctl = (gu32*)((w_) + WS_CTL); F.rs = (float*)((w_) + WS_CTL) + CW_RS; F.modv = (float*)((w_) + WS_CTL) + CW_MODV; F.kvmod = (float*)((w_) + WS_CTL) + CW_KVMOD; \
        F.dv = (float*)((w_) + WS_DV); F.tab = (float2*)((w_) + WS_TAB); } while (0)
    FRAME_PTRS(ws0_); F.xw = xw0_;
    if (threadIdx.x < 64) F.MISC[threadIdx.x] = 0u;
    __syncthreads();
    XcdBarrier bar = xcd_barrier_post((unsigned*)(F.ctl + CW_BAR), F.MISC);
    const int lo = args.ph_lo, hi = args.ph_hi;
    bool need_bar = false;
#define REPK(kind) for (int rep_ = 0; rep_ < ((PROBE_REP == (kind)) ? 2 : 1); ++rep_)
#define PH_BEGIN(p) if (lo <= (p) && (p) < hi) { if (need_bar) { XcdBarrier b_ = bar; asm volatile("" : "+s"(b_.bar), "+s"(b_.x)); xcd_barrier(b_); } need_bar = true; \
        unsigned char* ws = ws0_; float* xw_ = xw0_; asm volatile("" : "+s"(ws), "+s"(xw_)); FRAME_PTRS(ws); F.xw = xw_;
#define PH_END }
#define AQ ((bf16_t*)(ws + WS_AQ))
#define AKV ((bf16_t*)(ws + WS_AKV))
#define ACT ((bf16_t*)(ws + WS_ACT))
#define KN ((bf16_t*)(ws + WS_KN))
#define VV ((bf16_t*)(ws + WS_V))
#define KR ((bf16_t*)(ws + WS_KR))
#define CKV ((bf16_t*)(ws + WS_CKV))
#define CQ ((bf16_t*)(ws + WS_CQ))
#define QN ((bf16_t*)(ws + WS_QN))
#define QR ((bf16_t*)(ws + WS_QR))
#define OO ((bf16_t*)(ws + WS_O))

    #ifndef SK0
    PH_BEGIN(0) ph0_prologue(F); PH_END
#endif
    #ifndef SK1
    PH_BEGIN(1) REPK(8) ph1_prologue(F); PH_END
#endif
    for (int l = 0; l < 4; ++l) {
        const int base = 2 + 6 * l;
        if (l == 1) {
            PH_BEGIN(base) for (int u = F.vcu; u < 256; u += F.G) pool_unit<XBF16 != 0>(F, XBF16 ? (const void*)(ws + WS_XB) : (const void*)F.xw, ((const float*)F.a->in[5]) + 2048, F.modv + (size_t)4 * 12288 + 2048, u, AKV); PH_END
        }
        if (l >= 2) {
#ifndef SKD
            PH_BEGIN(base) {
                const bool first = (l == 2);
                pg8::Gemm g{first ? AKV : AQ, AQ, first ? 3 : 0, 2048, 0, (const bf16_t*)(ws + (first ? WS_WD2 : WS_WD3)), 2048, 2048, 64, first ? 5 : 2};
                pg8::StaticOrder S; S.init(g.nM, g.nN, F.G, (int)blockIdx.x);
                pg8::EpiDown E{F.rs + (first ? RS_M2 : RS_M3) * 16384, F.dv + (first ? DV_BD2 : DV_BD3), first ? 1280 : 512, first ? 3 : 0, ws, F.rs, first ? RS_Q2 : RS_Q3, F.tab};
                pg8::gemm_phase<pg8::EpiDown>(F.lds, g, S, E);
            } PH_END
#endif
#ifndef SKU
            PH_BEGIN(base + 1) {
                const bool first = (l == 2);
                pg8::Gemm g{first ? CKV : CQ, CQ, first ? 16 : 0, 512, 0, (const bf16_t*)(ws + (first ? WS_WU2 : WS_WU3)), 512, 512, 64, first ? 28 : 12};
                pg8::StaticOrder S; S.init(g.nM, g.nN, F.G, (int)blockIdx.x);
                pg8::EpiUp E{ws, F.rs, first ? RS_Q2 : RS_Q3, first ? 16 : 0, F.tab};
                REPK(5) pg8::gemm_phase<pg8::EpiUp>(F.lds, g, S, E);
            } PH_END
#endif
#ifndef SKA
            PH_BEGIN(base + 2) {
                REPK(3) att::attn_phase((char*)lds_raw, ws, F.vcu, F.G);
            } PH_END
#endif
        }
#ifndef SKM
        PH_BEGIN(base + 3) {
            const bool pool = l < 2;
            pg8::Gemm g{pool ? AKV : OO, pool ? AKV : OO, 0, 2048, pool ? 1 : 0, (const bf16_t*)(ws + (pool ? WS_WPOOL + l * SZ_WPOOL : WS_WO + (l - 2) * SZ_WO)), pool ? 512 : 2048, pool ? 512 : 2048, 64, 8};
            pg8::StaticOrder S; S.init(g.nM, g.nN, F.G, (int)blockIdx.x, 4);
            pg8::EpiRes E{l == 0 ? ((const float*)F.a->in[0]) : (XBF16 ? nullptr : F.xw), (const bf16_t*)(ws + WS_XB), XBF16 ? nullptr : F.xw, (bf16_t*)(ws + WS_XB), ws + WS_XL, F.dv + DV_GATEM + l * 4 * 2048, F.dv + DV_GF + l * 4 * 2048, AQ, nullptr, nullptr, F.rs + (RS_F0 + l) * 16384};
            if (PROBE_REP == 4) { pg8::EpiRes E2 = E; E2.xout32 = (float*)(ws + WS_FAST_END); E2.rowss = nullptr; E2.a0 = (bf16_t*)(ws + WS_FAST_END + (size_t)MROWS * DM * 4); pg8::gemm_phase<pg8::EpiRes, EPI_ALIGN_RES>(F.lds, g, S, E2); }
            pg8::gemm_phase<pg8::EpiRes, EPI_ALIGN_RES>(F.lds, g, S, E);
        } PH_END
#endif
#ifndef SKF1
        PH_BEGIN(base + 4) {
            pg8::Gemm g{AQ, AQ, 0, 2048, 0, (const bf16_t*)(ws + WS_WFFN1 + l * SZ_WFFN1), 2048, 2048, 64, 44};
            pg8::StaticOrder S; S.init(g.nM, g.nN, F.G, (int)blockIdx.x);
            pg8::EpiSwi E{F.rs + (RS_F0 + l) * 16384, F.dv + DV_BFFN + (size_t)l * 4 * 11264, ACT};
            REPK(1) pg8::gemm_phase<pg8::EpiSwi, true, FFN1_SP2, FFN1_SIM, L2PF_FFN1>(F.lds, g, S, E);
        } PH_END
#endif
#ifndef SKF2
        PH_BEGIN(base + 5) {
            pg8::Gemm g{ACT, ACT, 0, 5632, 0, (const bf16_t*)(ws + WS_WFFN2 + l * SZ_WFFN2), 5632, 5632, 64, 8};
            pg8::StaticOrder S; S.init(g.nM, g.nN, F.G, (int)blockIdx.x, 4);
            const bool hasA = (l == 1 || l == 2);
            pg8::EpiRes E{XBF16 ? nullptr : F.xw, (const bf16_t*)(ws + WS_XB), XBF16 ? nullptr : F.xw, (bf16_t*)(ws + WS_XB), ws + WS_XL, F.dv + DV_GATEF + l * 4 * 2048, hasA ? F.dv + DV_GM + (l + 1) * 4 * 2048 : nullptr, hasA ? AQ : nullptr,
                          l == 1 ? F.dv + DV_GKV : nullptr, l == 1 ? AKV : nullptr, hasA ? F.rs + (l == 1 ? RS_M2 : RS_M3) * 16384 : nullptr};
            if (PROBE_REP == 10) { pg8::EpiNull E0{(float*)(ws + WS_FAST_END)}; pg8::gemm_phase<pg8::EpiNull, true>(F.lds, g, S, E0); }
            if (PROBE_REP == 14) { pg8::EpiNull E0{(float*)(ws + WS_FAST_END)}; pg8::Gemm g2 = g; g2.grouped = 2; pg8::gemm_phase<pg8::EpiNull, true>(F.lds, g2, S, E0); }
            if (PROBE_REP == 2) { pg8::EpiRes E2 = E; E2.xout32 = (float*)(ws + WS_FAST_END); E2.rowss = nullptr; pg8::gemm_phase<pg8::EpiRes, EPI_ALIGN_RES>(F.lds, g, S, E2); }
            pg8::gemm_phase<pg8::EpiRes, EPI_ALIGN_RES, true, false, L2PF_FFN2>(F.lds, g, S, E);
        } PH_END
#endif
    }
    PH_BEGIN(26) final_norm_phase(F); PH_END
#undef PH_BEGIN
#undef PH_END
#undef FRAME_PTRS
#undef AQ
#undef AKV
#undef ACT
#undef KN
#undef VV
#undef KR
#undef CKV
#undef CQ
#undef QN
#undef QR
#undef OO
}
#if MODE >= 2
extern "C" void kernel_launch(void* const* d_in, const int* in_sizes, int n_in, void* d_out, int out_size, void* d_ws, size_t ws_size, hipStream_t stream) {
    static int grid = 0;
    if (grid == 0) {
        if (n_in != 25 || out_size != MROWS * DM || ws_size < WS_FAST_END) { fprintf(stderr, "kernel_launch: unexpected shapes / workspace (%d inputs, out %d, ws %zu < %zu)\n", n_in, out_size, ws_size, (size_t)WS_FAST_END); grid = -1; return; }
        int dev = 0, cus = 0, per_cu = 0;
        if (hipGetDevice(&dev) != hipSuccess || hipDeviceGetAttribute(&cus, hipDeviceAttributeMultiprocessorCount, dev) != hipSuccess) { grid = -1; return; }
        if (hipFuncSetAttribute((const void*)fwd_kernel, hipFuncAttributeMaxDynamicSharedMemorySize, LDS_BYTES) != hipSuccess) { fprintf(stderr, "kernel_launch: hipFuncSetAttribute failed\n"); grid = -1; return; }
        if (hipOccupancyMaxActiveBlocksPerMultiprocessor(&per_cu, (const void*)fwd_kernel, NWAVES * 64, LDS_BYTES) != hipSuccess || per_cu < 1) { fprintf(stderr, "kernel_launch: occupancy query says %d\n", per_cu); }
        (void)hipGetLastError();
        grid = cus;
    }
    if (grid < 0) return;
    (void)hipMemsetAsync((char*)d_ws + WS_CTL, 0, CTL_ZERO_BYTES, stream);
    Args a{};
    for (int i = 0; i < 25; ++i) a.in[i] = d_in[i];
    a.out = (float*)d_out; a.ws = (unsigned char*)d_ws;
#if MODE == 2
    a.ph_lo = 0; a.ph_hi = NPHASES;
    hipLaunchKernelGGL(fwd_kernel, dim3(grid), dim3(NWAVES * 64), LDS_BYTES, stream, a);
#else
    for (int p = 0; p < NPHASES; ++p) {
        const int k = p < 2 ? -1 : (p - 2) % 6, l = p < 2 ? -1 : (p - 2) / 6;
        if (p >= 2 && p < 26) { if (k == 0 && l == 0) continue; if ((k == 1 || k == 2) && l < 2) continue; }
        a.ph_lo = p; a.ph_hi = p + 1;
        hipLaunchKernelGGL(fwd_kernel, dim3(grid), dim3(NWAVES * 64), LDS_BYTES, stream, a);
    }
#endif
}
#endif
```

```cpp
#include <hip/hip_runtime.h>
#include <cstdio>
#include <cstdint>
#ifndef MODE
#define MODE 2
#define PROBE_REP 0
#endif
#define GAS __attribute__((address_space(1)))
#define LAS __attribute__((address_space(3)))
typedef unsigned short bf16_t;
typedef short bf16x8 __attribute__((ext_vector_type(8)));
typedef short s16x4 __attribute__((ext_vector_type(4)));
typedef float f32x4 __attribute__((ext_vector_type(4)));
typedef float f32x16 __attribute__((ext_vector_type(16)));
typedef unsigned u32x4 __attribute__((ext_vector_type(4)));
typedef unsigned u32x2 __attribute__((ext_vector_type(2)));
typedef GAS unsigned gu32;

#ifndef NT_LOADS0
#define NT_LOADS0 0
#endif
#ifndef NT_STORES
#define NT_STORES 0
#endif
#ifndef XBF16
#define XBF16 2
#endif
constexpr int NWAVES = 8;
constexpr int BATCH = 4, SEQ = 4096, DM = 2048, MROWS = BATCH * SEQ, FF = 5632, NH = 16;
constexpr float EPS = 1e-6f;
constexpr size_t MiB = 1u << 20;

constexpr size_t WS_CTL = 0, CTL_ZERO_BYTES = 4 * MiB;
constexpr int CW_TMO = 0;
constexpr int CW_BAR = 4096;
constexpr int CW_RS = 16384;
constexpr int RS_F0 = 0, RS_M2 = 4, RS_M3 = 5, RS_KV = 6, RS_Q2 = 7, RS_Q3 = 8;
constexpr int CW_MODV = CW_RS + 12 * 16384;
constexpr int CW_KVMOD = CW_MODV + 4 * 4 * 12288;
constexpr int CW_END = CW_KVMOD + 4 * 4096;
static_assert((size_t)CW_END * 4 <= CTL_ZERO_BYTES, "CTL region");
constexpr size_t WS_DV = 4 * MiB;
constexpr int DV_GM = 0;
constexpr int DV_GF = DV_GM + 4 * 4 * 2048;
constexpr int DV_GKV = DV_GF + 4 * 4 * 2048;
constexpr int DV_GATEM = DV_GKV + 4 * 2048;
constexpr int DV_GATEF = DV_GATEM + 4 * 4 * 2048;
constexpr int DV_BFFN = DV_GATEF + 4 * 4 * 2048;
constexpr int DV_BD2 = DV_BFFN + 4 * 4 * 11264;
constexpr int DV_BD3 = DV_BD2 + 4 * 1280;
constexpr int DV_END = DV_BD3 + 4 * 512;
static_assert((size_t)DV_END * 4 <= 2 * MiB, "DV region");
constexpr size_t WS_TAB = 6 * MiB;
constexpr size_t WS_WFFN1 = 10 * MiB;
constexpr size_t SZ_WFFN1 = (size_t)11264 * 2048 * 2;
constexpr size_t WS_WFFN2 = WS_WFFN1 + 4 * SZ_WFFN1;
constexpr size_t SZ_WFFN2 = (size_t)2048 * 5632 * 2;
constexpr size_t WS_WPOOL = WS_WFFN2 + 4 * SZ_WFFN2;
constexpr size_t SZ_WPOOL = (size_t)2048 * 512 * 2;
constexpr size_t WS_WD2 = WS_WPOOL + 2 * SZ_WPOOL;
constexpr size_t WS_WD3 = WS_WD2 + (size_t)1280 * 2048 * 2;
constexpr size_t WS_WU2 = WS_WD3 + (size_t)512 * 2048 * 2;
constexpr size_t WS_WU3 = WS_WU2 + (size_t)7168 * 512 * 2;
constexpr size_t WS_WO = WS_WU3 + (size_t)3072 * 512 * 2;
constexpr size_t SZ_WO = (size_t)2048 * 2048 * 2;
constexpr size_t WS_WEND = WS_WO + 2 * SZ_WO;
constexpr size_t SZ_MD = (size_t)MROWS * DM * 2;
constexpr size_t WS_AQ = (WS_WEND + MiB - 1) / MiB * MiB;
constexpr size_t WS_AKV = WS_AQ + SZ_MD;
constexpr size_t WS_KN = WS_AKV + SZ_MD;
constexpr size_t WS_V = WS_KN + SZ_MD;
constexpr size_t WS_KR = WS_V + SZ_MD;
constexpr size_t WS_CKV = WS_KR + (size_t)MROWS * 64 * 2;
constexpr size_t WS_CQ = WS_CKV + (size_t)MROWS * 512 * 2;
constexpr size_t WS_ACT = WS_CQ + (size_t)MROWS * 512 * 2;
constexpr size_t WS_QN = WS_ACT, WS_QR = WS_QN + SZ_MD, WS_O = WS_QR + (size_t)MROWS * 1024 * 2;
constexpr size_t WS_XB = WS_ACT + (size_t)MROWS * FF * 2;
constexpr size_t WS_XL = WS_XB + SZ_MD;
constexpr size_t WS_FAST_END = WS_XL + SZ_MD / 2;
static_assert(WS_O + SZ_MD <= WS_XB, "attention overlays inside act");

constexpr int RING_BYTES = 131072;
constexpr int LDS_BYTES = 147456;
constexpr int MISC_OFF = LDS_BYTES - 256;

#define RLX_AGENT __ATOMIC_RELAXED, __HIP_MEMORY_SCOPE_AGENT
#define LDS_WAIT() asm volatile("s_waitcnt lgkmcnt(0)" ::: "memory")
#define VM_WAIT() asm volatile("s_waitcnt vmcnt(0)" ::: "memory")
__device__ __forceinline__ unsigned f2bf(float f) { unsigned u = __builtin_bit_cast(unsigned, f); return (u + 0x7fffu + ((u >> 16) & 1u)) >> 16; }
__device__ __forceinline__ unsigned pk2(float lo, float hi) { return f2bf(lo) | (f2bf(hi) << 16); }
__device__ __forceinline__ float bf2f(unsigned short b) { return __builtin_bit_cast(float, (unsigned)b << 16); }
__device__ __forceinline__ unsigned cvt_pk_bf16(float lo, float hi) { unsigned r; asm volatile("v_cvt_pk_bf16_f32 %0, %1, %2" : "=v"(r) : "v"(lo), "v"(hi)); return r; }
__device__ __forceinline__ int opaque_lane() { int l; asm volatile("v_mbcnt_lo_u32_b32 %0, -1, 0\n\tv_mbcnt_hi_u32_b32 %0, -1, %0" : "=v"(l)); return l; }
__device__ __forceinline__ int opaque_tid() { int t = threadIdx.x; asm volatile("" : "+v"(t)); return t; }
__device__ __forceinline__ void x8_unpack16(const u32x4 h, f32x4& a, f32x4& b) {
    a = (f32x4){__builtin_bit_cast(float, h.x << 16), __builtin_bit_cast(float, h.x & 0xffff0000u), __builtin_bit_cast(float, h.y << 16), __builtin_bit_cast(float, h.y & 0xffff0000u)};
    b = (f32x4){__builtin_bit_cast(float, h.z << 16), __builtin_bit_cast(float, h.z & 0xffff0000u), __builtin_bit_cast(float, h.w << 16), __builtin_bit_cast(float, h.w & 0xffff0000u)}; }
__device__ __forceinline__ void x8_unpack24(const u32x4 h, const u32x2 l, f32x4& a, f32x4& b) {
    a = (f32x4){__builtin_bit_cast(float, (h.x << 16) | ((l.x << 8) & 0xff00u)), __builtin_bit_cast(float, (h.x & 0xffff0000u) | (l.x & 0xff00u)),
                __builtin_bit_cast(float, (h.y << 16) | ((l.x >> 8) & 0xff00u)), __builtin_bit_cast(float, (h.y & 0xffff0000u) | ((l.x >> 16) & 0xff00u))};
    b = (f32x4){__builtin_bit_cast(float, (h.z << 16) | ((l.y << 8) & 0xff00u)), __builtin_bit_cast(float, (h.z & 0xffff0000u) | (l.y & 0xff00u)),
                __builtin_bit_cast(float, (h.w << 16) | ((l.y >> 8) & 0xff00u)), __builtin_bit_cast(float, (h.w & 0xffff0000u) | ((l.y >> 16) & 0xff00u))}; }
__device__ __forceinline__ void x8_pack24(const f32x4 a, const f32x4 b, u32x4& h, u32x2& l) {
    unsigned t[8];
#pragma unroll
    for (int i = 0; i < 4; ++i) { const float fa = a[i], fb = b[i];
        t[i] = (__builtin_bit_cast(unsigned, fa) + 0x80u) >> 8; t[4 + i] = (__builtin_bit_cast(unsigned, fb) + 0x80u) >> 8; }
    h.x = (t[0] >> 8) | ((t[1] << 8) & 0xffff0000u); h.y = (t[2] >> 8) | ((t[3] << 8) & 0xffff0000u); h.z = (t[4] >> 8) | ((t[5] << 8) & 0xffff0000u); h.w = (t[6] >> 8) | ((t[7] << 8) & 0xffff0000u);
    l.x = (t[0] & 0xffu) | ((t[1] & 0xffu) << 8) | ((t[2] & 0xffu) << 16) | (t[3] << 24); l.y = (t[4] & 0xffu) | ((t[5] & 0xffu) << 8) | ((t[6] & 0xffu) << 16) | (t[7] << 24); }
template <class T> __device__ __forceinline__ void st_stream(T* p, const T& v) { if (NT_STORES) __builtin_nontemporal_store(v, p); else *p = v; }
__device__ __forceinline__ float dpp_xor1(float v) { return __builtin_bit_cast(float, __builtin_amdgcn_mov_dpp(__builtin_bit_cast(int, v), 0xB1, 0xF, 0xF, true)); }
__device__ __forceinline__ float dpp_xor2(float v) { return __builtin_bit_cast(float, __builtin_amdgcn_mov_dpp(__builtin_bit_cast(int, v), 0x4E, 0xF, 0xF, true)); }
__device__ __forceinline__ float dpp_hmirror(float v) { return __builtin_bit_cast(float, __builtin_amdgcn_mov_dpp(__builtin_bit_cast(int, v), 0x141, 0xF, 0xF, true)); }
__device__ __forceinline__ float dpp_mirror(float v) { return __builtin_bit_cast(float, __builtin_amdgcn_mov_dpp(__builtin_bit_cast(int, v), 0x140, 0xF, 0xF, true)); }
__device__ __forceinline__ float swz_xor16(float v) { return __builtin_bit_cast(float, __builtin_amdgcn_ds_swizzle(__builtin_bit_cast(int, v), 0x401F)); }
__device__ __forceinline__ float add_xor32(float v) {
    auto rr = __builtin_amdgcn_permlane32_swap(__builtin_bit_cast(unsigned, v), __builtin_bit_cast(unsigned, v), false, false);
    const unsigned a = rr[0], b = rr[1];
    return __builtin_bit_cast(float, a) + __builtin_bit_cast(float, b); }
__device__ __forceinline__ float wave_sum(float v) {
    v += dpp_xor1(v); v += dpp_xor2(v); v += dpp_hmirror(v); v += dpp_mirror(v); v += swz_xor16(v); return add_xor32(v);
}

#define XB_TMO      128
#define XB_XCNT(j)  (256  + 64 * (j))
#define XB_XSUB(j)  (1280 + 64 * (j))
#define XB_XGEN(j)  (2304 + 64 * (j))
#define XB_TOP      3328
#define XB_TOPGEN   3392
#define XCD_BAR_WORDS 3456
#define XB_SPIN_CAP (1u << 18)
__device__ __forceinline__ unsigned xb_ld(unsigned* p)              { return __hip_atomic_load(p, __ATOMIC_RELAXED, __HIP_MEMORY_SCOPE_AGENT); }
__device__ __forceinline__ unsigned xb_add(unsigned* p, unsigned v) { return __hip_atomic_fetch_add(p, v, __ATOMIC_RELAXED, __HIP_MEMORY_SCOPE_AGENT); }
__device__ __forceinline__ unsigned xb_xcc_id() { return (unsigned)__builtin_amdgcn_s_getreg((3 << 11) | 20) & 0xFu; }
#define XB_SPIN(cond, bar) do { unsigned _sp = 0; while (cond) { __builtin_amdgcn_s_sleep(1); \
    if ((++_sp & 255u) == 0u) { if (xb_ld(&(bar)[XB_TMO])) break; if (_sp > XB_SPIN_CAP) { atomicAdd(&(bar)[XB_TMO], 1u); break; } } } } while (0)
struct XcdBarrier { unsigned* bar; unsigned x; volatile LAS unsigned* st; };
__device__ __forceinline__ XcdBarrier xcd_barrier_post(unsigned* bar, volatile LAS unsigned* st) {
    XcdBarrier b; b.bar = bar; b.x = xb_xcc_id(); b.st = st;
    if (threadIdx.x == 0) (void)xb_add(&bar[XB_XCNT(b.x)], 1u);
    return b;
}
__device__ __forceinline__ void xcd_barrier_complete(unsigned* bar, unsigned x, unsigned& nloc, unsigned& nx) {
    const unsigned G = gridDim.x * gridDim.y * gridDim.z;
    unsigned sum, cnt, mine, sp = 0u;
    for (;;) {
        sum = 0u; cnt = 0u; mine = 0u;
#pragma unroll
        for (unsigned j = 0; j < 16; ++j) { const unsigned c = xb_ld(&bar[XB_XCNT(j)]); sum += c; cnt += (c > 0u) ? 1u : 0u; mine = (j == x) ? c : mine; }
        if (sum == G) break;
        __builtin_amdgcn_s_sleep(1);
        if ((++sp & 255u) == 0u) { if (xb_ld(&bar[XB_TMO])) break; if (sp > XB_SPIN_CAP) { atomicAdd(&bar[XB_TMO], 1u); break; } }
    }
    nloc = mine > 0u ? mine : 1u; nx = cnt > 0u ? cnt : 1u;
}
__device__ __forceinline__ void xcd_barrier(const XcdBarrier& b) {
    asm volatile("s_waitcnt vmcnt(0)" ::: "memory");
    __syncthreads();
    if (threadIdx.x == 0) {
        unsigned* bar = b.bar;
        __builtin_amdgcn_s_waitcnt(0);
        unsigned nloc = b.st[0], nx = b.st[1];
        if (nloc == 0u) { xcd_barrier_complete(bar, b.x, nloc, nx); b.st[0] = nloc; b.st[1] = nx; }
        const unsigned old = xb_add(&bar[XB_XSUB(b.x)], 1u);
        const unsigned gen = old / nloc;
        if (old + 1u == (gen + 1u) * nloc) {
            __builtin_amdgcn_fence(__ATOMIC_RELEASE, "agent");
            asm volatile("s_waitcnt vmcnt(0)" ::: "memory");
            const unsigned og = xb_add(&bar[XB_TOP], 1u);
            const unsigned tg = og / nx;
            if (og + 1u == (tg + 1u) * nx) xb_add(&bar[XB_TOPGEN], 1u);
            else XB_SPIN(xb_ld(&bar[XB_TOPGEN]) == tg, bar);
            __builtin_amdgcn_fence(__ATOMIC_ACQUIRE, "agent");
            xb_add(&bar[XB_XGEN(b.x)], 1u);
            asm volatile("s_waitcnt vmcnt(0)" ::: "memory");
        } else {
            XB_SPIN(xb_ld(&bar[XB_XGEN(b.x)]) == gen, bar);
            __builtin_amdgcn_fence(__ATOMIC_ACQUIRE, "agent");
            asm volatile("s_waitcnt vmcnt(0)" ::: "memory");
        }
    }
    __syncthreads();
}
#ifndef EPI_RES_PF
#define EPI_RES_PF 0
#endif
#ifndef PG8_L2PF_DEFAULT
#define PG8_L2PF_DEFAULT false
#endif
namespace pg8 {
constexpr int BM = 256, BK = 64, HALF = 128, HTB = HALF * BK * 2, NXCD = 8;
__host__ __device__ __forceinline__ int lds_byte(int r, int c) { const int st = (r >> 4) * 2 + (c >> 5), rr = r & 15, cc = c & 31, ob = rr * 64 + cc * 2; return st * 1024 + (ob ^ (((ob >> 9) & 1) << 5)); }
__host__ __device__ __forceinline__ void stage_rc(int b, int& R, int& C) { const int st = b / 1024, sb = b % 1024, swz = sb ^ (((sb >> 9) & 1) << 5); R = (st >> 1) * 16 + swz / 64; C = (st & 1) * 32 + (swz % 64) / 2; }
__host__ __device__ __forceinline__ int perm32(int rho) { const int n = rho >> 4, i = rho & 15; return 8 * (i >> 2) + 4 * n + (i & 3); }

struct Unit { int pm, pn; };
struct Gemm { const bf16_t* A0; const bf16_t* A1; int pn_split; int lda; int grouped; const bf16_t* Bt; int ldb; int K; int nM, nN; };
__device__ __forceinline__ const char* a_ptr(const Gemm& g, const Unit& u) {
    const bf16_t* a = (u.pn < g.pn_split) ? g.A0 : g.A1;
    return (const char*)(a + (size_t)u.pm * BM * g.lda + (g.grouped ? (u.pn >> 1) * 512 : 0));
}
__device__ __forceinline__ const char* b_ptr(const Gemm& g, const Unit& u) { return (const char*)(g.Bt + (size_t)u.pn * BM * g.ldb); }

struct StaticOrder {
    int nM, nN, nwg, G, c, WGM;
    __device__ void init(int nM_, int nN_, int G_, int c_, int wgm = 8) { nM = nM_; nN = nN_; nwg = nM * nN; G = G_; c = c_; WGM = wgm; }
    __device__ bool next(int i, Unit& u) const {
        const long L = (long)i * G + c; if (L >= nwg) return false;
        int wgid = (int)L; { const int q = nwg / NXCD, r = nwg % NXCD, xcd = wgid % NXCD, off = wgid / NXCD; wgid = (xcd < r ? xcd * (q + 1) : r * (q + 1) + (xcd - r) * q) + off; }
        const int nig = WGM * nN, gid = wgid / nig, fm = gid * WGM, gsz = (nM - fm) < WGM ? (nM - fm) : WGM;
        u.pm = fm + ((wgid % nig) % gsz); u.pn = (wgid % nig) / gsz; return true;
    }
};

template <class Epi, bool ALIGN_EPI = true, bool SP2 = true, bool STAGE_IN_MMA = false, bool L2PF = PG8_L2PF_DEFAULT>
__device__ __forceinline__ void gemm_phase(LAS unsigned char* lds, const Gemm g, const StaticOrder& S, const Epi& E) {
    const int tid = opaque_tid(), wid = __builtin_amdgcn_readfirstlane(tid >> 6), lane = tid & 63, wr = wid >> 2, wc = wid & 3, fr = lane & 15, fq = lane >> 4;
    const int K = g.K, nt = K / BK;
    unsigned voffA[2], voffB[2];
#pragma unroll
    for (int i = 0; i < 2; ++i) { int R, C; stage_rc(tid * 16 + i * 8192, R, C); const int Rb = (R & ~31) + perm32(R & 31);
        voffA[i] = (unsigned)(R * g.lda + C) * 2u; voffB[i] = (unsigned)(Rb * g.ldb + C) * 2u; }
    const size_t kstep = (size_t)(BK * 2);
    const size_t hstepA = (size_t)HALF * g.lda * 2, hstepB = (size_t)HALF * g.ldb * 2;
    const unsigned ldsw = (unsigned)wid * 1024u;
    const int wu = __builtin_amdgcn_readfirstlane(wid);
    const int aoff = lds_byte(wr * 64 + fr, fq * 8), boff = lds_byte(wc * 32 + fr, fq * 8);
#define PG8_SA(b, h) (((b) * 2 + (h)) * HTB)
#define PG8_SB(b, h) ((4 + (b) * 2 + (h)) * HTB)
#ifndef PG8_ASM_STAGE
#define PG8_ASM_STAGE 1
#endif
#if PG8_ASM_STAGE
    const unsigned ldsb = (unsigned)(size_t)lds + (unsigned)wu * 1024u;
#define PG8_STAGE(bufoff, gbase, voff) do { _Pragma("unroll") for (int _i = 0; _i < 2; ++_i) { const unsigned m0v_ = ldsb + (unsigned)(bufoff) + (unsigned)(_i * 8192); \
        asm volatile("s_mov_b32 m0, %0\n\ts_nop 0\n\tglobal_load_lds_dwordx4 %1, %2" :: "s"(m0v_), "v"((voff)[_i]), "s"((const char*)(gbase)) : "memory", "m0"); } } while (0)
#else
#define PG8_STAGE(bufoff, gbase, voff) do { _Pragma("unroll") for (int _i = 0; _i < 2; ++_i) \
        __builtin_amdgcn_global_load_lds((const unsigned*)((const char*)(gbase) + (voff)[_i]), (LAS unsigned*)(lds + (bufoff) + ldsw + _i * 8192), 16, 0, 0); } while (0)
#endif
#define PG8_LDA(dst, b, h) do { _Pragma("unroll") for (int m = 0; m < 4; ++m) _Pragma("unroll") for (int k = 0; k < 2; ++k) dst[m][k] = *(const LAS bf16x8*)(lds + PG8_SA(b, h) + aoff + m * 2048 + k * 1024); } while (0)
#define PG8_LDB(dst, b, h) do { _Pragma("unroll") for (int n = 0; n < 2; ++n) _Pragma("unroll") for (int k = 0; k < 2; ++k) dst[n][k] = *(const LAS bf16x8*)(lds + PG8_SB(b, h) + boff + n * 2048 + k * 1024); } while (0)
#ifndef PG8_STAGE_FIRST
#define PG8_STAGE_FIRST 0
#endif
#ifndef PG8_PRIO
#define PG8_PRIO 1
#endif
#define PG8_MMA(ai, bj, At, Bt) do { if (PG8_PRIO) __builtin_amdgcn_s_setprio(1); _Pragma("unroll") for (int m = 0; m < 4; ++m) _Pragma("unroll") for (int n = 0; n < 2; ++n) _Pragma("unroll") for (int k = 0; k < 2; ++k) \
        acc[ai][bj][m][n] = __builtin_amdgcn_mfma_f32_16x16x32_bf16(Bt[n][k], At[m][k], acc[ai][bj][m][n], 0, 0, 0); if (PG8_PRIO) __builtin_amdgcn_s_setprio(0); } while (0)
#define PG8_WAIT_V(n) asm volatile("s_waitcnt vmcnt(" #n ")" ::: "memory")
#define PG8_WAIT_L(n) asm volatile("s_waitcnt lgkmcnt(" #n ")" ::: "memory")
#define PG8_BAR __builtin_amdgcn_s_barrier()
#define PG8_SCHED __builtin_amdgcn_sched_barrier(0)
    Unit cur, nxt; int ui = 0;
    if (!S.next(0, cur)) return;
    f32x4 acc[2][2][4][2];
#pragma unroll
    for (int a = 0; a < 2; ++a)
#pragma unroll
        for (int b = 0; b < 2; ++b)
#pragma unroll
            for (int m = 0; m < 4; ++m)
#pragma unroll
                for (int n = 0; n < 2; ++n) acc[a][b][m][n] = (f32x4){0.f, 0.f, 0.f, 0.f};
    bf16x8 At[4][2], B0[2][2], B1[2][2];
    const char* cA = a_ptr(g, cur); const char* cB = b_ptr(g, cur);
    if constexpr (SP2) {
    PG8_STAGE(PG8_SB(0, 0), cB, voffB); PG8_STAGE(PG8_SB(0, 1), cB + hstepB, voffB); PG8_STAGE(PG8_SA(0, 0), cA, voffA); PG8_STAGE(PG8_SA(0, 1), cA + hstepA, voffA);
    if (wr == 1) PG8_BAR;
    PG8_WAIT_V(2); PG8_BAR;
    PG8_STAGE(PG8_SB(1, 0), cB + kstep, voffB); PG8_STAGE(PG8_SA(1, 0), cA + kstep, voffA); PG8_STAGE(PG8_SB(1, 1), cB + hstepB + kstep, voffB);
    PG8_WAIT_V(6); PG8_BAR;
    } else {
    PG8_STAGE(PG8_SB(0, 0), cB, voffB); PG8_STAGE(PG8_SA(0, 0), cA, voffA); PG8_STAGE(PG8_SB(0, 1), cB + hstepB, voffB); PG8_STAGE(PG8_SA(0, 1), cA + hstepA, voffA);
    if (wr == 1) PG8_BAR;
    PG8_WAIT_V(4); PG8_BAR;
    PG8_STAGE(PG8_SB(1, 0), cB + kstep, voffB); PG8_STAGE(PG8_SA(1, 0), cA + kstep, voffA); PG8_STAGE(PG8_SB(1, 1), cB + hstepB + kstep, voffB);
    PG8_WAIT_V(6); PG8_BAR;
    }
    for (;;) {
        const bool has_next = S.next(ui + 1, nxt);
        const char* nA = has_next ? a_ptr(g, nxt) : cA; const char* nB = has_next ? b_ptr(g, nxt) : cB;
        int pf_id = 0; const int pf_sh = (S.WGM == 8) ? (wu < 4 ? 6 : 5) : (wu < 4 ? 5 : 6);
        if constexpr (L2PF) pf_id = (S.WGM == 8) ? (wu < 4 ? (cur.pn & 3) : (cur.pm & 7)) : (wu < 4 ? (cur.pn & 7) : (cur.pm & 3));
        for (int t = 0; t < nt; t += 2) {
            const bool last = (t == nt - 2);
            const char* a1 = cA + (size_t)(t + 1) * kstep;
            const char* a2 = last ? nA : cA + (size_t)(t + 2) * kstep; const char* b2 = last ? nB : cB + (size_t)(t + 2) * kstep;
            const char* a3 = a2 + kstep; const char* b3 = b2 + kstep;
            if constexpr (!SP2) {
            PG8_LDB(B0, 0, 0); PG8_SCHED; PG8_LDA(At, 0, 0); PG8_STAGE(PG8_SA(1, 1), a1 + hstepA, voffA);
            PG8_WAIT_L(8); PG8_BAR; PG8_WAIT_L(0); PG8_MMA(0, 0, At, B0); PG8_BAR; PG8_SCHED;
            PG8_LDB(B1, 0, 1); PG8_STAGE(PG8_SB(0, 0), b2, voffB);
            PG8_BAR; PG8_WAIT_L(0); PG8_MMA(0, 1, At, B1); PG8_BAR;
            PG8_LDA(At, 0, 1); PG8_STAGE(PG8_SA(0, 0), a2, voffA);
            PG8_BAR; PG8_WAIT_L(0); PG8_MMA(1, 0, At, B0); PG8_BAR; PG8_SCHED;
            PG8_STAGE(PG8_SB(0, 1), b2 + hstepB, voffB);
            PG8_WAIT_V(6); PG8_BAR; PG8_MMA(1, 1, At, B1); PG8_BAR;
            PG8_LDB(B0, 1, 0); PG8_SCHED; PG8_LDA(At, 1, 0); PG8_STAGE(PG8_SA(0, 1), a2 + hstepA, voffA);
            PG8_WAIT_L(8); PG8_BAR; PG8_WAIT_L(0); PG8_MMA(0, 0, At, B0); PG8_BAR; PG8_SCHED;
            PG8_LDB(B1, 1, 1); PG8_STAGE(PG8_SB(1, 0), b3, voffB);
            PG8_BAR; PG8_WAIT_L(0); PG8_MMA(0, 1, At, B1); PG8_BAR;
            PG8_LDA(At, 1, 1); PG8_STAGE(PG8_SA(1, 0), a3, voffA);
            PG8_BAR; PG8_WAIT_L(0); PG8_MMA(1, 0, At, B0); PG8_BAR; PG8_SCHED;
            PG8_STAGE(PG8_SB(1, 1), b3 + hstepB, voffB);
            PG8_WAIT_V(6); PG8_BAR; PG8_MMA(1, 1, At, B1); PG8_BAR;
            } else if constexpr (STAGE_IN_MMA) {
            PG8_LDB(B0, 0, 0); PG8_LDB(B1, 0, 1); PG8_SCHED; PG8_LDA(At, 0, 0);
            PG8_WAIT_V(6); PG8_WAIT_L(0); PG8_BAR; PG8_MMA(0, 0, At, B0); PG8_STAGE(PG8_SA(1, 1), a1 + hstepA, voffA); PG8_MMA(0, 1, At, B1); PG8_BAR; PG8_SCHED;
            PG8_LDA(At, 0, 1);
            PG8_WAIT_V(2); PG8_WAIT_L(0); PG8_BAR; PG8_MMA(1, 0, At, B0); PG8_STAGE(PG8_SB(0, 0), b2, voffB); PG8_STAGE(PG8_SB(0, 1), b2 + hstepB, voffB); PG8_STAGE(PG8_SA(0, 0), a2, voffA); PG8_MMA(1, 1, At, B1); PG8_BAR; PG8_SCHED;
            PG8_LDB(B0, 1, 0); PG8_LDB(B1, 1, 1); PG8_SCHED; PG8_LDA(At, 1, 0);
            PG8_WAIT_V(6); PG8_WAIT_L(0); PG8_BAR; PG8_MMA(0, 0, At, B0); PG8_STAGE(PG8_SA(0, 1), a2 + hstepA, voffA); PG8_MMA(0, 1, At, B1); PG8_BAR; PG8_SCHED;
            PG8_LDA(At, 1, 1);
            PG8_WAIT_V(2); PG8_WAIT_L(0); PG8_BAR; PG8_MMA(1, 0, At, B0); PG8_STAGE(PG8_SB(1, 0), b3, voffB); PG8_STAGE(PG8_SB(1, 1), b3 + hstepB, voffB); PG8_STAGE(PG8_SA(1, 0), a3, voffA); PG8_MMA(1, 1, At, B1); PG8_BAR; PG8_SCHED;
            } else {
#if PG8_STAGE_FIRST
            PG8_STAGE(PG8_SA(1, 1), a1 + hstepA, voffA); PG8_SCHED; PG8_LDB(B0, 0, 0); PG8_LDB(B1, 0, 1); PG8_SCHED; PG8_LDA(At, 0, 0);
            PG8_WAIT_V(8); PG8_WAIT_L(0); PG8_BAR; PG8_MMA(0, 0, At, B0); PG8_MMA(0, 1, At, B1); PG8_BAR; PG8_SCHED;
            PG8_STAGE(PG8_SB(0, 0), b2, voffB); PG8_STAGE(PG8_SB(0, 1), b2 + hstepB, voffB); PG8_STAGE(PG8_SA(0, 0), a2, voffA); PG8_SCHED; PG8_LDA(At, 0, 1);
            PG8_WAIT_V(8); PG8_WAIT_L(0); PG8_BAR; PG8_MMA(1, 0, At, B0); PG8_MMA(1, 1, At, B1); PG8_BAR; PG8_SCHED;
            PG8_STAGE(PG8_SA(0, 1), a2 + hstepA, voffA); PG8_SCHED; PG8_LDB(B0, 1, 0); PG8_LDB(B1, 1, 1); PG8_SCHED; PG8_LDA(At, 1, 0);
            PG8_WAIT_V(8); PG8_WAIT_L(0); PG8_BAR; PG8_MMA(0, 0, At, B0); PG8_MMA(0, 1, At, B1); PG8_BAR; PG8_SCHED;
            PG8_STAGE(PG8_SB(1, 0), b3, voffB); PG8_STAGE(PG8_SB(1, 1), b3 + hstepB, voffB); PG8_STAGE(PG8_SA(1, 0), a3, voffA); PG8_SCHED; PG8_LDA(At, 1, 1);
            PG8_WAIT_V(8); PG8_WAIT_L(0); PG8_BAR; PG8_MMA(1, 0, At, B0); PG8_MMA(1, 1, At, B1); PG8_BAR; PG8_SCHED;
#else
#define PG8_PF(tt) do { if constexpr (L2PF) { const int tp_ = (tt) + 4 < nt ? (tt) + 4 : nt - 1; const bool isA_ = wu < 4; \
                const int r_ = (wu & 3) * 64 + opaque_lane(); const unsigned o_ = ((r_ >> pf_sh) == pf_id) ? (unsigned)r_ * ((unsigned)(isA_ ? g.lda : g.ldb) * 2u) : 0u; \
                const unsigned m0v_ = (unsigned)(size_t)lds + 131072u + (unsigned)wu * 256u; \
                asm volatile("s_mov_b32 m0, %0\n\ts_nop 0\n\tglobal_load_lds_dword %1, %2" :: "s"(m0v_), "v"(o_), "s"((isA_ ? cA : cB) + (size_t)tp_ * kstep) : "memory", "m0"); } } while (0)
#define PG8_WAIT_VP() do { if constexpr (L2PF) PG8_WAIT_V(9); else PG8_WAIT_V(8); } while (0)
            PG8_PF(t); PG8_SCHED; PG8_LDB(B0, 0, 0); PG8_LDB(B1, 0, 1); PG8_SCHED; PG8_LDA(At, 0, 0); PG8_STAGE(PG8_SA(1, 1), a1 + hstepA, voffA);
            PG8_WAIT_VP(); PG8_WAIT_L(0); PG8_BAR; PG8_MMA(0, 0, At, B0); PG8_MMA(0, 1, At, B1); PG8_BAR; PG8_SCHED;
            PG8_LDA(At, 0, 1); PG8_STAGE(PG8_SB(0, 0), b2, voffB); PG8_STAGE(PG8_SB(0, 1), b2 + hstepB, voffB); PG8_STAGE(PG8_SA(0, 0), a2, voffA);
            PG8_WAIT_VP(); PG8_WAIT_L(0); PG8_BAR; PG8_MMA(1, 0, At, B0); PG8_MMA(1, 1, At, B1); PG8_BAR; PG8_SCHED;
            PG8_PF(t + 1); PG8_SCHED; PG8_LDB(B0, 1, 0); PG8_LDB(B1, 1, 1); PG8_SCHED; PG8_LDA(At, 1, 0); PG8_STAGE(PG8_SA(0, 1), a2 + hstepA, voffA);
            PG8_WAIT_VP(); PG8_WAIT_L(0); PG8_BAR; PG8_MMA(0, 0, At, B0); PG8_MMA(0, 1, At, B1); PG8_BAR; PG8_SCHED;
            PG8_LDA(At, 1, 1); PG8_STAGE(PG8_SB(1, 0), b3, voffB); PG8_STAGE(PG8_SB(1, 1), b3 + hstepB, voffB); PG8_STAGE(PG8_SA(1, 0), a3, voffA);
            PG8_WAIT_VP(); PG8_WAIT_L(0); PG8_BAR; PG8_MMA(1, 0, At, B0); PG8_MMA(1, 1, At, B1); PG8_BAR; PG8_SCHED;
#undef PG8_PF
#undef PG8_WAIT_VP
#endif
            }
        }
        if constexpr (ALIGN_EPI) { if (wr == 0) PG8_BAR; }
        { const int te = opaque_tid(); E(acc, cur, wr, wc, te & 15, (te >> 4) & 3); }
        if (!has_next) break;
#pragma unroll
        for (int a = 0; a < 2; ++a)
#pragma unroll
            for (int b = 0; b < 2; ++b)
#pragma unroll
                for (int m = 0; m < 4; ++m)
#pragma unroll
                    for (int n = 0; n < 2; ++n) acc[a][b][m][n] = (f32x4){0.f, 0.f, 0.f, 0.f};
        cur = nxt; cA = nA; cB = nB; ++ui;
        if constexpr (ALIGN_EPI) { if (wr == 1) PG8_BAR; }
    }
    PG8_WAIT_V(0);
    if constexpr (!ALIGN_EPI) { if (wr == 0) PG8_BAR; }
    PG8_BAR;
#undef PG8_SA
#undef PG8_SB
#undef PG8_STAGE
#undef PG8_LDA
#undef PG8_LDB
#undef PG8_MMA
#undef PG8_WAIT_V
#undef PG8_WAIT_L
#undef PG8_BAR
#undef PG8_SCHED
}

__device__ __forceinline__ u32x4 pack8bf(const f32x4& a, const f32x4& b) { u32x4 w; w.x = cvt_pk_bf16(a[0], a[1]); w.y = cvt_pk_bf16(a[2], a[3]); w.z = cvt_pk_bf16(b[0], b[1]); w.w = cvt_pk_bf16(b[2], b[3]); return w; }
__device__ __forceinline__ float sumsq4(const f32x4& a) { return (a[0] * a[0] + a[1] * a[1]) + (a[2] * a[2] + a[3] * a[3]); }

struct EpiRes {
    const float* xin32; const bf16_t* xin16; float* xout32; bf16_t* xout16; unsigned char* xlo; const float* gate; const float* gm0; bf16_t* a0; const float* gm1; bf16_t* a1; float* rowss;
    unsigned pfl;
    __device__ __forceinline__ void operator()(const f32x4 (&acc)[2][2][4][2], const Unit& u, int wr, int wc, int fr, int fq) const {
        const int b = u.pm >> 4; const int row0 = u.pm * BM + wr * 64 + fr;
#if EPI_RES_PF
        if (pfl && !xin32 && XBF16 == 2) {
            const int ln_ = fr + 16 * fq; const int wv_ = __builtin_amdgcn_readfirstlane(wr * 4 + wc);
            const unsigned prow = (unsigned)(u.pm * BM + (wv_ & 1) * HALF + (wv_ >> 2) * 64 + ln_);
            const unsigned oh0 = (prow * DM + (unsigned)(u.pn * BM + ((wv_ >> 1) & 1) * 64)) * 2u, oh1 = oh0 + 256u;
            const unsigned ol = prow * DM + (unsigned)(u.pn * BM + ((wv_ >> 1) & 1) * HALF);
            const unsigned m0v = pfl + (unsigned)wv_ * 256u;
            asm volatile("s_mov_b32 m0, %0\n\ts_nop 0\n\tglobal_load_lds_dword %1, %4\n\tglobal_load_lds_dword %2, %4\n\tglobal_load_lds_dword %3, %5"
                         :: "s"(m0v), "v"(oh0), "v"(oh1), "v"(ol), "s"(xin16), "s"(xlo) : "memory", "m0");
        }
#endif
        float ss[2][4];
#pragma unroll
        for (int ai = 0; ai < 2; ++ai)
#pragma unroll
            for (int m = 0; m < 4; ++m) ss[ai][m] = 0.f;
#pragma unroll
        for (int bj = 0; bj < 2; ++bj) {
            const int col = u.pn * BM + bj * HALF + wc * 32 + 8 * fq; const int vo = b * DM + col;
            const f32x4 g0 = *(const f32x4*)(gate + vo), g1 = *(const f32x4*)(gate + vo + 4);
            f32x4 m00 = {0, 0, 0, 0}, m01 = {0, 0, 0, 0}, m10 = {0, 0, 0, 0}, m11 = {0, 0, 0, 0};
            if (a0) { m00 = *(const f32x4*)(gm0 + vo); m01 = *(const f32x4*)(gm0 + vo + 4); }
            if (a1) { m10 = *(const f32x4*)(gm1 + vo); m11 = *(const f32x4*)(gm1 + vo + 4); }
#pragma unroll
            for (int ai = 0; ai < 2; ++ai) {
                f32x4 xv[4][2];
                if (xin32) {
#pragma unroll
                    for (int m = 0; m < 4; ++m) { const size_t off = (size_t)(row0 + ai * HALF + m * 16) * DM + col; xv[m][0] = *(const f32x4*)(xin32 + off); xv[m][1] = *(const f32x4*)(xin32 + off + 4); }
                } else {
                    u32x4 xr[4]; u32x2 xl[4];
#pragma unroll
                    for (int m = 0; m < 4; ++m) { const size_t off = (size_t)(row0 + ai * HALF + m * 16) * DM + col; xr[m] = *(const u32x4*)(xin16 + off);
                        if (XBF16 == 2) xl[m] = *(const u32x2*)(xlo + off); }
#pragma unroll
                    for (int m = 0; m < 4; ++m) { if (XBF16 == 2) x8_unpack24(xr[m], xl[m], xv[m][0], xv[m][1]); else x8_unpack16(xr[m], xv[m][0], xv[m][1]); }
                }
#pragma unroll
                for (int m = 0; m < 4; ++m) {
                    const size_t off = (size_t)(row0 + ai * HALF + m * 16) * DM + col;
                    const f32x4 v0 = xv[m][0] + g0 * acc[ai][bj][m][0], v1 = xv[m][1] + g1 * acc[ai][bj][m][1];
                    if (xout32) { *(f32x4*)(xout32 + off) = v0; *(f32x4*)(xout32 + off + 4) = v1; }
                    else if (XBF16 == 2) { u32x4 hh; u32x2 ll; x8_pack24(v0, v1, hh, ll); st_stream((u32x4*)(xout16 + off), hh); st_stream((u32x2*)(xlo + off), ll); }
                    else *(u32x4*)(xout16 + off) = pack8bf(v0, v1);
                    ss[ai][m] += sumsq4(v0) + sumsq4(v1);
                    if (a0) *(u32x4*)(a0 + off) = pack8bf(v0 * m00, v1 * m01);
                    if (a1) *(u32x4*)(a1 + off) = pack8bf(v0 * m10, v1 * m11);
                }
            }
        }
        if (rowss) {
#pragma unroll
            for (int ai = 0; ai < 2; ++ai)
#pragma unroll
                for (int m = 0; m < 4; ++m) { float s = ss[ai][m]; s += swz_xor16(s); s = add_xor32(s); if (fq == 0) atomicAdd(rowss + row0 + ai * HALF + m * 16, s); }
        }
    }
};

struct EpiNull { float* sink;
    __device__ __forceinline__ void operator()(const f32x4 (&acc)[2][2][4][2], const Unit& u, int wr, int wc, int fr, int fq) const {
        f32x4 t = {0.f, 0.f, 0.f, 0.f};
#pragma unroll
        for (int ai = 0; ai < 2; ++ai)
#pragma unroll
            for (int bj = 0; bj < 2; ++bj)
#pragma unroll
                for (int m = 0; m < 4; ++m) t += acc[ai][bj][m][0] + acc[ai][bj][m][1];
        *(f32x4*)(sink + ((size_t)(blockIdx.x * 512 + threadIdx.x) * 4)) = t;
    }
};

struct EpiSwi {
    const float* rowss; const float* bias; bf16_t* act;
    __device__ __forceinline__ void operator()(const f32x4 (&acc)[2][2][4][2], const Unit& u, int wr, int wc, int fr, int fq) const {
        const int b = u.pm >> 4; const int row0 = u.pm * BM + wr * 64 + fr;
        const int vc = u.pn * BM + wc * 32 + 8 * fq; const int ac = u.pn * HALF + wc * 32 + 8 * fq;
        const float* bp = bias + (size_t)b * 11264 + vc;
        const f32x4 bg0 = *(const f32x4*)bp, bg1 = *(const f32x4*)(bp + 4), bu0 = *(const f32x4*)(bp + HALF), bu1 = *(const f32x4*)(bp + HALF + 4);
        float rsv[8];
#pragma unroll
        for (int r = 0; r < 8; ++r) rsv[r] = rowss[row0 + (r >> 2) * HALF + (r & 3) * 16];
#pragma unroll
        for (int ai = 0; ai < 2; ++ai)
#pragma unroll
            for (int m = 0; m < 4; ++m) {
                const int row = row0 + ai * HALF + m * 16;
                const float rstd = rsqrtf(rsv[ai * 4 + m] * (1.f / DM) + EPS);
                f32x4 r0, r1;
#pragma unroll
                for (int j = 0; j < 4; ++j) {
                    const float ga = acc[ai][0][m][0][j] * rstd + bg0[j], ua = acc[ai][1][m][0][j] * rstd + bu0[j];
                    const float gb = acc[ai][0][m][1][j] * rstd + bg1[j], ub = acc[ai][1][m][1][j] * rstd + bu1[j];
                    r0[j] = ga * ua * __builtin_amdgcn_rcpf(1.f + __builtin_amdgcn_exp2f(-1.4426950408889634f * ga));
                    r1[j] = gb * ub * __builtin_amdgcn_rcpf(1.f + __builtin_amdgcn_exp2f(-1.4426950408889634f * gb));
                }
                st_stream((u32x4*)(act + (size_t)row * FF + ac), pack8bf(r0, r1));
            }
    }
};

struct EpiDown {
    const float* rowss1; const float* bias; int ldbias; int pn_q0;
    unsigned char* ws; float* rsb; int rsq;
    const float2* tab;
    __device__ __forceinline__ void operator()(const f32x4 (&acc)[2][2][4][2], const Unit& u, int wr, int wc, int fr, int fq) const {
        const int b = u.pm >> 4; const int row0 = u.pm * BM + wr * 64 + fr;
        const float* bp = bias + (size_t)b * ldbias + u.pn * BM + wc * 32 + 8 * fq;
        const f32x4 b00 = *(const f32x4*)bp, b01 = *(const f32x4*)(bp + 4), b10 = *(const f32x4*)(bp + HALF), b11 = *(const f32x4*)(bp + HALF + 4);
        const bool is_q = u.pn >= pn_q0;
        if (is_q || u.pn < 2) {
            bf16_t* dst = (bf16_t*)(ws + (is_q ? WS_CQ : WS_CKV)); float* rs = rsb + (size_t)(is_q ? rsq : RS_KV) * 16384;
            const int col = (is_q ? (u.pn - pn_q0) : u.pn) * BM + wc * 32 + 8 * fq;
#pragma unroll
            for (int ai = 0; ai < 2; ++ai)
#pragma unroll
                for (int m = 0; m < 4; ++m) {
                    const int row = row0 + ai * HALF + m * 16;
                    const float rstd = rsqrtf(rowss1[row] * (1.f / DM) + EPS);
                    const f32x4 v00 = acc[ai][0][m][0] * rstd + b00, v01 = acc[ai][0][m][1] * rstd + b01, v10 = acc[ai][1][m][0] * rstd + b10, v11 = acc[ai][1][m][1] * rstd + b11;
                    *(u32x4*)(dst + (size_t)row * 512 + col) = pack8bf(v00, v01);
                    *(u32x4*)(dst + (size_t)row * 512 + col + HALF) = pack8bf(v10, v11);
                    float s = (sumsq4(v00) + sumsq4(v01)) + (sumsq4(v10) + sumsq4(v11));
                    s += swz_xor16(s); s = add_xor32(s); if (fq == 0) atomicAdd(rs + row, s);
                }
        } else if (wc == 0) {
            bf16_t* kr = (bf16_t*)(ws + WS_KR);
#pragma unroll
            for (int ai = 0; ai < 2; ++ai)
#pragma unroll
                for (int m = 0; m < 4; ++m) {
                    const int row = row0 + ai * HALF + m * 16;
                    const float rstd = rsqrtf(rowss1[row] * (1.f / DM) + EPS);
                    const f32x4 t10 = acc[ai][0][m][0] * rstd + b00, t11 = acc[ai][0][m][1] * rstd + b01, t20 = acc[ai][1][m][0] * rstd + b10, t21 = acc[ai][1][m][1] * rstd + b11;
                    const float2* tp = tab + (size_t)row * 32 + 8 * fq;
                    f32x4 o10, o11, o20, o21;
#pragma unroll
                    for (int j = 0; j < 4; ++j) { const float2 ca = tp[j], cb = tp[4 + j];
                        o10[j] = t10[j] * ca.x - t20[j] * ca.y; o20[j] = t20[j] * ca.x + t10[j] * ca.y;
                        o11[j] = t11[j] * cb.x - t21[j] * cb.y; o21[j] = t21[j] * cb.x + t11[j] * cb.y; }
                    *(u32x4*)(kr + (size_t)row * 64 + 8 * fq) = pack8bf(o10, o11);
                    *(u32x4*)(kr + (size_t)row * 64 + 32 + 8 * fq) = pack8bf(o20, o21);
                }
        }
    }
};

struct EpiUp {
    unsigned char* ws; const float* rsb; int rsq; int pn_q0; const float2* tab;
    __device__ __forceinline__ void operator()(const f32x4 (&acc)[2][2][4][2], const Unit& u, int wr, int wc, int fr, int fq) const {
        const int row0 = u.pm * BM + wr * 64 + fr;
        const bool is_q = u.pn >= pn_q0; const int p = is_q ? u.pn - pn_q0 : u.pn;
        const float* rs = rsb + (size_t)(is_q ? rsq : RS_KV) * 16384;
        if (!(is_q && p >= 8)) {
            bf16_t* dst = (bf16_t*)(ws + (is_q ? WS_QN : (p < 8 ? WS_KN : WS_V)));
            const int col = (p & 7) * BM + wc * 32 + 8 * fq;
#pragma unroll
            for (int ai = 0; ai < 2; ++ai)
#pragma unroll
                for (int m = 0; m < 4; ++m) {
                    const int row = row0 + ai * HALF + m * 16;
                    const float rstd = rsqrtf(rs[row] * (1.f / 512.f) + EPS);
                    st_stream((u32x4*)(dst + (size_t)row * DM + col), pack8bf(acc[ai][0][m][0] * rstd, acc[ai][0][m][1] * rstd));
                    st_stream((u32x4*)(dst + (size_t)row * DM + col + HALF), pack8bf(acc[ai][1][m][0] * rstd, acc[ai][1][m][1] * rstd));
                }
        } else {
            bf16_t* qr = (bf16_t*)(ws + WS_QR);
            const int hh = 4 * (p - 8) + wc;
#pragma unroll
            for (int ai = 0; ai < 2; ++ai)
#pragma unroll
                for (int m = 0; m < 4; ++m) {
                    const int row = row0 + ai * HALF + m * 16;
                    const float rstd = rsqrtf(rs[row] * (1.f / 512.f) + EPS);
                    const f32x4 t10 = acc[ai][0][m][0] * rstd, t11 = acc[ai][0][m][1] * rstd, t20 = acc[ai][1][m][0] * rstd, t21 = acc[ai][1][m][1] * rstd;
                    const float2* tp = tab + (size_t)row * 32 + 8 * fq;
                    f32x4 o10, o11, o20, o21;
#pragma unroll
                    for (int j = 0; j < 4; ++j) { const float2 ca = tp[j], cb = tp[4 + j];
                        o10[j] = t10[j] * ca.x - t20[j] * ca.y; o20[j] = t20[j] * ca.x + t10[j] * ca.y;
                        o11[j] = t11[j] * cb.x - t21[j] * cb.y; o21[j] = t21[j] * cb.x + t11[j] * cb.y; }
                    st_stream((u32x4*)(qr + (size_t)row * 1024 + hh * 64 + 8 * fq), pack8bf(o10, o11));
                    st_stream((u32x4*)(qr + (size_t)row * 1024 + hh * 64 + 32 + 8 * fq), pack8bf(o20, o21));
                }
        }
    }
};
}
namespace att {
constexpr int D = 128, DQK = 192, NW = 8, QBLK = 32, KVBLK = 64, QB = NW * QBLK;
constexpr int LDQ = 2048, LDQR = 1024, LDKR = 64;
constexpr float SCALE = 0.07216878364870322f;
constexpr float THR = 8.f;
constexpr int KROW = 400;
constexpr int SHM_V = KVBLK * D * 2, SHM_K = KVBLK * KROW;
constexpr int NVS = 3;
constexpr int K_LDS_OFF = NVS * SHM_V, WS_LDS_OFF = K_LDS_OFF + 2 * SHM_K;
constexpr int QR_LDS_OFF = WS_LDS_OFF + NW * 64 * 4;
constexpr int ATT_LDS_BYTES = QR_LDS_OFF + NW * 4096;
static_assert(ATT_LDS_BYTES <= MISC_OFF, "attention LDS map");
#define SBAR() __builtin_amdgcn_sched_barrier(0)
__device__ __forceinline__ int v_st(int k, int c) { const int kk = (k & ~0xC) | ((k & 4) << 1) | ((k & 8) >> 1); return ((kk >> 3) * 4 + (c >> 5)) * 512 + ((kk & 7) * 32 + (c & 31)) * 2; }
__device__ __forceinline__ int v_rd_base(int lane) { return ((lane & 3) << 3) | (((lane >> 2) & 3) << 6) | (((lane >> 4) & 1) << 5) | (((lane >> 5) & 1) << 8); }
constexpr int v_rd_off(int d0, int ks, int half) { return d0 * 512 + ks * 4096 + half * 2048; }
__device__ __forceinline__ int crow(int r, int hi) { return (r & 3) + 8 * (r >> 2) + 4 * hi; }
__device__ __forceinline__ unsigned cvtpk(float lo, float hi) { unsigned r; asm volatile("v_cvt_pk_bf16_f32 %0, %1, %2" : "=v"(r) : "v"(lo), "v"(hi)); return r; }
__device__ __forceinline__ bf16x8 load8(const bf16_t* p) { return *reinterpret_cast<const bf16x8*>(p); }
__device__ __forceinline__ void mask_tile(f32x16& p0, f32x16& p1, int dq) {
    const float NEG = -__builtin_inff();
#pragma unroll
    for (int r = 0; r < 16; ++r) {
        const int c = (r & 3) + 8 * (r >> 2);
        if (dq - c < 0) p0[r] = NEG;
        if (dq - c - 32 < 0) p1[r] = NEG;
    }
}
__device__ __forceinline__ void partialSM(f32x16& p0, f32x16& p1, float& m_reg, float& mn, float& alpha) {
    float pmax = p0[0]; for (int r = 1; r < 16; ++r) pmax = fmaxf(pmax, p0[r]); for (int r = 0; r < 16; ++r) pmax = fmaxf(pmax, p1[r]);
    { auto rr = __builtin_amdgcn_permlane32_swap(__float_as_uint(pmax), __float_as_uint(pmax), false, false);
      pmax = fmaxf(__uint_as_float(rr[0]), __uint_as_float(rr[1])); }
    constexpr float C2 = 1.4426950408889634f * SCALE;
    if (__builtin_expect(__all((pmax - m_reg) * SCALE <= THR), 1)) { mn = m_reg; alpha = 1.f; }
    else { mn = fmaxf(m_reg, pmax); alpha = __builtin_amdgcn_exp2f((m_reg - mn) * C2); m_reg = mn; }
    const float mnL = -mn * C2;
    for (int r = 0; r < 16; ++r) p0[r] = fmaf(p0[r], C2, mnL); for (int r = 0; r < 16; ++r) p1[r] = fmaf(p1[r], C2, mnL);
    for (int r = 0; r < 16; ++r) p0[r] = __builtin_amdgcn_exp2f(p0[r]);
}
__device__ __forceinline__ void finishSM(f32x16& p0, f32x16& p1, float alpha, float& l_reg, bf16x8& pa0, bf16x8& pa1, bf16x8& pa2, bf16x8& pa3) {
    for (int r = 0; r < 16; ++r) p1[r] = __builtin_amdgcn_exp2f(p1[r]);
    float ps = 0; for (int r = 0; r < 16; ++r) ps += p0[r]; for (int r = 0; r < 16; ++r) ps += p1[r];
    { auto rr = __builtin_amdgcn_permlane32_swap(__float_as_uint(ps), __float_as_uint(ps), false, false);
      ps = __uint_as_float(rr[0]) + __uint_as_float(rr[1]); }
    l_reg = l_reg * alpha + ps;
#define PK4(P, B_, OUT) do { unsigned a0 = cvtpk(P[B_+0], P[B_+1]), a1 = cvtpk(P[B_+2], P[B_+3]);                          \
        unsigned b0 = cvtpk(P[B_+4], P[B_+5]), b1 = cvtpk(P[B_+6], P[B_+7]);                                             \
        auto r0 = __builtin_amdgcn_permlane32_swap(a0, b0, false, false); auto r1 = __builtin_amdgcn_permlane32_swap(a1, b1, false, false); \
        u32x4 w = {r0[0], r1[0], r0[1], r1[1]}; OUT = *reinterpret_cast<bf16x8*>(&w); } while (0)
    PK4(p0, 0, pa0); PK4(p0, 8, pa1); PK4(p1, 0, pa2); PK4(p1, 8, pa3);
#undef PK4
}
template <int KB>
__device__ __forceinline__ void qkt(f32x16& p0, f32x16& p1, const char* K_lds, int r32, int hi, const bf16x8* qr, const char* qrl) {
    p0 = f32x16{}; p1 = f32x16{};
    const int kb0 = (int)(uintptr_t)K_lds + r32 * KROW + hi * 16;
    const int qb = (int)(uintptr_t)qrl;
    bf16x8 ka[12], kc[12], qq[4];
#define QK_LDR(dst, base, off) asm volatile("ds_read_b128 %0, %1 offset:%2" : "=&v"(dst) : "v"(base), "i"(off) : "memory")
#define QK_RD(d0) do { QK_LDR(ka[d0], kb0, KB * SHM_K + (d0) * 32); QK_LDR(kc[d0], kb0, KB * SHM_K + (d0) * 32 + 32 * KROW); \
        if ((d0) >= 8) QK_LDR(qq[(d0) >= 8 ? (d0) - 8 : 0], qb, ((d0) >= 8 ? (d0) - 8 : 0) * 1024); } while (0)
#define QK_N1(j) ((j) <= 11 ? 2 + ((j) >= 8 ? 1 : 0) : 0)
#define QK_STEP(d0) do { if ((d0) + 3 < 12) QK_RD((d0) + 3 < 12 ? (d0) + 3 : 0); \
        if ((d0) >= 8) asm volatile("s_waitcnt lgkmcnt(%3)" : "+v"(ka[d0]), "+v"(kc[d0]), "+v"(qq[(d0) >= 8 ? (d0) - 8 : 0]) : "i"(QK_N1((d0) + 1) + QK_N1((d0) + 2) + QK_N1((d0) + 3)) : "memory"); \
        else asm volatile("s_waitcnt lgkmcnt(%2)" : "+v"(ka[d0]), "+v"(kc[d0]) : "i"(QK_N1((d0) + 1) + QK_N1((d0) + 2) + QK_N1((d0) + 3)) : "memory"); \
        { const bf16x8 q = (d0) < 8 ? qr[(d0) < 8 ? (d0) : 0] : qq[(d0) >= 8 ? (d0) - 8 : 0]; \
          p0 = __builtin_amdgcn_mfma_f32_32x32x16_bf16(ka[d0], q, p0, 0, 0, 0); p1 = __builtin_amdgcn_mfma_f32_32x32x16_bf16(kc[d0], q, p1, 0, 0, 0); } } while (0)
    QK_RD(0); QK_RD(1); QK_RD(2);
    QK_STEP(0); QK_STEP(1); QK_STEP(2); QK_STEP(3); QK_STEP(4); QK_STEP(5); QK_STEP(6); QK_STEP(7); QK_STEP(8); QK_STEP(9); QK_STEP(10); QK_STEP(11);
#undef QK_STEP
#undef QK_N1
#undef QK_RD
#undef QK_LDR
}
__device__ __forceinline__ void pv_tile(f32x16* o, int vb, bf16x8 pa0, bf16x8 pa1, bf16x8 pa2, bf16x8 pa3) {
#define TRRD(dst, off) asm volatile("ds_read_b64_tr_b16 %0, %1 offset:%2" : "=&v"(dst) : "v"(vb), "i"(off) : "memory")
#define PV_RD(d0, S_) do { constexpr int b_ = v_rd_off(d0, 0, 0); \
        TRRD(S_##l0, b_); TRRD(S_##h0, b_ + 2048); TRRD(S_##l1, b_ + 4096); TRRD(S_##h1, b_ + 6144); TRRD(S_##l2, b_ + 8192); TRRD(S_##h2, b_ + 10240); TRRD(S_##l3, b_ + 12288); TRRD(S_##h3, b_ + 14336); } while (0)
#define PV_MM(d0, S_) do { \
        o[d0] = __builtin_amdgcn_mfma_f32_32x32x16_bf16(pa0, (bf16x8){S_##l0[0], S_##l0[1], S_##l0[2], S_##l0[3], S_##h0[0], S_##h0[1], S_##h0[2], S_##h0[3]}, o[d0], 0, 0, 0);   \
        o[d0] = __builtin_amdgcn_mfma_f32_32x32x16_bf16(pa1, (bf16x8){S_##l1[0], S_##l1[1], S_##l1[2], S_##l1[3], S_##h1[0], S_##h1[1], S_##h1[2], S_##h1[3]}, o[d0], 0, 0, 0);   \
        o[d0] = __builtin_amdgcn_mfma_f32_32x32x16_bf16(pa2, (bf16x8){S_##l2[0], S_##l2[1], S_##l2[2], S_##l2[3], S_##h2[0], S_##h2[1], S_##h2[2], S_##h2[3]}, o[d0], 0, 0, 0);   \
        o[d0] = __builtin_amdgcn_mfma_f32_32x32x16_bf16(pa3, (bf16x8){S_##l3[0], S_##l3[1], S_##l3[2], S_##l3[3], S_##h3[0], S_##h3[1], S_##h3[2], S_##h3[3]}, o[d0], 0, 0, 0); } while (0)
#define PV_WAIT(n, S_) asm volatile("s_waitcnt lgkmcnt(%8)" : "+v"(S_##l0), "+v"(S_##h0), "+v"(S_##l1), "+v"(S_##h1), "+v"(S_##l2), "+v"(S_##h2), "+v"(S_##l3), "+v"(S_##h3) : "i"(n) : "memory")
    s16x4 Al0, Al1, Al2, Al3, Ah0, Ah1, Ah2, Ah3, Bl0, Bl1, Bl2, Bl3, Bh0, Bh1, Bh2, Bh3;
    PV_RD(0, A); PV_RD(1, B); PV_WAIT(8, A); PV_MM(0, A);
    PV_RD(2, A); PV_WAIT(8, B); PV_MM(1, B);
    PV_RD(3, B); PV_WAIT(8, A); PV_MM(2, A);
    PV_WAIT(0, B); PV_MM(3, B);
#undef PV_WAIT
#undef PV_MM
#undef PV_RD
#undef TRRD
}

struct BlockRef { unsigned char* wsb; int tok0, row0, h, P0; };
#define T_QN(R_) ((const bf16_t*)((R_).wsb + WS_QN) + (size_t)(R_).row0 * LDQ + (R_).h * 128)
#define T_QR(R_) ((const bf16_t*)((R_).wsb + WS_QR) + (size_t)(R_).row0 * LDQR + (R_).h * 64)
#define T_KN(R_) ((const bf16_t*)((R_).wsb + WS_KN) + (size_t)(R_).tok0 * LDQ + (R_).h * 128)
#define T_KR(R_) ((const bf16_t*)((R_).wsb + WS_KR) + (size_t)(R_).tok0 * LDKR)
#define T_V(R_)  ((const bf16_t*)((R_).wsb + WS_V) + (size_t)(R_).tok0 * LDQ + (R_).h * 128)
#define T_O(R_)  ((bf16_t*)((R_).wsb + WS_O) + (size_t)(R_).row0 * LDQ + (R_).h * 128)
struct Seam { bf16x8 qr[8]; };
#define VMW() asm volatile("s_waitcnt vmcnt(0)" ::: "memory")
#define DMA_TILE(k0, kbf, vslot) do { _Pragma("unroll") for (int i_ = 0; i_ < 4; ++i_) if (i_ < 3 || wid == 0) \
            __builtin_amdgcn_global_load_lds((const unsigned*)(cur.wsb + (size_t)kdo[i_] + (size_t)(k0) * kds[i_]), (LAS unsigned*)(lds + K_LDS_OFF + (kbf) * SHM_K + (wid + 8 * i_) * 1024), 16, 0, 0); \
        _Pragma("unroll") for (int i_ = 0; i_ < 2; ++i_) \
            __builtin_amdgcn_global_load_lds((const unsigned*)(cur.wsb + (size_t)vdo[i_] + (size_t)(k0) * 4096), (LAS unsigned*)(lds + (vslot) * SHM_V + (wid * 2 + i_) * 1024), 16, 0, 0); } while (0)
#define QLOAD(R_) do { _Pragma("unroll") for (int d0 = 0; d0 < 8; ++d0) S.qr[d0] = load8(T_QN(R_) + (size_t)(wid * QBLK + r32) * LDQ + d0 * 16 + hi * 8); \
                       _Pragma("unroll") for (int d0 = 0; d0 < 4; ++d0) *(bf16x8*)(qrl + d0 * 1024) = load8(T_QR(R_) + (size_t)(wid * QBLK + r32) * LDQR + d0 * 16 + hi * 8); } while (0)

__device__ __forceinline__ void block(const BlockRef& cur, char* lds) {
    const int tid = opaque_tid(), wid = __builtin_amdgcn_readfirstlane(tid >> 6), lane = tid & 63, r32 = lane & 31, hi = lane >> 5;
    const int NT = cur.P0 / KVBLK + QB / KVBLK;
    const int qlo = cur.P0 + wid * QBLK, qm = qlo + r32 - 4 * hi;
    char* V_lds = lds; char* K_lds = lds + K_LDS_OFF;
    float* ws = (float*)(lds + WS_LDS_OFF) + wid * 64; float* li_l = ws, * al_l = ws + 32;
    Seam S;
    unsigned kdo[4], kds[4], vdo[2];
#pragma unroll
    for (int i = 0; i < 4; ++i) { const int L = (wid + 8 * i) * 1024 + lane * 16, row = (L / KROW) & 63, pos = L % KROW, c = pos < 384 ? pos >> 4 : 0;
        const bool rope = c >= 16;
        kdo[i] = rope ? (unsigned)(WS_KR + ((size_t)(cur.tok0 + row) * LDKR + (c - 16) * 8) * 2) : (unsigned)(WS_KN + ((size_t)(cur.tok0 + row) * LDQ + cur.h * 128 + c * 8) * 2);
        kds[i] = rope ? (unsigned)(LDKR * 2) : (unsigned)(LDQ * 2); }
#pragma unroll
    for (int i = 0; i < 2; ++i) { const int L = (wid * 2 + i) * 1024 + lane * 16, st = L >> 9, in = L & 511, kk = (st >> 2) * 8 + (in >> 6), k = (kk & ~0xC) | ((kk & 4) << 1) | ((kk & 8) >> 1), col = (st & 3) * 32 + ((in & 63) >> 1);
        vdo[i] = (unsigned)(WS_V + ((size_t)(cur.tok0 + k) * LDQ + cur.h * 128 + col) * 2); }
    const int vb0 = (int)(uintptr_t)V_lds + v_rd_base(lane);
    char* qrl = lds + QR_LDS_OFF + wid * 4096 + lane * 16;
    if (wid >= 4) __builtin_amdgcn_s_setprio(1);
    QLOAD(cur);
    DMA_TILE(0, 0, 0);
    __syncthreads();
    float m_reg = -1e30f, l_reg = 0; f32x16 o[4] = {};
    f32x16 pA0, pA1, pB0, pB1; float mnA, mnB, alA, alB; bf16x8 pa0, pa1, pa2, pa3;
#define RESC(a) do { if (__any((a) < 1.f)) { if (hi == 0) al_l[r32] = (a); asm volatile("s_waitcnt lgkmcnt(0)" ::: "memory");              \
                     for (int d_ = 0; d_ < 4; ++d_) for (int r = 0; r < 16; ++r) o[d_][r] *= al_l[crow(r, hi)]; } } while (0)
#define KBASE(t) ((t) * KVBLK)
#define MASKT(P0_, P1_, t) do { const int kb_ = KBASE(t); if (kb_ + KVBLK - 1 > qlo) { asm volatile("" ::: "memory"); mask_tile(P0_, P1_, qm - kb_); } } while (0)
    int vs_prev = 0, vs_cur = 1, vs_next = 2;
    DMA_TILE(KBASE(1), 1, 1);
    qkt<0>(pA0, pA1, K_lds, r32, hi, S.qr, qrl);
    MASKT(pA0, pA1, 0); partialSM(pA0, pA1, m_reg, mnA, alA);
    __syncthreads();
#define HALF_STEP(PX0, PX1, mnX, alX, PY0, PY1, alY, t, KB) do {                                                             \
        if ((t) + 1 < NT) DMA_TILE(KBASE((t) + 1), (KB) ^ 1, vs_next);                                                         \
        qkt<KB>(PX0, PX1, K_lds, r32, hi, S.qr, qrl);                                                                           \
        finishSM(PY0, PY1, alY, l_reg, pa0, pa1, pa2, pa3);                                                                      \
        pv_tile(o, vb0 + vs_prev * SHM_V, pa0, pa1, pa2, pa3);                                                                   \
        MASKT(PX0, PX1, (t)); partialSM(PX0, PX1, m_reg, mnX, alX); RESC(alX);                                                   \
        { const int tmp_ = vs_prev; vs_prev = vs_cur; vs_cur = vs_next; vs_next = tmp_; }                                        \
        __syncthreads(); } while (0)
    for (int t = 1; t + 1 < NT; t += 2) {
        HALF_STEP(pB0, pB1, mnB, alB, pA0, pA1, alA, t, 1);
        HALF_STEP(pA0, pA1, mnA, alA, pB0, pB1, alB, t + 1, 0);
    }
    HALF_STEP(pB0, pB1, mnB, alB, pA0, pA1, alA, NT - 1, 1);
    finishSM(pB0, pB1, alB, l_reg, pa0, pa1, pa2, pa3);
    pv_tile(o, vb0 + vs_prev * SHM_V, pa0, pa1, pa2, pa3);
#undef HALF_STEP
    if (hi == 0) li_l[r32] = l_reg; asm volatile("s_waitcnt lgkmcnt(0)" ::: "memory");
    float rli[16];
#pragma unroll
    for (int r = 0; r < 16; ++r) rli[r] = __builtin_amdgcn_rcpf(li_l[crow(r, hi)]);
    bf16_t* Ow = T_O(cur) + (size_t)(wid * QBLK) * LDQ;
    char* ost = lds + QR_LDS_OFF + wid * 4096;
#pragma unroll
    for (int pass = 0; pass < 2; ++pass) {
#pragma unroll
        for (int r8 = 0; r8 < 8; ++r8) { const int r = pass * 8 + r8, rl = crow(r, hi) - 16 * pass;
#pragma unroll
            for (int d0 = 0; d0 < 4; ++d0) { const float v = o[d0][r] * rli[r]; const float vn = dpp_xor1(v);
                if ((r32 & 1) == 0) *(unsigned*)(ost + rl * 256 + (d0 * 32 + r32) * 2) = cvtpk(v, vn); } }
        asm volatile("s_waitcnt lgkmcnt(0)" ::: "memory");
#pragma unroll
        for (int i = 0; i < 4; ++i) { const int c = lane + 64 * i; const u32x4 w = *(const u32x4*)(ost + c * 16);
            *(u32x4*)(Ow + (size_t)(16 * pass + (c >> 4)) * LDQ + (c & 15) * 8) = w; }
        asm volatile("s_waitcnt lgkmcnt(0)" ::: "memory");
    }
    __builtin_amdgcn_s_setprio(0);
    __syncthreads();
#undef RESC
#undef KBASE
#undef MASKT
}
#undef VMW
#undef QLOAD
#undef DMA_TILE

__device__ __forceinline__ void attn_phase(char* lds, unsigned char* wsb, int vcu, int G) {
    constexpr int total = 512;
    for (int L = vcu; L < total; L += G) {
        for (int pass = 0; pass < 2; ++pass) {
            const int bh = L >> 3, x = L & 7, b = bh >> 4, h = bh & 15, qb = pass ? 15 - x : x;
            BlockRef cur; cur.wsb = wsb; cur.tok0 = b * 4096; cur.row0 = b * 4096 + qb * QB; cur.h = h; cur.P0 = qb * QB;
            block(cur, lds);
        }
    }
}
#undef T_QN
#undef T_QR
#undef T_KN
#undef T_KR
#undef T_V
#undef T_O
#undef SBAR
}
#ifndef PROBE_REP
#define PROBE_REP 0
#endif
#ifndef L2PF_FFN1
#define L2PF_FFN1 false
#endif
#ifndef L2PF_FFN2
#define L2PF_FFN2 false
#endif
#ifndef FFN1_SIM
#define FFN1_SIM false
#endif
#ifndef FFN1_SP2
#define FFN1_SP2 true
#endif
#ifndef EPI_ALIGN_RES
#define EPI_ALIGN_RES true
#endif
struct Args { const void* in[25]; float* out; unsigned char* ws; int ph_lo, ph_hi; };
struct Frame {
    LAS unsigned char* lds; volatile LAS unsigned* MISC; gu32* ctl; unsigned char* ws;
    int vcu, G;
    const Args* a;
    float* xw;
    float* rs;
    float* modv; float* kvmod;
    float* dv; float2* tab;
};
__device__ const double kInvFreqTurns[32] = {
1.59154943091895346e-01, 1.19349370211248862e-01, 8.94994016088910133e-02, 6.71150830052272551e-02, 5.03292121044870353e-02, 3.77415847174197711e-02, 2.83021958306233987e-02, 2.12236527647776604e-02,
1.59154943091895339e-02, 1.19349370211248862e-02, 8.94994016088910237e-03, 6.71150830052272534e-03, 5.03292121044870370e-03, 3.77415847174197719e-03, 2.83021958306233987e-03, 2.12236527647776622e-03,
1.59154943091895356e-03, 1.19349370211248849e-03, 8.94994016088910237e-04, 6.71150830052272599e-04, 5.03292121044870326e-04, 3.77415847174197741e-04, 2.83021958306233954e-04, 2.12236527647776605e-04,
1.59154943091895351e-04, 1.19349370211248862e-04, 8.94994016088910182e-05, 6.71150830052272545e-05, 5.03292121044870354e-05, 3.77415847174197768e-05, 2.83021958306233961e-05, 2.12236527647776592e-05};

__device__ __forceinline__ void tr_item(const float* W, int ldw, int col0, int k0, bf16_t* dst, int ldd, int drow0, const float* kscale, LAS float* scr, int lane) {
#pragma unroll 8
    for (int i = 0; i < 32; ++i) { const int kk = 2 * i + (lane >> 5); const float* wp_ = W + (size_t)(k0 + kk) * ldw + col0 + (lane & 31); float v = NT_LOADS0 ? __builtin_nontemporal_load(wp_) : *wp_; if (kscale) v *= kscale[k0 + kk]; scr[kk * 33 + (lane & 31)] = v; }
    LDS_WAIT(); asm volatile("" ::: "memory");
    const int c = lane & 7;
#pragma unroll
    for (int j = 0; j < 4; ++j) { const int n = (lane >> 3) + 8 * j; const LAS float* s = scr + (8 * c) * 33 + n;
        u32x4 o; o.x = pk2(s[0 * 33], s[1 * 33]); o.y = pk2(s[2 * 33], s[3 * 33]); o.z = pk2(s[4 * 33], s[5 * 33]); o.w = pk2(s[6 * 33], s[7 * 33]);
        *(GAS u32x4*)(dst + (size_t)(drow0 + n) * ldd + k0 + 8 * c) = o; }
    LDS_WAIT(); asm volatile("" ::: "memory");
}
__device__ __forceinline__ void modgemv_item(const float* c, const float* W, int N, const float* bias, float* out, int n0, int kc, LAS float* scr, int lane) {
    const int kb = kc * 256;
#pragma unroll
    for (int j = 0; j < 16; ++j) { const int e = lane + 64 * j; const int b = e >> 8, kk = e & 255; const float v = c[b * 2048 + kb + kk]; scr[e] = v / (1.f + __expf(-v)); }
    LDS_WAIT(); asm volatile("" ::: "memory");
    f32x4 a0 = {0, 0, 0, 0}, a1 = a0, a2 = a0, a3 = a0;
    const float* wp = W + (size_t)kb * N + n0 + 4 * lane;
#pragma unroll 8
    for (int kk = 0; kk < 256; ++kk) { const f32x4 w = NT_LOADS0 ? __builtin_nontemporal_load((const f32x4*)(wp + (size_t)kk * N)) : *(const f32x4*)(wp + (size_t)kk * N);
        a0 += w * scr[kk]; a1 += w * scr[256 + kk]; a2 += w * scr[512 + kk]; a3 += w * scr[768 + kk]; }
    if (kc == 0) { const f32x4 bb = *(const f32x4*)(bias + n0 + 4 * lane); a0 += bb; a1 += bb; a2 += bb; a3 += bb; }
    float* o = out + n0 + 4 * lane;
#pragma unroll
    for (int j = 0; j < 4; ++j) { atomicAdd(o + j, a0[j]); atomicAdd(o + N + j, a1[j]); atomicAdd(o + 2 * N + j, a2[j]); atomicAdd(o + 3 * N + j, a3[j]); }
    LDS_WAIT(); asm volatile("" ::: "memory");
}
__device__ __forceinline__ void ph0_prologue(Frame& F) {
    const int tid = opaque_tid(), lane = tid & 63, wave = __builtin_amdgcn_readfirstlane(tid >> 6);
    LAS float* scr = (LAS float*)(F.lds + wave * 16384);
    const int gw = F.vcu * NWAVES + wave, NGW = F.G * NWAVES;
    unsigned char* ws = F.ws;
    constexpr int N_MG = 208 * 8, N_F1 = 32 * 352, N_F2 = 88 * 64, N_PL = 128, N_DKV = 512, N_KR = 64, N_DQ = 512, N_UK = 512, N_UQ = 768, N_WO = 2048, N_Z = 192, N_R = 8192;
    constexpr int NITEMS = N_MG + 4 * N_F1 + 4 * N_F2 + 8 * N_PL + N_DKV + N_KR + 2 * N_DQ + 2 * N_UK + 2 * N_UQ + 2 * N_WO + N_Z + N_R;
    for (int rep0 = 0; rep0 < (PROBE_REP == 7 ? 2 : 1); ++rep0)
    for (int it = gw; it < NITEMS; it += NGW) {
        int r = it;
        if (rep0 == 1 && (r < N_MG || r >= NITEMS - N_R)) continue;
        if (r < N_MG) { const int cb = r >> 3, kc = r & 7;
            if (cb < 192) { const int l = cb / 48, n0 = (cb % 48) * 256; modgemv_item(((const float*)F.a->in[1]), ((const float*)F.a->in[3]) + (size_t)l * 2048 * 12288, 12288, ((const float*)F.a->in[4]) + l * 12288, F.modv + (size_t)l * 4 * 12288, n0, kc, scr, lane); }
            else { const int n0 = (cb - 192) * 256; modgemv_item(((const float*)F.a->in[1]), ((const float*)F.a->in[9]), 4096, ((const float*)F.a->in[10]), F.kvmod, n0, kc, scr, lane); }
            continue; } r -= N_MG;
        if (r < 4 * N_F1) { const int l = r / N_F1, q = r % N_F1, kb = q / 352, nb = q % 352, tile = nb >> 3, qq = nb & 7;
            const float* src = ((qq >> 2) ? ((const float*)F.a->in[22]) : ((const float*)F.a->in[21])) + (size_t)l * 2048 * 5632;
            tr_item(src, 5632, tile * 128 + (qq & 3) * 32, kb * 64, (bf16_t*)(ws + WS_WFFN1 + l * SZ_WFFN1), 2048, nb * 32, nullptr, scr, lane); continue; } r -= 4 * N_F1;
        if (r < 4 * N_F2) { const int l = r / N_F2, q = r % N_F2, kb = q / 64, nb = q % 64;
            tr_item(((const float*)F.a->in[23]) + (size_t)l * 5632 * 2048, 2048, nb * 32, kb * 64, (bf16_t*)(ws + WS_WFFN2 + l * SZ_WFFN2), 5632, nb * 32, nullptr, scr, lane); continue; } r -= 4 * N_F2;
        if (r < 8 * N_PL) { const int lg = r / N_PL, q = r % N_PL, kb = q / 16, nb = q % 16, l = lg >> 2, g = lg & 3;
            tr_item(((const float*)F.a->in[7]) + (size_t)lg * 512 * 512, 512, nb * 32, kb * 64, (bf16_t*)(ws + WS_WPOOL + l * SZ_WPOOL), 512, g * 512 + nb * 32, nullptr, scr, lane); continue; } r -= 8 * N_PL;
        if (r < N_DKV) { const int kb = r / 16, nb = r % 16; tr_item(((const float*)F.a->in[12]), 512, nb * 32, kb * 64, (bf16_t*)(ws + WS_WD2), 2048, nb * 32, nullptr, scr, lane); continue; } r -= N_DKV;
        if (r < N_KR) { const int kb = r / 2, nb = r % 2; tr_item(((const float*)F.a->in[16]), 64, nb * 32, kb * 64, (bf16_t*)(ws + WS_WD2), 2048, 512 + nb * 128, nullptr, scr, lane); continue; } r -= N_KR;
        if (r < 2 * N_DQ) { const int j = r / N_DQ, q = r % N_DQ, kb = q / 16, nb = q % 16;
            tr_item(((const float*)F.a->in[17]) + (size_t)j * 2048 * 512, 512, nb * 32, kb * 64, (bf16_t*)(ws + (j ? WS_WD3 : WS_WD2)), 2048, (j ? 0 : 768) + nb * 32, nullptr, scr, lane); continue; } r -= 2 * N_DQ;
        if (r < 2 * N_UK) { const int j = r / N_UK, q = r % N_UK, kb = q / 64, nb = q % 64;
            tr_item(j ? ((const float*)F.a->in[15]) : ((const float*)F.a->in[14]), 2048, nb * 32, kb * 64, (bf16_t*)(ws + WS_WU2), 512, j * 2048 + nb * 32, ((const float*)F.a->in[13]), scr, lane); continue; } r -= 2 * N_UK;
        if (r < 2 * N_UQ) { const int j = r / N_UQ, q = r % N_UQ, kb = q / 96, db = q % 96; int col0, drow;
            if (db < 64) { col0 = (db >> 2) * 192 + (db & 3) * 32; drow = db * 32; }
            else { const int e = db - 64, tt = e >> 3, r8 = e & 7, bj = r8 >> 2, wcp = r8 & 3; col0 = (4 * tt + wcp) * 192 + 128 + bj * 32; drow = 2048 + e * 32; }
            tr_item(((const float*)F.a->in[19]) + (size_t)j * 512 * 3072, 3072, col0, kb * 64, (bf16_t*)(ws + (j ? WS_WU3 : WS_WU2)), 512, (j ? 0 : 4096) + drow, ((const float*)F.a->in[18]) + j * 512, scr, lane); continue; } r -= 2 * N_UQ;
        if (r < 2 * N_WO) { const int j = r / N_WO, q = r % N_WO, kb = q / 64, nb = q % 64;
            tr_item(((const float*)F.a->in[20]) + (size_t)j * 2048 * 2048, 2048, nb * 32, kb * 64, (bf16_t*)(ws + WS_WO + j * SZ_WO), 2048, nb * 32, nullptr, scr, lane); continue; } r -= 2 * N_WO;
        if (r < N_Z) { const int row = r < 96 ? 544 + r : 672 + (r - 96); GAS u32x4* p = (GAS u32x4*)((bf16_t*)(ws + WS_WD2) + (size_t)row * 2048);
#pragma unroll
            for (int j = 0; j < 4; ++j) p[lane + 64 * j] = (u32x4){0u, 0u, 0u, 0u};
            continue; } r -= N_Z;
        { const int row = r * 2 + (lane >> 5), i = lane & 31;
          const double t = (double)((const int*)F.a->in[2])[row] * kInvFreqTurns[i]; const double fr = t - __builtin_rint(t);
          const float a = (float)(fr * 6.283185307179586476925);
          F.tab[(size_t)row * 32 + i] = make_float2(cosf(a), sinf(a)); }
    }
}

typedef float f32x2 __attribute__((ext_vector_type(2)));
template <int W, bool XB>
__device__ __forceinline__ void pool_cols(const void* xcv, const unsigned char* xlv, const LAS float* rsl, const f32x2 gm, int tb, int start, bf16_t* dp) {
    f32x2 hp[16], hc[16];
    auto ldx = [&](int pos) -> f32x2 { if constexpr (XB) { const unsigned r = *(const unsigned*)((const bf16_t*)xcv + (size_t)pos * DM); unsigned lo = 0u; if (XBF16 == 2) lo = *(const unsigned short*)(xlv + (size_t)pos * DM); return (f32x2){__builtin_bit_cast(float, (r << 16) | ((lo << 8) & 0xff00u)), __builtin_bit_cast(float, (r & 0xffff0000u) | (lo & 0xff00u))}; } else return *(const f32x2*)((const float*)xcv + (size_t)pos * DM); };
#pragma unroll
    for (int i = 0; i < 16; ++i) hp[i] = (f32x2){0.f, 0.f};
    if (tb > 0) {
#pragma unroll
        for (int i = 0; i < 16; ++i) hp[i] = ldx(tb - 16 + i);
#pragma unroll
        for (int i = 0; i < 16; ++i) hp[i] = hp[i] * (gm * rsl[tb - 16 + i - start]);
    }
    f32x2 S = {0.f, 0.f};
#pragma unroll
    for (int i = 16 - W; i < 16; ++i) S += hp[i];
    for (int ch = 0; ch < 4; ++ch) {
        const int p0 = tb + ch * 16;
#pragma unroll
        for (int i = 0; i < 16; ++i) hc[i] = ldx(p0 + i);
#pragma unroll
        for (int i = 0; i < 16; ++i) hc[i] = hc[i] * (gm * rsl[p0 + i - start]);
#pragma unroll
        for (int i = 0; i < 16; ++i) {
            const int pos = p0 + i;
            S += hc[i]; S -= (i >= W) ? hc[i - W] : hp[16 + i - W];
            const float inv = 1.f / (float)(pos + 1 < W ? pos + 1 : W);
            const f32x2 d = S * inv - hc[i];
            *(GAS unsigned*)(dp + (size_t)pos * DM) = cvt_pk_bf16(d[0], d[1]);
        }
#pragma unroll
        for (int i = 0; i < 16; ++i) hp[i] = hc[i];
    }
}
template <bool XB>
__device__ __forceinline__ void pool_unit(Frame& F, const void* xsrc, const float* gnorm, const float* scale_m  , int unit, bf16_t* Dout) {
    LAS float* rsl = (LAS float*)F.lds;
    const int tid = opaque_tid(), lane = tid & 63, wave = __builtin_amdgcn_readfirstlane(tid >> 6);
    const int t0 = unit * 64, b = t0 >> 12, tb = t0 & 4095;
    const int start = tb >= 16 ? tb - 16 : 0, nrows = tb + 64 - start;
    const size_t xboff = (size_t)b * 4096 * DM;
    for (int ri = wave; ri < nrows; ri += 2 * NWAVES) {
        const int r2 = ri + NWAVES < nrows ? ri + NWAVES : ri;
        float sa = 0.f, sb = 0.f;
        if constexpr (XB) {
            const GAS u32x4* xa = (const GAS u32x4*)((const bf16_t*)xsrc + xboff + (size_t)(start + ri) * DM) + lane; const GAS u32x4* xq = (const GAS u32x4*)((const bf16_t*)xsrc + xboff + (size_t)(start + r2) * DM) + lane;
            const GAS u32x2* la = (const GAS u32x2*)(F.ws + WS_XL + xboff + (size_t)(start + ri) * DM) + lane; const GAS u32x2* lq = (const GAS u32x2*)(F.ws + WS_XL + xboff + (size_t)(start + r2) * DM) + lane;
            u32x4 va[4], vb[4]; u32x2 wa[4], wb[4];
#pragma unroll
            for (int j = 0; j < 4; ++j) { va[j] = xa[64 * j]; vb[j] = xq[64 * j]; if (XBF16 == 2) { wa[j] = la[64 * j]; wb[j] = lq[64 * j]; } }
#pragma unroll
            for (int j = 0; j < 4; ++j) { f32x4 a0, a1, b0, b1;
                if (XBF16 == 2) { x8_unpack24(va[j], wa[j], a0, a1); x8_unpack24(vb[j], wb[j], b0, b1); } else { x8_unpack16(va[j], a0, a1); x8_unpack16(vb[j], b0, b1); }
                sa += (a0[0] * a0[0] + a0[1] * a0[1]) + (a0[2] * a0[2] + a0[3] * a0[3]) + (a1[0] * a1[0] + a1[1] * a1[1]) + (a1[2] * a1[2] + a1[3] * a1[3]);
                sb += (b0[0] * b0[0] + b0[1] * b0[1]) + (b0[2] * b0[2] + b0[3] * b0[3]) + (b1[0] * b1[0] + b1[1] * b1[1]) + (b1[2] * b1[2] + b1[3] * b1[3]); }
        } else {
            const GAS f32x4* xa = (const GAS f32x4*)((const float*)xsrc + xboff + (size_t)(start + ri) * DM) + lane; const GAS f32x4* xq = (const GAS f32x4*)((const float*)xsrc + xboff + (size_t)(start + r2) * DM) + lane;
            f32x4 va[8], vb[8];
#pragma unroll
            for (int j = 0; j < 8; ++j) { va[j] = xa[64 * j]; vb[j] = xq[64 * j]; }
#pragma unroll
            for (int j = 0; j < 8; ++j) { sa += (va[j][0] * va[j][0] + va[j][1] * va[j][1]) + (va[j][2] * va[j][2] + va[j][3] * va[j][3]); sb += (vb[j][0] * vb[j][0] + vb[j][1] * vb[j][1]) + (vb[j][2] * vb[j][2] + vb[j][3] * vb[j][3]); }
        }
        sa = wave_sum(sa); sb = wave_sum(sb);
        if (lane == 0) { rsl[ri] = rsqrtf(sa * (1.f / DM) + EPS); rsl[r2] = rsqrtf(sb * (1.f / DM) + EPS); }
    }
    __syncthreads();
    for (int pass = 0; pass < 2; ++pass) {
        const int c = pass * 1024 + 2 * tid, g = pass * 2 + __builtin_amdgcn_readfirstlane(tid >> 8);
        f32x2 gm = *(const f32x2*)(gnorm + c); { const f32x2 sm = *(const f32x2*)(scale_m + (size_t)b * 12288 + c); gm = gm * (sm + 1.f); }
        const void* xc = XB ? (const void*)((const bf16_t*)xsrc + xboff + c) : (const void*)((const float*)xsrc + xboff + c); bf16_t* dp = Dout + (size_t)b * 4096 * DM + c; const unsigned char* xl = F.ws + WS_XL + xboff + c;
        if (g == 0) pool_cols<2, XB>(xc, xl, rsl, gm, tb, start, dp);
        else if (g == 1) pool_cols<4, XB>(xc, xl, rsl, gm, tb, start, dp);
        else if (g == 2) pool_cols<8, XB>(xc, xl, rsl, gm, tb, start, dp);
        else pool_cols<16, XB>(xc, xl, rsl, gm, tb, start, dp);
    }
    __syncthreads();
}
__device__ __forceinline__ void bias_rows(const bf16_t* W, int nrows, const float* shift, int sstride, float* out, int ostride, int w0, int nw, int lane) {
    if (w0 >= nrows) return;
    f32x4 sh[4][4][2];
#pragma unroll
    for (int bb = 0; bb < 4; ++bb)
#pragma unroll
        for (int j = 0; j < 4; ++j) { const float* sp = shift + (size_t)bb * sstride + (lane + 64 * j) * 8; sh[bb][j][0] = *(const f32x4*)sp; sh[bb][j][1] = *(const f32x4*)(sp + 4); }
    for (int n = w0; n < nrows; n += nw) {
        const bf16_t* wrow = W + (size_t)n * 2048;
        bf16x8 wv[4];
#pragma unroll
        for (int j = 0; j < 4; ++j) wv[j] = *(const bf16x8*)(wrow + (lane + 64 * j) * 8);
        float a[4] = {0.f, 0.f, 0.f, 0.f};
#pragma unroll
        for (int j = 0; j < 4; ++j)
#pragma unroll
            for (int e = 0; e < 8; ++e) { const float w = bf2f((unsigned short)wv[j][e]);
#pragma unroll
                for (int bb = 0; bb < 4; ++bb) a[bb] += sh[bb][j][e >> 2][e & 3] * w; }
#pragma unroll
        for (int bb = 0; bb < 4; ++bb) a[bb] = wave_sum(a[bb]);
        if (lane == 0) { out[n] = a[0]; out[ostride + n] = a[1]; out[2 * ostride + n] = a[2]; out[3 * ostride + n] = a[3]; }
    }
}
__device__ __forceinline__ void ph1_prologue(Frame& F) {
    for (int u = F.vcu; u < 256; u += F.G) pool_unit<false>(F, ((const float*)F.a->in[0]), ((const float*)F.a->in[5]), F.modv + 2048, u, (bf16_t*)(F.ws + WS_AKV));
    const int tid = opaque_tid(), lane = tid & 63, wave = __builtin_amdgcn_readfirstlane(tid >> 6);
    const int gt = F.vcu * NWAVES * 64 + tid, NGT = F.G * NWAVES * 64;
    for (int i = gt; i < 4 * 4 * 2048; i += NGT) { const int col = i & 2047, lb = i >> 11, l = lb >> 2;
        const float* mv = F.modv + (size_t)lb * 12288;
        F.dv[DV_GM + i] = ((const float*)F.a->in[5])[l * 2048 + col] * (1.f + mv[2048 + col]);
        F.dv[DV_GF + i] = ((const float*)F.a->in[6])[l * 2048 + col] * (1.f + mv[8192 + col]);
        F.dv[DV_GATEM + i] = mv[4096 + col] * (l < 2 ? ((const float*)F.a->in[8])[l * 2048 + col] : 1.f);
        F.dv[DV_GATEF + i] = mv[10240 + col];
        if (i < 4 * 2048) F.dv[DV_GKV + i] = ((const float*)F.a->in[11])[col] * (1.f + F.kvmod[(size_t)lb * 4096 + 2048 + col]); }
    const int gw = F.vcu * NWAVES + wave, NGW = F.G * NWAVES;
    for (int l = 0; l < 4; ++l)
        bias_rows((const bf16_t*)(F.ws + WS_WFFN1 + l * SZ_WFFN1), 11264, F.modv + (size_t)l * 4 * 12288 + 6144, 12288, F.dv + DV_BFFN + (size_t)l * 4 * 11264, 11264, gw, NGW, lane);
    bias_rows((const bf16_t*)(F.ws + WS_WD2), 768, F.kvmod, 4096, F.dv + DV_BD2, 1280, gw, NGW, lane);
    bias_rows((const bf16_t*)(F.ws + WS_WD2) + (size_t)768 * 2048, 512, F.modv + (size_t)2 * 4 * 12288, 12288, F.dv + DV_BD2 + 768, 1280, gw, NGW, lane);
    bias_rows((const bf16_t*)(F.ws + WS_WD3), 512, F.modv + (size_t)3 * 4 * 12288, 12288, F.dv + DV_BD3, 512, gw, NGW, lane);
}
__device__ __forceinline__ void final_norm_phase(Frame& F) {
    const int tid = opaque_tid(), lane = tid & 63, wave = __builtin_amdgcn_readfirstlane(tid >> 6);
    const int gw = F.vcu * NWAVES + wave, NGW = F.G * NWAVES;
    f32x4 g[8];
#pragma unroll
    for (int j = 0; j < 8; ++j) g[j] = *((const GAS f32x4*)((const float*)F.a->in[24]) + lane + 64 * j);
    for (int m = gw; m < MROWS; m += NGW) {
        GAS f32x4* xr = (GAS f32x4*)(F.xw + (size_t)m * DM) + lane; f32x4 v[8]; float s = 0.f;
#if XBF16
        const GAS u32x2* xb = (const GAS u32x2*)((const bf16_t*)(F.ws + WS_XB) + (size_t)m * DM) + lane;
        const GAS unsigned* xlw = (const GAS unsigned*)(F.ws + WS_XL + (size_t)m * DM) + lane;
#pragma unroll
        for (int j = 0; j < 8; ++j) { const u32x2 r = xb[64 * j]; unsigned lo = 0u; if (XBF16 == 2) lo = xlw[64 * j];
            v[j] = (f32x4){__builtin_bit_cast(float, (r.x << 16) | ((lo << 8) & 0xff00u)), __builtin_bit_cast(float, (r.x & 0xffff0000u) | (lo & 0xff00u)),
                           __builtin_bit_cast(float, (r.y << 16) | ((lo >> 8) & 0xff00u)), __builtin_bit_cast(float, (r.y & 0xffff0000u) | ((lo >> 16) & 0xff00u))}; }
#else
#pragma unroll
        for (int j = 0; j < 8; ++j) v[j] = xr[64 * j];
#endif
#pragma unroll
        for (int j = 0; j < 8; ++j) s += (v[j][0] * v[j][0] + v[j][1] * v[j][1]) + (v[j][2] * v[j][2] + v[j][3] * v[j][3]);
        const float rstd = rsqrtf(wave_sum(s) * (1.f / DM) + EPS);
#pragma unroll
        for (int j = 0; j < 8; ++j) xr[64 * j] = v[j] * rstd * g[j];
    }
}

constexpr int NPHASES = 27;
__global__ void __launch_bounds__(NWAVES * 64, 2) fwd_kernel(Args args) {
    extern __shared__ __attribute__((aligned(16))) unsigned char lds_raw[];
    Frame F;
    F.lds = (LAS unsigned char*)lds_raw; F.MISC = (volatile LAS unsigned*)(F.lds + MISC_OFF);
    F.G = gridDim.x; { const int bx = blockIdx.x; F.vcu = (F.G % 8 == 0) ? (bx % 8) * (F.G / 8) + bx / 8 : bx; }
    unsigned char* const ws0_ = args.ws; float* const xw0_ = args.out;
    F.a = &args;
#define FRAME_PTRS(w_) do { F.ws = (w_); F.ctl = (gu32*)((w_) + WS_CTL); F.rs = (float*)((w_) + WS_CTL) + CW_RS; F.modv = (float*)((w_) + WS_CTL) + CW_MODV; F.kvmod = (float*)((w_) + WS_CTL) + CW_KVMOD; \
        F.dv = (float*)((w_) + WS_DV); F.tab = (float2*)((w_) + WS_TAB); } while (0)
    FRAME_PTRS(ws0_); F.xw = xw0_;
    if (threadIdx.x < 64) F.MISC[threadIdx.x] = 0u;
    __syncthreads();
    XcdBarrier bar = xcd_barrier_post((unsigned*)(F.ctl + CW_BAR), F.MISC);
    const int lo = args.ph_lo, hi = args.ph_hi;
    bool need_bar = false;
#define REPK(kind) for (int rep_ = 0; rep_ < ((PROBE_REP == (kind)) ? 2 : 1); ++rep_)
#define PH_BEGIN(p) if (lo <= (p) && (p) < hi) { if (need_bar) { XcdBarrier b_ = bar; asm volatile("" : "+s"(b_.bar), "+s"(b_.x)); xcd_barrier(b_); if (PROBE_REP == 15) xcd_barrier(b_); } need_bar = true; \
        unsigned char* ws = ws0_; float* xw_ = xw0_; asm volatile("" : "+s"(ws), "+s"(xw_)); FRAME_PTRS(ws); F.xw = xw_;
#define PH_END }
#define AQ ((bf16_t*)(ws + WS_AQ))
#define AKV ((bf16_t*)(ws + WS_AKV))
#define ACT ((bf16_t*)(ws + WS_ACT))
#define KN ((bf16_t*)(ws + WS_KN))
#define VV ((bf16_t*)(ws + WS_V))
#define KR ((bf16_t*)(ws + WS_KR))
#define CKV ((bf16_t*)(ws + WS_CKV))
#define CQ ((bf16_t*)(ws + WS_CQ))
#define QN ((bf16_t*)(ws + WS_QN))
#define QR ((bf16_t*)(ws + WS_QR))
#define OO ((bf16_t*)(ws + WS_O))

    #ifndef SK0
    PH_BEGIN(0) ph0_prologue(F); PH_END
#endif
    #ifndef SK1
    PH_BEGIN(1) REPK(8) ph1_prologue(F); PH_END
#endif
    for (int l = 0; l < 4; ++l) {
        const int base = 2 + 6 * l;
        if (l == 1) {
            PH_BEGIN(base) REPK(9) for (int u = F.vcu; u < 256; u += F.G) pool_unit<XBF16 != 0>(F, XBF16 ? (const void*)(ws + WS_XB) : (const void*)F.xw, ((const float*)F.a->in[5]) + 2048, F.modv + (size_t)4 * 12288 + 2048, u, AKV); PH_END
        }
        if (l >= 2) {
#ifndef SKD
            PH_BEGIN(base) {
                const bool first = (l == 2);
                pg8::Gemm g{first ? AKV : AQ, AQ, first ? 3 : 0, 2048, 0, (const bf16_t*)(ws + (first ? WS_WD2 : WS_WD3)), 2048, 2048, 64, first ? 5 : 2};
                pg8::StaticOrder S; S.init(g.nM, g.nN, F.G, (int)blockIdx.x);
                pg8::EpiDown E{F.rs + (first ? RS_M2 : RS_M3) * 16384, F.dv + (first ? DV_BD2 : DV_BD3), first ? 1280 : 512, first ? 3 : 0, ws, F.rs, first ? RS_Q2 : RS_Q3, F.tab};
                pg8::gemm_phase<pg8::EpiDown>(F.lds, g, S, E);
            } PH_END
#endif
#ifndef SKU
            PH_BEGIN(base + 1) {
                const bool first = (l == 2);
                pg8::Gemm g{first ? CKV : CQ, CQ, first ? 16 : 0, 512, 0, (const bf16_t*)(ws + (first ? WS_WU2 : WS_WU3)), 512, 512, 64, first ? 28 : 12};
                pg8::StaticOrder S; S.init(g.nM, g.nN, F.G, (int)blockIdx.x);
                pg8::EpiUp E{ws, F.rs, first ? RS_Q2 : RS_Q3, first ? 16 : 0, F.tab};
                REPK(5) pg8::gemm_phase<pg8::EpiUp>(F.lds, g, S, E);
            } PH_END
#endif
#ifndef SKA
            PH_BEGIN(base + 2) {
                REPK(3) att::attn_phase((char*)lds_raw, ws, F.vcu, F.G);
            } PH_END
#endif
        }
#ifndef SKM
        PH_BEGIN(base + 3) {
            const bool pool = l < 2;
            pg8::Gemm g{pool ? AKV : OO, pool ? AKV : OO, 0, 2048, pool ? 1 : 0, (const bf16_t*)(ws + (pool ? WS_WPOOL + l * SZ_WPOOL : WS_WO + (l - 2) * SZ_WO)), pool ? 512 : 2048, pool ? 512 : 2048, 64, 8};
            pg8::StaticOrder S; S.init(g.nM, g.nN, F.G, (int)blockIdx.x, 4);
            pg8::EpiRes E{l == 0 ? ((const float*)F.a->in[0]) : (XBF16 ? nullptr : F.xw), (const bf16_t*)(ws + WS_XB), XBF16 ? nullptr : F.xw, (bf16_t*)(ws + WS_XB), ws + WS_XL, F.dv + DV_GATEM + l * 4 * 2048, F.dv + DV_GF + l * 4 * 2048, AQ, nullptr, nullptr, F.rs + (RS_F0 + l) * 16384, (unsigned)(size_t)(F.lds + 131072)};
            if (PROBE_REP == 4) { pg8::EpiRes E2 = E; E2.xout32 = (float*)(ws + WS_FAST_END); E2.rowss = nullptr; E2.a0 = (bf16_t*)(ws + WS_FAST_END + (size_t)MROWS * DM * 4); pg8::gemm_phase<pg8::EpiRes, EPI_ALIGN_RES>(F.lds, g, S, E2); }
            pg8::gemm_phase<pg8::EpiRes, EPI_ALIGN_RES>(F.lds, g, S, E);
        } PH_END
#endif
#ifndef SKF1
        PH_BEGIN(base + 4) {
            pg8::Gemm g{AQ, AQ, 0, 2048, 0, (const bf16_t*)(ws + WS_WFFN1 + l * SZ_WFFN1), 2048, 2048, 64, 44};
            pg8::StaticOrder S; S.init(g.nM, g.nN, F.G, (int)blockIdx.x);
            pg8::EpiSwi E{F.rs + (RS_F0 + l) * 16384, F.dv + DV_BFFN + (size_t)l * 4 * 11264, ACT};
            REPK(1) pg8::gemm_phase<pg8::EpiSwi, true, FFN1_SP2, FFN1_SIM, L2PF_FFN1>(F.lds, g, S, E);
        } PH_END
#endif
#ifndef SKF2
        PH_BEGIN(base + 5) {
            pg8::Gemm g{ACT, ACT, 0, 5632, 0, (const bf16_t*)(ws + WS_WFFN2 + l * SZ_WFFN2), 5632, 5632, 64, 8};
            pg8::StaticOrder S; S.init(g.nM, g.nN, F.G, (int)blockIdx.x, 4);
            const bool hasA = (l == 1 || l == 2);
            pg8::EpiRes E{XBF16 ? nullptr : F.xw, (const bf16_t*)(ws + WS_XB), XBF16 ? nullptr : F.xw, (bf16_t*)(ws + WS_XB), ws + WS_XL, F.dv + DV_GATEF + l * 4 * 2048, hasA ? F.dv + DV_GM + (l + 1) * 4 * 2048 : nullptr, hasA ? AQ : nullptr,
                          l == 1 ? F.dv + DV_GKV : nullptr, l == 1 ? AKV : nullptr, hasA ? F.rs + (l == 1 ? RS_M2 : RS_M3) * 16384 : nullptr, (unsigned)(size_t)(F.lds + 131072)};
            if (PROBE_REP == 10) { pg8::EpiNull E0{(float*)(ws + WS_FAST_END)}; pg8::gemm_phase<pg8::EpiNull, true>(F.lds, g, S, E0); }
            if (PROBE_REP == 14) { pg8::EpiNull E0{(float*)(ws + WS_FAST_END)}; pg8::Gemm g2 = g; g2.grouped = 2; pg8::gemm_phase<pg8::EpiNull, true>(F.lds, g2, S, E0); }
            if (PROBE_REP == 2) { pg8::EpiRes E2 = E; E2.xout32 = (float*)(ws + WS_FAST_END); E2.rowss = nullptr; pg8::gemm_phase<pg8::EpiRes, EPI_ALIGN_RES>(F.lds, g, S, E2); }
            pg8::gemm_phase<pg8::EpiRes, EPI_ALIGN_RES, true, false, L2PF_FFN2>(F.lds, g, S, E);
        } PH_END
#endif
    }
    PH_BEGIN(26) REPK(12) final_norm_phase(F); PH_END
#undef PH_BEGIN
#undef PH_END
#undef FRAME_PTRS
#undef AQ
#undef AKV
#undef ACT
#undef KN
#undef VV
#undef KR
#undef CKV
#undef CQ
#undef QN
#undef QR
#undef OO
}
#if MODE >= 2
extern "C" void kernel_launch(void* const* d_in, const int* in_sizes, int n_in, void* d_out, int out_size, void* d_ws, size_t ws_size, hipStream_t stream) {
    static int grid = 0;
    if (grid == 0) {
        if (n_in != 25 || out_size != MROWS * DM || ws_size < WS_FAST_END) { fprintf(stderr, "kernel_launch: unexpected shapes / workspace (%d inputs, out %d, ws %zu < %zu)\n", n_in, out_size, ws_size, (size_t)WS_FAST_END); grid = -1; return; }
        int dev = 0, cus = 0, per_cu = 0;
        if (hipGetDevice(&dev) != hipSuccess || hipDeviceGetAttribute(&cus, hipDeviceAttributeMultiprocessorCount, dev) != hipSuccess) { grid = -1; return; }
        if (hipFuncSetAttribute((const void*)fwd_kernel, hipFuncAttributeMaxDynamicSharedMemorySize, LDS_BYTES) != hipSuccess) { fprintf(stderr, "kernel_launch: hipFuncSetAttribute failed\n"); grid = -1; return; }
        if (hipOccupancyMaxActiveBlocksPerMultiprocessor(&per_cu, (const void*)fwd_kernel, NWAVES * 64, LDS_BYTES) != hipSuccess || per_cu < 1) { fprintf(stderr, "kernel_launch: occupancy query says %d\n", per_cu); }
        (void)hipGetLastError();
        grid = cus;
    }
    if (grid < 0) return;
    (void)hipMemsetAsync((char*)d_ws + WS_CTL, 0, CTL_ZERO_BYTES, stream);
    Args a{};
    for (int i = 0; i < 25; ++i) a.in[i] = d_in[i];
    a.out = (float*)d_out; a.ws = (unsigned char*)d_ws;
#if MODE == 2
    a.ph_lo = 0; a.ph_hi = NPHASES;
    hipLaunchKernelGGL(fwd_kernel, dim3(grid), dim3(NWAVES * 64), LDS_BYTES, stream, a);
#else
    for (int p = 0; p < NPHASES; ++p) {
        const int k = p < 2 ? -1 : (p - 2) % 6, l = p < 2 ? -1 : (p - 2) / 6;
        if (p >= 2 && p < 26) { if (k == 0 && l == 0) continue; if ((k == 1 || k == 2) && l < 2) continue; }
        a.ph_lo = p; a.ph_hi = p + 1;
        hipLaunchKernelGGL(fwd_kernel, dim3(grid), dim3(NWAVES * 64), LDS_BYTES, stream, a);
    }
#endif
}
#endif
```

```cpp
#include <hip/hip_runtime.h>
#include <cstdio>
#include <cstdint>
#ifndef MODE
#define MODE 2
#define PROBE_REP 0
#endif
#define GAS __attribute__((address_space(1)))
#define LAS __attribute__((address_space(3)))
typedef unsigned short bf16_t;
typedef short bf16x8 __attribute__((ext_vector_type(8)));
typedef short s16x4 __attribute__((ext_vector_type(4)));
typedef float f32x4 __attribute__((ext_vector_type(4)));
typedef float f32x16 __attribute__((ext_vector_type(16)));
typedef unsigned u32x4 __attribute__((ext_vector_type(4)));
typedef unsigned u32x2 __attribute__((ext_vector_type(2)));
typedef GAS unsigned gu32;

#ifndef NT_LOADS0
#define NT_LOADS0 1
#endif
#ifndef NT_STORES
#define NT_STORES 0
#endif
#ifndef XBF16
#define XBF16 1
#endif
constexpr int NWAVES = 8;
constexpr int BATCH = 4, SEQ = 4096, DM = 2048, MROWS = BATCH * SEQ, FF = 5632, NH = 16;
constexpr float EPS = 1e-6f;
constexpr size_t MiB = 1u << 20;

constexpr size_t WS_CTL = 0, CTL_ZERO_BYTES = 2 * MiB;
constexpr int CW_TMO = 0;
constexpr int CW_BAR = 4096;
constexpr int CW_RS = 16384;
constexpr int RS_F0 = 0, RS_M2 = 4, RS_M3 = 5, RS_KV = 6, RS_Q2 = 7, RS_Q3 = 8;
constexpr int CW_MODV = CW_RS + 2 * 12 * 16384;
constexpr int CW_KVMOD = CW_MODV + 4 * 4 * 12288;
constexpr int CW_END = CW_KVMOD + 4 * 4096;
static_assert((size_t)CW_MODV * 4 <= CTL_ZERO_BYTES && (size_t)CW_END * 4 <= 4 * MiB, "CTL region: the barrier words and the row-sum accumulators are zeroed per call; the mod vectors behind them are fully written before they are read");
constexpr size_t WS_DV = 4 * MiB;
constexpr int DV_GM = 0;
constexpr int DV_GF = DV_GM + 4 * 4 * 2048;
constexpr int DV_GKV = DV_GF + 4 * 4 * 2048;
constexpr int DV_GATEM = DV_GKV + 4 * 2048;
constexpr int DV_GATEF = DV_GATEM + 4 * 4 * 2048;
constexpr int DV_BFFN = DV_GATEF + 4 * 4 * 2048;
constexpr int DV_BD2 = DV_BFFN + 4 * 4 * 11264;
constexpr int DV_BD3 = DV_BD2 + 4 * 1280;
constexpr int DV_END = DV_BD3 + 4 * 512;
static_assert((size_t)DV_END * 4 <= 2 * MiB, "DV region");
constexpr size_t WS_TAB = 6 * MiB;
constexpr size_t WS_WFFN1 = 10 * MiB;
constexpr size_t SZ_WFFN1 = (size_t)11264 * 2048 * 2;
constexpr size_t WS_WFFN2 = WS_WFFN1 + 4 * SZ_WFFN1;
constexpr size_t SZ_WFFN2 = (size_t)2048 * 5632 * 2;
constexpr size_t WS_WPOOL = WS_WFFN2 + 4 * SZ_WFFN2;
constexpr size_t SZ_WPOOL = (size_t)2048 * 512 * 2;
constexpr size_t WS_WD2 = WS_WPOOL + 2 * SZ_WPOOL;
constexpr size_t WS_WD3 = WS_WD2 + (size_t)1280 * 2048 * 2;
constexpr size_t WS_WU2 = WS_WD3 + (size_t)512 * 2048 * 2;
constexpr size_t WS_WU3 = WS_WU2 + (size_t)7168 * 512 * 2;
constexpr size_t WS_WO = WS_WU3 + (size_t)3072 * 512 * 2;
constexpr size_t SZ_WO = (size_t)2048 * 2048 * 2;
constexpr size_t WS_WEND = WS_WO + 2 * SZ_WO;
constexpr size_t SZ_MD = (size_t)MROWS * DM * 2;
constexpr size_t WS_AQ = (WS_WEND + MiB - 1) / MiB * MiB;
constexpr size_t WS_AKV = WS_AQ + SZ_MD;
constexpr size_t WS_KN = WS_AKV + SZ_MD;
constexpr size_t WS_V = WS_KN + SZ_MD;
constexpr size_t WS_KR = WS_V + SZ_MD;
constexpr size_t WS_CKV = WS_KR + (size_t)MROWS * 64 * 2;
constexpr size_t WS_CQ = WS_CKV + (size_t)MROWS * 512 * 2;
constexpr size_t WS_ACT = WS_CQ + (size_t)MROWS * 512 * 2;
constexpr size_t WS_QN = WS_ACT, WS_QR = WS_QN + SZ_MD, WS_O = WS_QR + (size_t)MROWS * 1024 * 2;
constexpr size_t WS_XB = WS_ACT + (size_t)MROWS * FF * 2;
constexpr size_t WS_XL = WS_XB + SZ_MD;
constexpr size_t WS_FAST_END = WS_XL + SZ_MD / 2;
constexpr int MODN = 4 * 4 * 12288 + 4 * 4096;
constexpr size_t WS_MODP = WS_FAST_END;
constexpr size_t WS_NEED = WS_MODP + (size_t)8 * MODN * 4;
static_assert(WS_O + SZ_MD <= WS_XB, "attention overlays inside act");

constexpr int RING_BYTES = 131072;
constexpr int LDS_BYTES = 147456;
constexpr int MISC_OFF = LDS_BYTES - 256;

#define RLX_AGENT __ATOMIC_RELAXED, __HIP_MEMORY_SCOPE_AGENT
#define LDS_WAIT() asm volatile("s_waitcnt lgkmcnt(0)" ::: "memory")
#define VM_WAIT() asm volatile("s_waitcnt vmcnt(0)" ::: "memory")
__device__ __forceinline__ unsigned f2bf(float f) { unsigned u = __builtin_bit_cast(unsigned, f); return (u + 0x7fffu + ((u >> 16) & 1u)) >> 16; }
__device__ __forceinline__ unsigned pk2(float lo, float hi) { return f2bf(lo) | (f2bf(hi) << 16); }
__device__ __forceinline__ float bf2f(unsigned short b) { return __builtin_bit_cast(float, (unsigned)b << 16); }
__device__ __forceinline__ unsigned cvt_pk_bf16(float lo, float hi) { unsigned r; asm volatile("v_cvt_pk_bf16_f32 %0, %1, %2" : "=v"(r) : "v"(lo), "v"(hi)); return r; }
__device__ __forceinline__ int opaque_lane() { int l; asm volatile("v_mbcnt_lo_u32_b32 %0, -1, 0\n\tv_mbcnt_hi_u32_b32 %0, -1, %0" : "=v"(l)); return l; }
typedef unsigned long long rs_t;
constexpr float RS_SCALE = 1048576.f, RS_INV = 1.f / 1048576.f, MA_SCALE = 4294967296.f, MA_INV = 1.f / 4294967296.f;
__device__ __forceinline__ void rs_add(rs_t* p, float s) { (void)__hip_atomic_fetch_add((GAS rs_t*)p, (rs_t)(long long)(s * RS_SCALE), __ATOMIC_RELAXED, __HIP_MEMORY_SCOPE_AGENT); }
__device__ __forceinline__ float rs_get(const rs_t* p) { return (float)(long long)*(const GAS rs_t*)p * RS_INV; }
__device__ __forceinline__ int opaque_tid(int wv) { return wv * 64 + opaque_lane(); }
__device__ __forceinline__ void x8_unpack16(const u32x4 h, f32x4& a, f32x4& b) {
    a = (f32x4){__builtin_bit_cast(float, h.x << 16), __builtin_bit_cast(float, h.x & 0xffff0000u), __builtin_bit_cast(float, h.y << 16), __builtin_bit_cast(float, h.y & 0xffff0000u)};
    b = (f32x4){__builtin_bit_cast(float, h.z << 16), __builtin_bit_cast(float, h.z & 0xffff0000u), __builtin_bit_cast(float, h.w << 16), __builtin_bit_cast(float, h.w & 0xffff0000u)}; }
__device__ __forceinline__ void x8_unpack24(const u32x4 h, const u32x2 l, f32x4& a, f32x4& b) {
    a = (f32x4){__builtin_bit_cast(float, (h.x << 16) | ((l.x << 8) & 0xff00u)), __builtin_bit_cast(float, (h.x & 0xffff0000u) | (l.x & 0xff00u)),
                __builtin_bit_cast(float, (h.y << 16) | ((l.x >> 8) & 0xff00u)), __builtin_bit_cast(float, (h.y & 0xffff0000u) | ((l.x >> 16) & 0xff00u))};
    b = (f32x4){__builtin_bit_cast(float, (h.z << 16) | ((l.y << 8) & 0xff00u)), __builtin_bit_cast(float, (h.z & 0xffff0000u) | (l.y & 0xff00u)),
                __builtin_bit_cast(float, (h.w << 16) | ((l.y >> 8) & 0xff00u)), __builtin_bit_cast(float, (h.w & 0xffff0000u) | ((l.y >> 16) & 0xff00u))}; }
__device__ __forceinline__ void x8_pack24(const f32x4 a, const f32x4 b, u32x4& h, u32x2& l) {
    unsigned t[8];
#pragma unroll
    for (int i = 0; i < 4; ++i) { const float fa = a[i], fb = b[i];
        t[i] = (__builtin_bit_cast(unsigned, fa) + 0x80u) >> 8; t[4 + i] = (__builtin_bit_cast(unsigned, fb) + 0x80u) >> 8; }
    h.x = (t[0] >> 8) | ((t[1] << 8) & 0xffff0000u); h.y = (t[2] >> 8) | ((t[3] << 8) & 0xffff0000u); h.z = (t[4] >> 8) | ((t[5] << 8) & 0xffff0000u); h.w = (t[6] >> 8) | ((t[7] << 8) & 0xffff0000u);
    l.x = (t[0] & 0xffu) | ((t[1] & 0xffu) << 8) | ((t[2] & 0xffu) << 16) | (t[3] << 24); l.y = (t[4] & 0xffu) | ((t[5] & 0xffu) << 8) | ((t[6] & 0xffu) << 16) | (t[7] << 24); }
template <class T> __device__ __forceinline__ void st_stream(T* p, const T& v) { if (NT_STORES) __builtin_nontemporal_store(v, p); else *p = v; }
__device__ __forceinline__ float dpp_xor1(float v) { return __builtin_bit_cast(float, __builtin_amdgcn_mov_dpp(__builtin_bit_cast(int, v), 0xB1, 0xF, 0xF, true)); }
__device__ __forceinline__ float dpp_xor2(float v) { return __builtin_bit_cast(float, __builtin_amdgcn_mov_dpp(__builtin_bit_cast(int, v), 0x4E, 0xF, 0xF, true)); }
__device__ __forceinline__ float dpp_hmirror(float v) { return __builtin_bit_cast(float, __builtin_amdgcn_mov_dpp(__builtin_bit_cast(int, v), 0x141, 0xF, 0xF, true)); }
__device__ __forceinline__ float dpp_mirror(float v) { return __builtin_bit_cast(float, __builtin_amdgcn_mov_dpp(__builtin_bit_cast(int, v), 0x140, 0xF, 0xF, true)); }
__device__ __forceinline__ float swz_xor16(float v) { return __builtin_bit_cast(float, __builtin_amdgcn_ds_swizzle(__builtin_bit_cast(int, v), 0x401F)); }
__device__ __forceinline__ float add_xor32(float v) {
    auto rr = __builtin_amdgcn_permlane32_swap(__builtin_bit_cast(unsigned, v), __builtin_bit_cast(unsigned, v), false, false);
    const unsigned a = rr[0], b = rr[1];
    return __builtin_bit_cast(float, a) + __builtin_bit_cast(float, b); }
__device__ __forceinline__ float wave_sum(float v) {
    v += dpp_xor1(v); v += dpp_xor2(v); v += dpp_hmirror(v); v += dpp_mirror(v); v += swz_xor16(v); return add_xor32(v);
}

#define XB_TMO      128
#define XB_XCNT(j)  (256  + 64 * (j))
#define XB_XSUB(j)  (1280 + 64 * (j))
#define XB_XGEN(j)  (2304 + 64 * (j))
#define XB_TOP      3328
#define XB_TOPGEN   3392
#define XCD_BAR_WORDS 3456
#define XB_SPIN_CAP (1u << 18)
__device__ __forceinline__ unsigned xb_ld(unsigned* p)              { return __hip_atomic_load(p, __ATOMIC_RELAXED, __HIP_MEMORY_SCOPE_AGENT); }
__device__ __forceinline__ unsigned xb_add(unsigned* p, unsigned v) { return __hip_atomic_fetch_add(p, v, __ATOMIC_RELAXED, __HIP_MEMORY_SCOPE_AGENT); }
__device__ __forceinline__ unsigned xb_xcc_id() { return (unsigned)__builtin_amdgcn_s_getreg((3 << 11) | 20) & 0xFu; }
#define XB_SPIN(cond, bar) do { unsigned _sp = 0; while (cond) { __builtin_amdgcn_s_sleep(1); \
    if ((++_sp & 255u) == 0u) { if (xb_ld(&(bar)[XB_TMO])) break; if (_sp > XB_SPIN_CAP) { atomicAdd(&(bar)[XB_TMO], 1u); break; } } } } while (0)
struct XcdBarrier { unsigned* bar; unsigned x; volatile LAS unsigned* st; };
__device__ __forceinline__ XcdBarrier xcd_barrier_post(unsigned* bar, volatile LAS unsigned* st, bool t0  ) {
    XcdBarrier b; b.bar = bar; b.x = xb_xcc_id(); b.st = st;
    if (t0) (void)xb_add(&bar[XB_XCNT(b.x)], 1u);
    return b;
}
__device__ __forceinline__ void xcd_barrier_complete(unsigned* bar, unsigned x, unsigned& nloc, unsigned& nx) {
    const unsigned G = gridDim.x * gridDim.y * gridDim.z;
    unsigned sum, cnt, mine, sp = 0u;
    for (;;) {
        sum = 0u; cnt = 0u; mine = 0u;
#pragma unroll
        for (unsigned j = 0; j < 16; ++j) { const unsigned c = xb_ld(&bar[XB_XCNT(j)]); sum += c; cnt += (c > 0u) ? 1u : 0u; mine = (j == x) ? c : mine; }
        if (sum == G) break;
        __builtin_amdgcn_s_sleep(1);
        if ((++sp & 255u) == 0u) { if (xb_ld(&bar[XB_TMO])) break; if (sp > XB_SPIN_CAP) { atomicAdd(&bar[XB_TMO], 1u); break; } }
    }
    nloc = mine > 0u ? mine : 1u; nx = cnt > 0u ? cnt : 1u;
}
__device__ __forceinline__ void xcd_barrier(const XcdBarrier& b, bool t0  ) {
    asm volatile("s_waitcnt vmcnt(0)" ::: "memory");
    __syncthreads();
    if (t0) {
        unsigned* bar = b.bar;
        __builtin_amdgcn_s_waitcnt(0);
        unsigned nloc = b.st[0], nx = b.st[1];
        if (nloc == 0u) { xcd_barrier_complete(bar, b.x, nloc, nx); b.st[0] = nloc; b.st[1] = nx; }
        const unsigned old = xb_add(&bar[XB_XSUB(b.x)], 1u);
        const unsigned gen = old / nloc;
        if (old + 1u == (gen + 1u) * nloc) {
            __builtin_amdgcn_fence(__ATOMIC_RELEASE, "agent");
            asm volatile("s_waitcnt vmcnt(0)" ::: "memory");
            const unsigned og = xb_add(&bar[XB_TOP], 1u);
            const unsigned tg = og / nx;
            if (og + 1u == (tg + 1u) * nx) xb_add(&bar[XB_TOPGEN], 1u);
            else XB_SPIN(xb_ld(&bar[XB_TOPGEN]) == tg, bar);
            __builtin_amdgcn_fence(__ATOMIC_ACQUIRE, "agent");
            xb_add(&bar[XB_XGEN(b.x)], 1u);
            asm volatile("s_waitcnt vmcnt(0)" ::: "memory");
        } else {
            XB_SPIN(xb_ld(&bar[XB_XGEN(b.x)]) == gen, bar);
            __builtin_amdgcn_fence(__ATOMIC_ACQUIRE, "agent");
            asm volatile("s_waitcnt vmcnt(0)" ::: "memory");
        }
    }
    __syncthreads();
}
#ifndef EPI_RELAX
#define EPI_RELAX 1
#endif
#ifndef EPI_RES_2G
#define EPI_RES_2G 0
#endif
#ifndef EPI_PF_LEAD
#define EPI_PF_LEAD 8
#endif
#ifndef EPI_RES_PF
#define EPI_RES_PF 0
#endif
#ifndef PG8_L2PF_DEFAULT
#define PG8_L2PF_DEFAULT false
#endif
namespace pg8 {
constexpr int BM = 256, BK = 64, HALF = 128, HTB = HALF * BK * 2, NXCD = 8;
__host__ __device__ __forceinline__ int lds_byte(int r, int c) { const int st = (r >> 4) * 2 + (c >> 5), rr = r & 15, cc = c & 31, ob = rr * 64 + cc * 2; return st * 1024 + (ob ^ (((ob >> 9) & 1) << 5)); }
__host__ __device__ __forceinline__ void stage_rc(int b, int& R, int& C) { const int st = b / 1024, sb = b % 1024, swz = sb ^ (((sb >> 9) & 1) << 5); R = (st >> 1) * 16 + swz / 64; C = (st & 1) * 32 + (swz % 64) / 2; }
__host__ __device__ __forceinline__ int perm32(int rho) { const int n = rho >> 4, i = rho & 15; return 8 * (i >> 2) + 4 * n + (i & 3); }

struct Unit { int pm, pn; };
struct Gemm { const bf16_t* A0; const bf16_t* A1; int pn_split; int lda; int grouped; const bf16_t* Bt; int ldb; int K; int nM, nN; };
__device__ __forceinline__ const char* a_ptr(const Gemm& g, const Unit& u) {
    const bf16_t* a = (u.pn < g.pn_split) ? g.A0 : g.A1;
    return (const char*)(a + (size_t)u.pm * BM * g.lda + (g.grouped ? (u.pn >> 1) * 512 : 0));
}
__device__ __forceinline__ const char* b_ptr(const Gemm& g, const Unit& u) { return (const char*)(g.Bt + (size_t)u.pn * BM * g.ldb); }

struct StaticOrder {
    int nM, nN, nwg, G, c, WGM;
    __device__ void init(int nM_, int nN_, int G_, int c_, int wgm = 8) { nM = nM_; nN = nN_; nwg = nM * nN; G = G_; c = c_; WGM = wgm; }
    __device__ bool next(int i, Unit& u) const {
        const long L = (long)i * G + c; if (L >= nwg) return false;
        int wgid = (int)L; { const int q = nwg / NXCD, r = nwg % NXCD, xcd = wgid % NXCD, off = wgid / NXCD; wgid = (xcd < r ? xcd * (q + 1) : r * (q + 1) + (xcd - r) * q) + off; }
        const int nig = WGM * nN, gid = wgid / nig, fm = gid * WGM, gsz = (nM - fm) < WGM ? (nM - fm) : WGM;
        u.pm = fm + ((wgid % nig) % gsz); u.pn = (wgid % nig) / gsz; return true;
    }
};

template <class Epi, bool ALIGN_EPI = true, bool SP2 = true, bool STAGE_IN_MMA = false, bool L2PF = PG8_L2PF_DEFAULT>
__device__ __forceinline__ void gemm_phase(LAS unsigned char* lds, const Gemm g, const StaticOrder& S, const Epi& E, int wv) {
    const int tid = opaque_tid(wv), wid = wv, lane = tid & 63, wr = wid >> 2, wc = wid & 3, fr = lane & 15, fq = lane >> 4;
    const int K = g.K, nt = K / BK;
    const int tpf = nt > EPI_PF_LEAD ? nt - EPI_PF_LEAD : 0;
    unsigned voffA[2], voffB[2];
#pragma unroll
    for (int i = 0; i < 2; ++i) { int R, C; stage_rc(tid * 16 + i * 8192, R, C); const int Rb = (R & ~31) + perm32(R & 31);
        voffA[i] = (unsigned)(R * g.lda + C) * 2u; voffB[i] = (unsigned)(Rb * g.ldb + C) * 2u; }
    const size_t kstep = (size_t)(BK * 2);
    const size_t hstepA = (size_t)HALF * g.lda * 2, hstepB = (size_t)HALF * g.ldb * 2;
    const unsigned ldsw = (unsigned)wid * 1024u;
    const int wu = __builtin_amdgcn_readfirstlane(wid);
    const int aoff = lds_byte(wr * 64 + fr, fq * 8), boff = lds_byte(wc * 32 + fr, fq * 8);
#define PG8_SA(b, h) (((b) * 2 + (h)) * HTB)
#define PG8_SB(b, h) ((4 + (b) * 2 + (h)) * HTB)
#ifndef PG8_ASM_STAGE
#define PG8_ASM_STAGE 1
#endif
#if PG8_ASM_STAGE
    const unsigned ldsb = (unsigned)(size_t)lds + (unsigned)wu * 1024u;
#define PG8_STAGE(bufoff, gbase, voff) do { _Pragma("unroll") for (int _i = 0; _i < 2; ++_i) { const unsigned m0v_ = ldsb + (unsigned)(bufoff) + (unsigned)(_i * 8192); \
        asm volatile("s_mov_b32 m0, %0\n\ts_nop 0\n\tglobal_load_lds_dwordx4 %1, %2" :: "s"(m0v_), "v"((voff)[_i]), "s"((const char*)(gbase)) : "memory", "m0"); } } while (0)
#else
#define PG8_STAGE(bufoff, gbase, voff) do { _Pragma("unroll") for (int _i = 0; _i < 2; ++_i) \
        __builtin_amdgcn_global_load_lds((const unsigned*)((const char*)(gbase) + (voff)[_i]), (LAS unsigned*)(lds + (bufoff) + ldsw + _i * 8192), 16, 0, 0); } while (0)
#endif
#define PG8_LDA(dst, b, h) do { _Pragma("unroll") for (int m = 0; m < 4; ++m) _Pragma("unroll") for (int k = 0; k < 2; ++k) dst[m][k] = *(const LAS bf16x8*)(lds + PG8_SA(b, h) + aoff + m * 2048 + k * 1024); } while (0)
#define PG8_LDB(dst, b, h) do { _Pragma("unroll") for (int n = 0; n < 2; ++n) _Pragma("unroll") for (int k = 0; k < 2; ++k) dst[n][k] = *(const LAS bf16x8*)(lds + PG8_SB(b, h) + boff + n * 2048 + k * 1024); } while (0)
#ifndef PG8_STAGE_FIRST
#define PG8_STAGE_FIRST 0
#endif
#ifndef PG8_PRIO
#define PG8_PRIO 1
#endif
#define PG8_MMA(ai, bj, At, Bt) do { if (PG8_PRIO) __builtin_amdgcn_s_setprio(1); _Pragma("unroll") for (int m = 0; m < 4; ++m) _Pragma("unroll") for (int n = 0; n < 2; ++n) _Pragma("unroll") for (int k = 0; k < 2; ++k) \
        acc[ai][bj][m][n] = __builtin_amdgcn_mfma_f32_16x16x32_bf16(Bt[n][k], At[m][k], acc[ai][bj][m][n], 0, 0, 0); if (PG8_PRIO) __builtin_amdgcn_s_setprio(0); } while (0)
#define PG8_WAIT_V(n) asm volatile("s_waitcnt vmcnt(" #n ")" ::: "memory")
#define PG8_WAIT_L(n) asm volatile("s_waitcnt lgkmcnt(" #n ")" ::: "memory")
#define PG8_BAR __builtin_amdgcn_s_barrier()
#define PG8_SCHED __builtin_amdgcn_sched_barrier(0)
    Unit cur, nxt; int ui = 0;
    if (!S.next(0, cur)) return;
    f32x4 acc[2][2][4][2];
#pragma unroll
    for (int a = 0; a < 2; ++a)
#pragma unroll
        for (int b = 0; b < 2; ++b)
#pragma unroll
            for (int m = 0; m < 4; ++m)
#pragma unroll
                for (int n = 0; n < 2; ++n) acc[a][b][m][n] = (f32x4){0.f, 0.f, 0.f, 0.f};
    bf16x8 At[4][2], B0[2][2], B1[2][2];
    const char* cA = a_ptr(g, cur); const char* cB = b_ptr(g, cur);
    if constexpr (SP2) {
    PG8_STAGE(PG8_SB(0, 0), cB, voffB); PG8_STAGE(PG8_SB(0, 1), cB + hstepB, voffB); PG8_STAGE(PG8_SA(0, 0), cA, voffA); PG8_STAGE(PG8_SA(0, 1), cA + hstepA, voffA);
    if (wr == 1) PG8_BAR;
    PG8_WAIT_V(2); PG8_BAR;
    PG8_STAGE(PG8_SB(1, 0), cB + kstep, voffB); PG8_STAGE(PG8_SA(1, 0), cA + kstep, voffA); PG8_STAGE(PG8_SB(1, 1), cB + hstepB + kstep, voffB);
    PG8_WAIT_V(6); PG8_BAR;
    } else {
    PG8_STAGE(PG8_SB(0, 0), cB, voffB); PG8_STAGE(PG8_SA(0, 0), cA, voffA); PG8_STAGE(PG8_SB(0, 1), cB + hstepB, voffB); PG8_STAGE(PG8_SA(0, 1), cA + hstepA, voffA);
    if (wr == 1) PG8_BAR;
    PG8_WAIT_V(4); PG8_BAR;
    PG8_STAGE(PG8_SB(1, 0), cB + kstep, voffB); PG8_STAGE(PG8_SA(1, 0), cA + kstep, voffA); PG8_STAGE(PG8_SB(1, 1), cB + hstepB + kstep, voffB);
    PG8_WAIT_V(6); PG8_BAR;
    }
    for (;;) {
        const bool has_next = S.next(ui + 1, nxt);
        const char* nA = has_next ? a_ptr(g, nxt) : cA; const char* nB = has_next ? b_ptr(g, nxt) : cB;
        int pf_id = 0; const int pf_sh = (S.WGM == 8) ? (wu < 4 ? 6 : 5) : (wu < 4 ? 5 : 6);
        if constexpr (L2PF) pf_id = (S.WGM == 8) ? (wu < 4 ? (cur.pn & 3) : (cur.pm & 7)) : (wu < 4 ? (cur.pn & 7) : (cur.pm & 3));
        for (int t = 0; t < nt; t += 2) {
            const bool last = (t == nt - 2);
            const char* a1 = cA + (size_t)(t + 1) * kstep;
            const char* a2 = last ? nA : cA + (size_t)(t + 2) * kstep; const char* b2 = last ? nB : cB + (size_t)(t + 2) * kstep;
            const char* a3 = a2 + kstep; const char* b3 = b2 + kstep;
            if constexpr (!SP2) {
            PG8_LDB(B0, 0, 0); PG8_SCHED; PG8_LDA(At, 0, 0); PG8_STAGE(PG8_SA(1, 1), a1 + hstepA, voffA);
            PG8_WAIT_L(8); PG8_BAR; PG8_WAIT_L(0); PG8_MMA(0, 0, At, B0); PG8_BAR; PG8_SCHED;
            PG8_LDB(B1, 0, 1); PG8_STAGE(PG8_SB(0, 0), b2, voffB);
            PG8_BAR; PG8_WAIT_L(0); PG8_MMA(0, 1, At, B1); PG8_BAR;
            PG8_LDA(At, 0, 1); PG8_STAGE(PG8_SA(0, 0), a2, voffA);
            PG8_BAR; PG8_WAIT_L(0); PG8_MMA(1, 0, At, B0); PG8_BAR; PG8_SCHED;
            PG8_STAGE(PG8_SB(0, 1), b2 + hstepB, voffB);
            PG8_WAIT_V(6); PG8_BAR; PG8_MMA(1, 1, At, B1); PG8_BAR;
            PG8_LDB(B0, 1, 0); PG8_SCHED; PG8_LDA(At, 1, 0); PG8_STAGE(PG8_SA(0, 1), a2 + hstepA, voffA);
            PG8_WAIT_L(8); PG8_BAR; PG8_WAIT_L(0); PG8_MMA(0, 0, At, B0); PG8_BAR; PG8_SCHED;
            PG8_LDB(B1, 1, 1); PG8_STAGE(PG8_SB(1, 0), b3, voffB);
            PG8_BAR; PG8_WAIT_L(0); PG8_MMA(0, 1, At, B1); PG8_BAR;
            PG8_LDA(At, 1, 1); PG8_STAGE(PG8_SA(1, 0), a3, voffA);
            PG8_BAR; PG8_WAIT_L(0); PG8_MMA(1, 0, At, B0); PG8_BAR; PG8_SCHED;
            PG8_STAGE(PG8_SB(1, 1), b3 + hstepB, voffB);
            PG8_WAIT_V(6); PG8_BAR; PG8_MMA(1, 1, At, B1); PG8_BAR;
            } else if constexpr (STAGE_IN_MMA) {
            PG8_LDB(B0, 0, 0); PG8_LDB(B1, 0, 1); PG8_SCHED; PG8_LDA(At, 0, 0);
            PG8_WAIT_V(6); PG8_WAIT_L(0); PG8_BAR; PG8_MMA(0, 0, At, B0); PG8_STAGE(PG8_SA(1, 1), a1 + hstepA, voffA); PG8_MMA(0, 1, At, B1); PG8_BAR; PG8_SCHED;
            PG8_LDA(At, 0, 1);
            PG8_WAIT_V(2); PG8_WAIT_L(0); PG8_BAR; PG8_MMA(1, 0, At, B0); PG8_STAGE(PG8_SB(0, 0), b2, voffB); PG8_STAGE(PG8_SB(0, 1), b2 + hstepB, voffB); PG8_STAGE(PG8_SA(0, 0), a2, voffA); PG8_MMA(1, 1, At, B1); PG8_BAR; PG8_SCHED;
            PG8_LDB(B0, 1, 0); PG8_LDB(B1, 1, 1); PG8_SCHED; PG8_LDA(At, 1, 0);
            PG8_WAIT_V(6); PG8_WAIT_L(0); PG8_BAR; PG8_MMA(0, 0, At, B0); PG8_STAGE(PG8_SA(0, 1), a2 + hstepA, voffA); PG8_MMA(0, 1, At, B1); PG8_BAR; PG8_SCHED;
            PG8_LDA(At, 1, 1);
            PG8_WAIT_V(2); PG8_WAIT_L(0); PG8_BAR; PG8_MMA(1, 0, At, B0); PG8_STAGE(PG8_SB(1, 0), b3, voffB); PG8_STAGE(PG8_SB(1, 1), b3 + hstepB, voffB); PG8_STAGE(PG8_SA(1, 0), a3, voffA); PG8_MMA(1, 1, At, B1); PG8_BAR; PG8_SCHED;
            } else {
#if PG8_STAGE_FIRST
            PG8_STAGE(PG8_SA(1, 1), a1 + hstepA, voffA); PG8_SCHED; PG8_LDB(B0, 0, 0); PG8_LDB(B1, 0, 1); PG8_SCHED; PG8_LDA(At, 0, 0);
            PG8_WAIT_V(8); PG8_WAIT_L(0); PG8_BAR; PG8_MMA(0, 0, At, B0); PG8_MMA(0, 1, At, B1); PG8_BAR; PG8_SCHED;
            PG8_STAGE(PG8_SB(0, 0), b2, voffB); PG8_STAGE(PG8_SB(0, 1), b2 + hstepB, voffB); PG8_STAGE(PG8_SA(0, 0), a2, voffA); PG8_SCHED; PG8_LDA(At, 0, 1);
            PG8_WAIT_V(8); PG8_WAIT_L(0); PG8_BAR; PG8_MMA(1, 0, At, B0); PG8_MMA(1, 1, At, B1); PG8_BAR; PG8_SCHED;
            PG8_STAGE(PG8_SA(0, 1), a2 + hstepA, voffA); PG8_SCHED; PG8_LDB(B0, 1, 0); PG8_LDB(B1, 1, 1); PG8_SCHED; PG8_LDA(At, 1, 0);
            PG8_WAIT_V(8); PG8_WAIT_L(0); PG8_BAR; PG8_MMA(0, 0, At, B0); PG8_MMA(0, 1, At, B1); PG8_BAR; PG8_SCHED;
            PG8_STAGE(PG8_SB(1, 0), b3, voffB); PG8_STAGE(PG8_SB(1, 1), b3 + hstepB, voffB); PG8_STAGE(PG8_SA(1, 0), a3, voffA); PG8_SCHED; PG8_LDA(At, 1, 1);
            PG8_WAIT_V(8); PG8_WAIT_L(0); PG8_BAR; PG8_MMA(1, 0, At, B0); PG8_MMA(1, 1, At, B1); PG8_BAR; PG8_SCHED;
#else
#define PG8_PF(tt) do { if constexpr (L2PF) { const int tp_ = (tt) + 4 < nt ? (tt) + 4 : nt - 1; const bool isA_ = wu < 4; \
                const int r_ = (wu & 3) * 64 + opaque_lane(); const unsigned o_ = ((r_ >> pf_sh) == pf_id) ? (unsigned)r_ * ((unsigned)(isA_ ? g.lda : g.ldb) * 2u) : 0u; \
                const unsigned m0v_ = (unsigned)(size_t)lds + 131072u + (unsigned)wu * 256u; \
                asm volatile("s_mov_b32 m0, %0\n\ts_nop 0\n\tglobal_load_lds_dword %1, %2" :: "s"(m0v_), "v"(o_), "s"((isA_ ? cA : cB) + (size_t)tp_ * kstep) : "memory", "m0"); } } while (0)
#define PG8_WAIT_VP() do { if constexpr (L2PF) PG8_WAIT_V(9); else PG8_WAIT_V(8); } while (0)
#define PG8_WAIT_VF() do { if constexpr (Epi::NVM > 0 && !L2PF) { if (t == 0 && ui > 0) asm volatile("s_waitcnt vmcnt(%0)" :: "i"(8 + Epi::NVM) : "memory"); else PG8_WAIT_V(8); } else PG8_WAIT_VP(); } while (0)
            if constexpr (Epi::HAS_PF) { if (t == tpf) { E.prefetch(cur, wu, opaque_lane()); PG8_SCHED; } }
            PG8_PF(t); PG8_SCHED; PG8_LDB(B0, 0, 0); PG8_LDB(B1, 0, 1); PG8_SCHED; PG8_LDA(At, 0, 0); PG8_STAGE(PG8_SA(1, 1), a1 + hstepA, voffA);
            PG8_WAIT_VF(); PG8_WAIT_L(0); PG8_BAR; PG8_MMA(0, 0, At, B0); PG8_MMA(0, 1, At, B1); PG8_BAR; PG8_SCHED;
            PG8_LDA(At, 0, 1); PG8_STAGE(PG8_SB(0, 0), b2, voffB); PG8_STAGE(PG8_SB(0, 1), b2 + hstepB, voffB); PG8_STAGE(PG8_SA(0, 0), a2, voffA);
            PG8_WAIT_VF(); PG8_WAIT_L(0); PG8_BAR; PG8_MMA(1, 0, At, B0); PG8_MMA(1, 1, At, B1); PG8_BAR; PG8_SCHED;
            PG8_PF(t + 1); PG8_SCHED; PG8_LDB(B0, 1, 0); PG8_LDB(B1, 1, 1); PG8_SCHED; PG8_LDA(At, 1, 0); PG8_STAGE(PG8_SA(0, 1), a2 + hstepA, voffA);
            PG8_WAIT_VP(); PG8_WAIT_L(0); PG8_BAR; PG8_MMA(0, 0, At, B0); PG8_MMA(0, 1, At, B1); PG8_BAR; PG8_SCHED;
            PG8_LDA(At, 1, 1); PG8_STAGE(PG8_SB(1, 0), b3, voffB); PG8_STAGE(PG8_SB(1, 1), b3 + hstepB, voffB); PG8_STAGE(PG8_SA(1, 0), a3, voffA);
            PG8_WAIT_VP(); PG8_WAIT_L(0); PG8_BAR; PG8_MMA(1, 0, At, B0); PG8_MMA(1, 1, At, B1); PG8_BAR; PG8_SCHED;
#undef PG8_PF
#undef PG8_WAIT_VP
#undef PG8_WAIT_VF
#endif
            }
        }
        if constexpr (ALIGN_EPI) { if (wr == 0) PG8_BAR; }
        { const int te = opaque_lane(); E(acc, cur, wr, wc, te & 15, (te >> 4) & 3); }
        if (!has_next) break;
#pragma unroll
        for (int a = 0; a < 2; ++a)
#pragma unroll
            for (int b = 0; b < 2; ++b)
#pragma unroll
                for (int m = 0; m < 4; ++m)
#pragma unroll
                    for (int n = 0; n < 2; ++n) acc[a][b][m][n] = (f32x4){0.f, 0.f, 0.f, 0.f};
        cur = nxt; cA = nA; cB = nB; ++ui;
        if constexpr (ALIGN_EPI) { if (wr == 1) PG8_BAR; }
    }
    PG8_WAIT_V(0);
    if constexpr (!ALIGN_EPI) { if (wr == 0) PG8_BAR; }
    PG8_BAR;
#undef PG8_SA
#undef PG8_SB
#undef PG8_STAGE
#undef PG8_LDA
#undef PG8_LDB
#undef PG8_MMA
#undef PG8_WAIT_V
#undef PG8_WAIT_L
#undef PG8_BAR
#undef PG8_SCHED
}

__device__ __forceinline__ u32x4 pack8bf(const f32x4& a, const f32x4& b) { u32x4 w; w.x = cvt_pk_bf16(a[0], a[1]); w.y = cvt_pk_bf16(a[2], a[3]); w.z = cvt_pk_bf16(b[0], b[1]); w.w = cvt_pk_bf16(b[2], b[3]); return w; }
__device__ __forceinline__ float sumsq4(const f32x4& a) { return (a[0] * a[0] + a[1] * a[1]) + (a[2] * a[2] + a[3] * a[3]); }

struct EpiRes {
    const float* xin32; const bf16_t* xin16; float* xout32; bf16_t* xout16; unsigned char* xlo; const float* gate; const float* gm0; bf16_t* a0; const float* gm1; bf16_t* a1; rs_t* rowss;
    unsigned pfl;
    static constexpr bool HAS_PF = EPI_RES_PF != 0;
    static constexpr int NVM = EPI_RELAX ? 32 : 0;
    __device__ __forceinline__ void prefetch(const Unit& u, int wv_  , int ln_) const {
        if (pfl && !xin32 && XBF16 == 2) {
            const unsigned prow = (unsigned)(u.pm * BM + (wv_ & 1) * HALF + (wv_ >> 2) * 64 + ln_);
            const unsigned oh0 = (prow * DM + (unsigned)(u.pn * BM + ((wv_ >> 1) & 1) * 64)) * 2u, oh1 = oh0 + 256u;
            const unsigned ol = prow * DM + (unsigned)(u.pn * BM + ((wv_ >> 1) & 1) * HALF);
            const unsigned m0v = pfl + (unsigned)wv_ * 256u;
            asm volatile("s_mov_b32 m0, %0\n\ts_nop 0\n\tglobal_load_lds_dword %1, %4\n\tglobal_load_lds_dword %2, %4\n\tglobal_load_lds_dword %3, %5"
                         :: "s"(m0v), "v"(oh0), "v"(oh1), "v"(ol), "s"(xin16), "s"(xlo) : "memory", "m0");
        }
    }
    __device__ __forceinline__ void operator()(const f32x4 (&acc)[2][2][4][2], const Unit& u, int wr, int wc, int fr, int fq) const {
        const int b = u.pm >> 4; const int row0 = u.pm * BM + wr * 64 + fr;
        float ss[2][4];
#pragma unroll
        for (int ai = 0; ai < 2; ++ai)
#pragma unroll
            for (int m = 0; m < 4; ++m) ss[ai][m] = 0.f;
#pragma unroll
        for (int bj = 0; bj < 2; ++bj) {
            const int col = u.pn * BM + bj * HALF + wc * 32 + 8 * fq; const int vo = b * DM + col;
            const f32x4 g0 = *(const f32x4*)(gate + vo), g1 = *(const f32x4*)(gate + vo + 4);
            f32x4 m00 = {0, 0, 0, 0}, m01 = {0, 0, 0, 0}, m10 = {0, 0, 0, 0}, m11 = {0, 0, 0, 0};
            if (a0) { m00 = *(const f32x4*)(gm0 + vo); m01 = *(const f32x4*)(gm0 + vo + 4); }
            if (a1) { m10 = *(const f32x4*)(gm1 + vo); m11 = *(const f32x4*)(gm1 + vo + 4); }
#if EPI_RES_2G
            u32x4 xr2[4];
            if (!xin32) {
#pragma unroll
                for (int m = 0; m < 4; ++m) { const size_t off = (size_t)(row0 + HALF + m * 16) * DM + col; xr2[m] = *(const u32x4*)(xin16 + off); }
            }
#endif
#pragma unroll
            for (int ai = 0; ai < 2; ++ai) {
                f32x4 xv[4][2];
                if (xin32) {
#pragma unroll
                    for (int m = 0; m < 4; ++m) { const size_t off = (size_t)(row0 + ai * HALF + m * 16) * DM + col; xv[m][0] = *(const f32x4*)(xin32 + off); xv[m][1] = *(const f32x4*)(xin32 + off + 4); }
                } else {
                    u32x4 xr[4]; u32x2 xl[4];
#if EPI_RES_2G
#pragma unroll
                    for (int m = 0; m < 4; ++m) { const size_t off = (size_t)(row0 + ai * HALF + m * 16) * DM + col; if (ai == 0) xr[m] = *(const u32x4*)(xin16 + off); else xr[m] = xr2[m];
                        if (XBF16 == 2) xl[m] = *(const u32x2*)(xlo + off); }
#else
#pragma unroll
                    for (int m = 0; m < 4; ++m) { const size_t off = (size_t)(row0 + ai * HALF + m * 16) * DM + col; xr[m] = *(const u32x4*)(xin16 + off);
                        if (XBF16 == 2) xl[m] = *(const u32x2*)(xlo + off); }
#endif
#pragma unroll
                    for (int m = 0; m < 4; ++m) { if (XBF16 == 2) x8_unpack24(xr[m], xl[m], xv[m][0], xv[m][1]); else x8_unpack16(xr[m], xv[m][0], xv[m][1]); }
                }
#pragma unroll
                for (int m = 0; m < 4; ++m) {
                    const size_t off = (size_t)(row0 + ai * HALF + m * 16) * DM + col;
                    const f32x4 v0 = xv[m][0] + g0 * acc[ai][bj][m][0], v1 = xv[m][1] + g1 * acc[ai][bj][m][1];
                    if (xout32) { *(f32x4*)(xout32 + off) = v0; *(f32x4*)(xout32 + off + 4) = v1; }
                    else if (XBF16 == 2) { u32x4 hh; u32x2 ll; x8_pack24(v0, v1, hh, ll); st_stream((u32x4*)(xout16 + off), hh); st_stream((u32x2*)(xlo + off), ll); }
                    else *(u32x4*)(xout16 + off) = pack8bf(v0, v1);
                    ss[ai][m] += sumsq4(v0) + sumsq4(v1);
                    if (a0) *(u32x4*)(a0 + off) = pack8bf(v0 * m00, v1 * m01);
                    if (a1) *(u32x4*)(a1 + off) = pack8bf(v0 * m10, v1 * m11);
                }
            }
        }
        if (rowss) {
#pragma unroll
            for (int ai = 0; ai < 2; ++ai)
#pragma unroll
                for (int m = 0; m < 4; ++m) { float s = ss[ai][m]; s += swz_xor16(s); s = add_xor32(s); if (fq == 0) rs_add(rowss + row0 + ai * HALF + m * 16, s); }
        }
    }
};

struct EpiNull { float* sink;
    static constexpr bool HAS_PF = false; __device__ __forceinline__ void prefetch(const Unit&, int, int) const {} static constexpr int NVM = 0;
    __device__ __forceinline__ void operator()(const f32x4 (&acc)[2][2][4][2], const Unit& u, int wr, int wc, int fr, int fq) const {
        f32x4 t = {0.f, 0.f, 0.f, 0.f};
#pragma unroll
        for (int ai = 0; ai < 2; ++ai)
#pragma unroll
            for (int bj = 0; bj < 2; ++bj)
#pragma unroll
                for (int m = 0; m < 4; ++m) t += acc[ai][bj][m][0] + acc[ai][bj][m][1];
        *(f32x4*)(sink + ((size_t)(blockIdx.x * 512 + threadIdx.x) * 4)) = t;
    }
};

struct EpiSwi {
    static constexpr bool HAS_PF = false; __device__ __forceinline__ void prefetch(const Unit&, int, int) const {} static constexpr int NVM = EPI_RELAX ? 16 : 0;
    const rs_t* rowss; const float* bias; bf16_t* act;
    __device__ __forceinline__ void operator()(const f32x4 (&acc)[2][2][4][2], const Unit& u, int wr, int wc, int fr, int fq) const {
        const int b = u.pm >> 4; const int row0 = u.pm * BM + wr * 64 + fr;
        const int vc = u.pn * BM + wc * 32 + 8 * fq; const int ac = u.pn * HALF + wc * 32 + 8 * fq;
        const float* bp = bias + (size_t)b * 11264 + vc;
        const f32x4 bg0 = *(const f32x4*)bp, bg1 = *(const f32x4*)(bp + 4), bu0 = *(const f32x4*)(bp + HALF), bu1 = *(const f32x4*)(bp + HALF + 4);
        const f32x4 bgl0 = bg0 * -1.4426950408889634f, bgl1 = bg1 * -1.4426950408889634f;
        float rsv[8];
#pragma unroll
        for (int r = 0; r < 8; ++r) rsv[r] = rs_get(rowss + row0 + (r >> 2) * HALF + (r & 3) * 16);
#pragma unroll
        for (int ai = 0; ai < 2; ++ai)
#pragma unroll
            for (int m = 0; m < 4; ++m) {
                const int row = row0 + ai * HALF + m * 16;
                const float rstd = rsqrtf(rsv[ai * 4 + m] * (1.f / DM) + EPS);
                const float rl = rstd * -1.4426950408889634f;
                const f32x4 ga = acc[ai][0][m][0] * rstd + bg0, gb = acc[ai][0][m][1] * rstd + bg1, ua = acc[ai][1][m][0] * rstd + bu0, ub = acc[ai][1][m][1] * rstd + bu1;
                f32x4 ea = acc[ai][0][m][0] * rl + bgl0, eb = acc[ai][0][m][1] * rl + bgl1;
#pragma unroll
                for (int j = 0; j < 4; ++j) { ea[j] = __builtin_amdgcn_exp2f(ea[j]); eb[j] = __builtin_amdgcn_exp2f(eb[j]); }
                ea = ea + 1.f; eb = eb + 1.f;
#pragma unroll
                for (int j = 0; j < 4; ++j) { ea[j] = __builtin_amdgcn_rcpf(ea[j]); eb[j] = __builtin_amdgcn_rcpf(eb[j]); }
                const f32x4 r0 = (ga * ua) * ea, r1 = (gb * ub) * eb;
                st_stream((u32x4*)(act + (size_t)row * FF + ac), pack8bf(r0, r1));
            }
    }
};

struct EpiDown {
    static constexpr bool HAS_PF = false; __device__ __forceinline__ void prefetch(const Unit&, int, int) const {} static constexpr int NVM = 0;
    const rs_t* rowss1; const float* bias; int ldbias; int pn_q0;
    unsigned char* ws; rs_t* rsb; int rsq;
    const float2* tab;
    __device__ __forceinline__ void operator()(const f32x4 (&acc)[2][2][4][2], const Unit& u, int wr, int wc, int fr, int fq) const {
        const int b = u.pm >> 4; const int row0 = u.pm * BM + wr * 64 + fr;
        const float* bp = bias + (size_t)b * ldbias + u.pn * BM + wc * 32 + 8 * fq;
        const f32x4 b00 = *(const f32x4*)bp, b01 = *(const f32x4*)(bp + 4), b10 = *(const f32x4*)(bp + HALF), b11 = *(const f32x4*)(bp + HALF + 4);
        const bool is_q = u.pn >= pn_q0;
        if (is_q || u.pn < 2) {
            bf16_t* dst = (bf16_t*)(ws + (is_q ? WS_CQ : WS_CKV)); rs_t* rs = rsb + (size_t)(is_q ? rsq : RS_KV) * 16384;
            const int col = (is_q ? (u.pn - pn_q0) : u.pn) * BM + wc * 32 + 8 * fq;
#pragma unroll
            for (int ai = 0; ai < 2; ++ai)
#pragma unroll
                for (int m = 0; m < 4; ++m) {
                    const int row = row0 + ai * HALF + m * 16;
                    const float rstd = rsqrtf(rs_get(rowss1 + row) * (1.f / DM) + EPS);
                    const f32x4 v00 = acc[ai][0][m][0] * rstd + b00, v01 = acc[ai][0][m][1] * rstd + b01, v10 = acc[ai][1][m][0] * rstd + b10, v11 = acc[ai][1][m][1] * rstd + b11;
                    *(u32x4*)(dst + (size_t)row * 512 + col) = pack8bf(v00, v01);
                    *(u32x4*)(dst + (size_t)row * 512 + col + HALF) = pack8bf(v10, v11);
                    float s = (sumsq4(v00) + sumsq4(v01)) + (sumsq4(v10) + sumsq4(v11));
                    s += swz_xor16(s); s = add_xor32(s); if (fq == 0) rs_add(rs + row, s);
                }
        } else if (wc == 0) {
            bf16_t* kr = (bf16_t*)(ws + WS_KR);
#pragma unroll
            for (int ai = 0; ai < 2; ++ai)
#pragma unroll
                for (int m = 0; m < 4; ++m) {
                    const int row = row0 + ai * HALF + m * 16;
                    const float rstd = rsqrtf(rs_get(rowss1 + row) * (1.f / DM) + EPS);
                    const f32x4 t10 = acc[ai][0][m][0] * rstd + b00, t11 = acc[ai][0][m][1] * rstd + b01, t20 = acc[ai][1][m][0] * rstd + b10, t21 = acc[ai][1][m][1] * rstd + b11;
                    const float2* tp = tab + (size_t)row * 32 + 8 * fq;
                    f32x4 o10, o11, o20, o21;
#pragma unroll
                    for (int j = 0; j < 4; ++j) { const float2 ca = tp[j], cb = tp[4 + j];
                        o10[j] = t10[j] * ca.x - t20[j] * ca.y; o20[j] = t20[j] * ca.x + t10[j] * ca.y;
                        o11[j] = t11[j] * cb.x - t21[j] * cb.y; o21[j] = t21[j] * cb.x + t11[j] * cb.y; }
                    *(u32x4*)(kr + (size_t)row * 64 + 8 * fq) = pack8bf(o10, o11);
                    *(u32x4*)(kr + (size_t)row * 64 + 32 + 8 * fq) = pack8bf(o20, o21);
                }
        }
    }
};

struct EpiUp {
    static constexpr bool HAS_PF = false; __device__ __forceinline__ void prefetch(const Unit&, int, int) const {} static constexpr int NVM = EPI_RELAX ? 16 : 0;
    unsigned char* ws; const rs_t* rsb; int rsq; int pn_q0; const float2* tab;
    __device__ __forceinline__ void operator()(const f32x4 (&acc)[2][2][4][2], const Unit& u, int wr, int wc, int fr, int fq) const {
        const int row0 = u.pm * BM + wr * 64 + fr;
        const bool is_q = u.pn >= pn_q0; const int p = is_q ? u.pn - pn_q0 : u.pn;
        const rs_t* rs = rsb + (size_t)(is_q ? rsq : RS_KV) * 16384;
        if (!(is_q && p >= 8)) {
            bf16_t* dst = (bf16_t*)(ws + (is_q ? WS_QN : (p < 8 ? WS_KN : WS_V)));
            const int col = (p & 7) * BM + wc * 32 + 8 * fq;
#pragma unroll
            for (int ai = 0; ai < 2; ++ai)
#pragma unroll
                for (int m = 0; m < 4; ++m) {
                    const int row = row0 + ai * HALF + m * 16;
                    const float rstd = rsqrtf(rs_get(rs + row) * (1.f / 512.f) + EPS);
                    st_stream((u32x4*)(dst + (size_t)row * DM + col), pack8bf(acc[ai][0][m][0] * rstd, acc[ai][0][m][1] * rstd));
                    st_stream((u32x4*)(dst + (size_t)row * DM + col + HALF), pack8bf(acc[ai][1][m][0] * rstd, acc[ai][1][m][1] * rstd));
                }
        } else {
            bf16_t* qr = (bf16_t*)(ws + WS_QR);
            const int hh = 4 * (p - 8) + wc;
#pragma unroll
            for (int ai = 0; ai < 2; ++ai)
#pragma unroll
                for (int m = 0; m < 4; ++m) {
                    const int row = row0 + ai * HALF + m * 16;
                    const float rstd = rsqrtf(rs_get(rs + row) * (1.f / 512.f) + EPS);
                    const f32x4 t10 = acc[ai][0][m][0] * rstd, t11 = acc[ai][0][m][1] * rstd, t20 = acc[ai][1][m][0] * rstd, t21 = acc[ai][1][m][1] * rstd;
                    const float2* tp = tab + (size_t)row * 32 + 8 * fq;
                    f32x4 o10, o11, o20, o21;
#pragma unroll
                    for (int j = 0; j < 4; ++j) { const float2 ca = tp[j], cb = tp[4 + j];
                        o10[j] = t10[j] * ca.x - t20[j] * ca.y; o20[j] = t20[j] * ca.x + t10[j] * ca.y;
                        o11[j] = t11[j] * cb.x - t21[j] * cb.y; o21[j] = t21[j] * cb.x + t11[j] * cb.y; }
                    st_stream((u32x4*)(qr + (size_t)row * 1024 + hh * 64 + 8 * fq), pack8bf(o10, o11));
                    st_stream((u32x4*)(qr + (size_t)row * 1024 + hh * 64 + 32 + 8 * fq), pack8bf(o20, o21));
                }
        }
    }
};
}
namespace att {
constexpr int D = 128, DQK = 192, NW = 8, QBLK = 32, KVBLK = 64, QB = NW * QBLK;
constexpr int LDQ = 2048, LDQR = 1024, LDKR = 64;
constexpr float SCALE = 0.07216878364870322f;
constexpr float THR = 8.f;
constexpr int KROW = 400;
constexpr int SHM_V = KVBLK * D * 2, SHM_K = KVBLK * KROW;
constexpr int NVS = 3;
constexpr int K_LDS_OFF = NVS * SHM_V, WS_LDS_OFF = K_LDS_OFF + 2 * SHM_K;
constexpr int QR_LDS_OFF = WS_LDS_OFF + NW * 64 * 4;
constexpr int ATT_LDS_BYTES = QR_LDS_OFF + NW * 4096;
constexpr int PF_LDS_OFF = ATT_LDS_BYTES;
static_assert(ATT_LDS_BYTES + 2048 <= MISC_OFF, "attention LDS map");
#ifndef ATT_SKIP
#define ATT_SKIP 1
#endif
#ifndef ATT_SWAP
#define ATT_SWAP 3
#endif
#define SBAR() __builtin_amdgcn_sched_barrier(0)
__device__ __forceinline__ int v_st(int k, int c) { const int kk = (k & ~0xC) | ((k & 4) << 1) | ((k & 8) >> 1); return ((kk >> 3) * 4 + (c >> 5)) * 512 + ((kk & 7) * 32 + (c & 31)) * 2; }
__device__ __forceinline__ int v_rd_base(int lane) { return ((lane & 3) << 3) | (((lane >> 2) & 3) << 6) | (((lane >> 4) & 1) << 5) | (((lane >> 5) & 1) << 8); }
constexpr int v_rd_off(int d0, int ks, int half) { return d0 * 512 + ks * 4096 + half * 2048; }
__device__ __forceinline__ int crow(int r, int hi) { return (r & 3) + 8 * (r >> 2) + 4 * hi; }
__device__ __forceinline__ unsigned cvtpk(float lo, float hi) { unsigned r; asm volatile("v_cvt_pk_bf16_f32 %0, %1, %2" : "=v"(r) : "v"(lo), "v"(hi)); return r; }
__device__ __forceinline__ bf16x8 load8(const bf16_t* p) { return *reinterpret_cast<const bf16x8*>(p); }
__device__ __forceinline__ void mask_tile(f32x16& p0, f32x16& p1, int dq) {
    const float NEG = -__builtin_inff();
#pragma unroll
    for (int r = 0; r < 16; ++r) {
        const int c = (r & 3) + 8 * (r >> 2);
        if (dq - c < 0) p0[r] = NEG;
        if (dq - c - 32 < 0) p1[r] = NEG;
    }
}
__device__ __forceinline__ void partialSM(f32x16& p0, f32x16& p1, float& m_reg, float& mn, float& alpha) {
    float pmax = p0[0]; for (int r = 1; r < 16; ++r) pmax = fmaxf(pmax, p0[r]); for (int r = 0; r < 16; ++r) pmax = fmaxf(pmax, p1[r]);
    { auto rr = __builtin_amdgcn_permlane32_swap(__float_as_uint(pmax), __float_as_uint(pmax), false, false);
      pmax = fmaxf(__uint_as_float(rr[0]), __uint_as_float(rr[1])); }
    constexpr float C2 = 1.4426950408889634f * SCALE;
    if (__builtin_expect(__all((pmax - m_reg) * SCALE <= THR), 1)) { mn = m_reg; alpha = 1.f; }
    else { mn = fmaxf(m_reg, pmax); alpha = __builtin_amdgcn_exp2f((m_reg - mn) * C2); m_reg = mn; }
    const float mnL = -mn * C2;
    for (int r = 0; r < 16; ++r) p0[r] = fmaf(p0[r], C2, mnL); for (int r = 0; r < 16; ++r) p1[r] = fmaf(p1[r], C2, mnL);
    for (int r = 0; r < 16; ++r) p0[r] = __builtin_amdgcn_exp2f(p0[r]);
}
__device__ __forceinline__ void finishSM(f32x16& p0, f32x16& p1, float alpha, float& l_reg, bf16x8& pa0, bf16x8& pa1, bf16x8& pa2, bf16x8& pa3) {
    for (int r = 0; r < 16; ++r) p1[r] = __builtin_amdgcn_exp2f(p1[r]);
    float ps = 0; for (int r = 0; r < 16; ++r) ps += p0[r]; for (int r = 0; r < 16; ++r) ps += p1[r];
    { auto rr = __builtin_amdgcn_permlane32_swap(__float_as_uint(ps), __float_as_uint(ps), false, false);
      ps = __uint_as_float(rr[0]) + __uint_as_float(rr[1]); }
    l_reg = l_reg * alpha + ps;
#define PK4(P, B_, OUT) do { unsigned a0 = cvtpk(P[B_+0], P[B_+1]), a1 = cvtpk(P[B_+2], P[B_+3]);                          \
        unsigned b0 = cvtpk(P[B_+4], P[B_+5]), b1 = cvtpk(P[B_+6], P[B_+7]);                                             \
        auto r0 = __builtin_amdgcn_permlane32_swap(a0, b0, false, false); auto r1 = __builtin_amdgcn_permlane32_swap(a1, b1, false, false); \
        u32x4 w = {r0[0], r1[0], r0[1], r1[1]}; OUT = *reinterpret_cast<bf16x8*>(&w); } while (0)
    PK4(p0, 0, pa0); PK4(p0, 8, pa1); PK4(p1, 0, pa2); PK4(p1, 8, pa3);
#undef PK4
}
template <int KB>
__device__ __forceinline__ void qkt(f32x16& p0, f32x16& p1, const char* K_lds, int r32, int hi, const bf16x8* qr, const char* qrl) {
    p0 = f32x16{}; p1 = f32x16{};
    const int kb0 = (int)(uintptr_t)K_lds + r32 * KROW + hi * 16;
    const int qb = (int)(uintptr_t)qrl;
    bf16x8 ka[12], kc[12], qq[4];
#define QK_LDR(dst, base, off) asm volatile("ds_read_b128 %0, %1 offset:%2" : "=&v"(dst) : "v"(base), "i"(off) : "memory")
#define QK_RD(d0) do { QK_LDR(ka[d0], kb0, KB * SHM_K + (d0) * 32); QK_LDR(kc[d0], kb0, KB * SHM_K + (d0) * 32 + 32 * KROW); \
        if ((d0) >= 8) QK_LDR(qq[(d0) >= 8 ? (d0) - 8 : 0], qb, ((d0) >= 8 ? (d0) - 8 : 0) * 1024); } while (0)
#define QK_N1(j) ((j) <= 11 ? 2 + ((j) >= 8 ? 1 : 0) : 0)
#define QK_STEP(d0) do { if ((d0) + 3 < 12) QK_RD((d0) + 3 < 12 ? (d0) + 3 : 0); \
        if ((d0) >= 8) asm volatile("s_waitcnt lgkmcnt(%3)" : "+v"(ka[d0]), "+v"(kc[d0]), "+v"(qq[(d0) >= 8 ? (d0) - 8 : 0]) : "i"(QK_N1((d0) + 1) + QK_N1((d0) + 2) + QK_N1((d0) + 3)) : "memory"); \
        else asm volatile("s_waitcnt lgkmcnt(%2)" : "+v"(ka[d0]), "+v"(kc[d0]) : "i"(QK_N1((d0) + 1) + QK_N1((d0) + 2) + QK_N1((d0) + 3)) : "memory"); \
        { const bf16x8 q = (d0) < 8 ? qr[(d0) < 8 ? (d0) : 0] : qq[(d0) >= 8 ? (d0) - 8 : 0]; \
          p0 = __builtin_amdgcn_mfma_f32_32x32x16_bf16(ka[d0], q, p0, 0, 0, 0); p1 = __builtin_amdgcn_mfma_f32_32x32x16_bf16(kc[d0], q, p1, 0, 0, 0); } } while (0)
    QK_RD(0); QK_RD(1); QK_RD(2);
    QK_STEP(0); QK_STEP(1); QK_STEP(2); QK_STEP(3); QK_STEP(4); QK_STEP(5); QK_STEP(6); QK_STEP(7); QK_STEP(8); QK_STEP(9); QK_STEP(10); QK_STEP(11);
#undef QK_STEP
#undef QK_N1
#undef QK_RD
#undef QK_LDR
}
__device__ __forceinline__ void pv_tile(f32x16* o, int vb, bf16x8 pa0, bf16x8 pa1, bf16x8 pa2, bf16x8 pa3) {
#define TRRD(dst, off) asm volatile("ds_read_b64_tr_b16 %0, %1 offset:%2" : "=&v"(dst) : "v"(vb), "i"(off) : "memory")
#define PV_RD(d0, S_) do { constexpr int b_ = v_rd_off(d0, 0, 0); \
        TRRD(S_##l0, b_); TRRD(S_##h0, b_ + 2048); TRRD(S_##l1, b_ + 4096); TRRD(S_##h1, b_ + 6144); TRRD(S_##l2, b_ + 8192); TRRD(S_##h2, b_ + 10240); TRRD(S_##l3, b_ + 12288); TRRD(S_##h3, b_ + 14336); } while (0)
#define PV_MM(d0, S_) do { \
        o[d0] = __builtin_amdgcn_mfma_f32_32x32x16_bf16(pa0, (bf16x8){S_##l0[0], S_##l0[1], S_##l0[2], S_##l0[3], S_##h0[0], S_##h0[1], S_##h0[2], S_##h0[3]}, o[d0], 0, 0, 0);   \
        o[d0] = __builtin_amdgcn_mfma_f32_32x32x16_bf16(pa1, (bf16x8){S_##l1[0], S_##l1[1], S_##l1[2], S_##l1[3], S_##h1[0], S_##h1[1], S_##h1[2], S_##h1[3]}, o[d0], 0, 0, 0);   \
        o[d0] = __builtin_amdgcn_mfma_f32_32x32x16_bf16(pa2, (bf16x8){S_##l2[0], S_##l2[1], S_##l2[2], S_##l2[3], S_##h2[0], S_##h2[1], S_##h2[2], S_##h2[3]}, o[d0], 0, 0, 0);   \
        o[d0] = __builtin_amdgcn_mfma_f32_32x32x16_bf16(pa3, (bf16x8){S_##l3[0], S_##l3[1], S_##l3[2], S_##l3[3], S_##h3[0], S_##h3[1], S_##h3[2], S_##h3[3]}, o[d0], 0, 0, 0); } while (0)
#define PV_WAIT(n, S_) asm volatile("s_waitcnt lgkmcnt(%8)" : "+v"(S_##l0), "+v"(S_##h0), "+v"(S_##l1), "+v"(S_##h1), "+v"(S_##l2), "+v"(S_##h2), "+v"(S_##l3), "+v"(S_##h3) : "i"(n) : "memory")
    s16x4 Al0, Al1, Al2, Al3, Ah0, Ah1, Ah2, Ah3, Bl0, Bl1, Bl2, Bl3, Bh0, Bh1, Bh2, Bh3;
    PV_RD(0, A); PV_RD(1, B); PV_WAIT(8, A); PV_MM(0, A);
    PV_RD(2, A); PV_WAIT(8, B); PV_MM(1, B);
    PV_RD(3, B); PV_WAIT(8, A); PV_MM(2, A);
    PV_WAIT(0, B); PV_MM(3, B);
#undef PV_WAIT
#undef PV_MM
#undef PV_RD
#undef TRRD
}

struct BlockRef { unsigned char* wsb; int tok0, row0, h, P0; };
#define T_QN(R_) ((const bf16_t*)((R_).wsb + WS_QN) + (size_t)(R_).row0 * LDQ + (R_).h * 128)
#define T_QR(R_) ((const bf16_t*)((R_).wsb + WS_QR) + (size_t)(R_).row0 * LDQR + (R_).h * 64)
#define T_KN(R_) ((const bf16_t*)((R_).wsb + WS_KN) + (size_t)(R_).tok0 * LDQ + (R_).h * 128)
#define T_KR(R_) ((const bf16_t*)((R_).wsb + WS_KR) + (size_t)(R_).tok0 * LDKR)
#define T_V(R_)  ((const bf16_t*)((R_).wsb + WS_V) + (size_t)(R_).tok0 * LDQ + (R_).h * 128)
#define T_O(R_)  ((bf16_t*)((R_).wsb + WS_O) + (size_t)(R_).row0 * LDQ + (R_).h * 128)
struct Seam { bf16x8 qr[8]; };
#define VMW() asm volatile("s_waitcnt vmcnt(0)" ::: "memory")
#ifndef ATT_PF
#define ATT_PF 1
#endif
#if ATT_PF
#define DMA_ASM(m0v, voff, OP) asm volatile("s_mov_b32 m0, %0\n\ts_nop 0\n\t" OP " %1, %2" :: "s"(m0v), "v"(voff), "s"(cur.wsb) : "memory", "m0")
#define DMA_TILE(k0, kbf, vslot) do { _Pragma("unroll") for (int i_ = 0; i_ < 4; ++i_) if (i_ < 3 || wid == 0) { \
            const unsigned m0_ = ldsb_ + (unsigned)(K_LDS_OFF + (kbf) * SHM_K + (wid + 8 * i_) * 1024); DMA_ASM(m0_, kdo[i_] + (unsigned)(k0) * kds[i_], "global_load_lds_dwordx4"); } \
        _Pragma("unroll") for (int i_ = 0; i_ < 2; ++i_) { const unsigned m0_ = ldsb_ + (unsigned)((vslot) * SHM_V + (wid * 2 + i_) * 1024); DMA_ASM(m0_, vdo[i_] + (unsigned)(k0) * 4096u, "global_load_lds_dwordx4"); } } while (0)
#define DMA_K(k0, kbf) do { _Pragma("unroll") for (int i_ = 0; i_ < 4; ++i_) if (i_ < 3 || wid == 0) { \
            const unsigned m0_ = ldsb_ + (unsigned)(K_LDS_OFF + (kbf) * SHM_K + (wid + 8 * i_) * 1024); DMA_ASM(m0_, kdo[i_] + (unsigned)(k0) * kds[i_], "global_load_lds_dwordx4"); } } while (0)
#define DMA_V(k0, vslot) do { _Pragma("unroll") for (int i_ = 0; i_ < 2; ++i_) { const unsigned m0_ = ldsb_ + (unsigned)((vslot) * SHM_V + (wid * 2 + i_) * 1024); DMA_ASM(m0_, vdo[i_] + (unsigned)(k0) * 4096u, "global_load_lds_dwordx4"); } } while (0)
#if ATT_PF >= 2
#define PF_TILE(k0) do { const unsigned m0_ = ldsb_ + (unsigned)(PF_LDS_OFF + wid * 256); DMA_ASM(m0_, pfo_ + (unsigned)(k0) * pfs_, "global_load_lds_dword"); } while (0)
#define PFN 1
#else
#define PF_TILE(k0) do { (void)pfo_; (void)pfs_; } while (0)
#define PFN 0
#endif
#define VMW1() asm volatile("s_waitcnt vmcnt(%0)" :: "i"(PFN) : "memory")
#define VMW3() asm volatile("s_waitcnt vmcnt(%0)" :: "i"(2 + PFN) : "memory")
#else
#define DMA_TILE(k0, kbf, vslot) do { _Pragma("unroll") for (int i_ = 0; i_ < 4; ++i_) if (i_ < 3 || wid == 0) \
            __builtin_amdgcn_global_load_lds((const unsigned*)(cur.wsb + (size_t)kdo[i_] + (size_t)(k0) * kds[i_]), (LAS unsigned*)(lds + K_LDS_OFF + (kbf) * SHM_K + (wid + 8 * i_) * 1024), 16, 0, 0); \
        _Pragma("unroll") for (int i_ = 0; i_ < 2; ++i_) \
            __builtin_amdgcn_global_load_lds((const unsigned*)(cur.wsb + (size_t)vdo[i_] + (size_t)(k0) * 4096), (LAS unsigned*)(lds + (vslot) * SHM_V + (wid * 2 + i_) * 1024), 16, 0, 0); } while (0)
#define PF_TILE(k0) do { } while (0)
#define VMW1() do { } while (0)
#define VMW3() do { } while (0)
#endif
#define QLOAD(R_) do { _Pragma("unroll") for (int d0 = 0; d0 < 8; ++d0) S.qr[d0] = load8(T_QN(R_) + (size_t)(wid * QBLK + r32) * LDQ + d0 * 16 + hi * 8); \
                       _Pragma("unroll") for (int d0 = 0; d0 < 4; ++d0) *(bf16x8*)(qrl + d0 * 1024) = load8(T_QR(R_) + (size_t)(wid * QBLK + r32) * LDQR + d0 * 16 + hi * 8); } while (0)

template <bool SWAP>
__device__ __forceinline__ void block_t(const BlockRef& cur, char* lds, int wv) {
    const int tid = opaque_tid(wv), wid = wv, lane = tid & 63, r32 = lane & 31, hi = lane >> 5;
    const int NT = cur.P0 / KVBLK + QB / KVBLK;
    const int qlo = cur.P0 + wid * QBLK, qm = qlo + r32 - 4 * hi;
    char* V_lds = lds; char* K_lds = lds + K_LDS_OFF;
    float* ws = (float*)(lds + WS_LDS_OFF) + wid * 64; float* li_l = ws, * al_l = ws + 32;
    Seam S;
    unsigned kdo[4], kds[4], vdo[2];
#pragma unroll
    for (int i = 0; i < 4; ++i) { const int L = (wid + 8 * i) * 1024 + lane * 16, row = (L / KROW) & 63, pos = L % KROW, c = pos < 384 ? pos >> 4 : 0;
        const bool rope = c >= 16;
        kdo[i] = rope ? (unsigned)(WS_KR + ((size_t)(cur.tok0 + row) * LDKR + (c - 16) * 8) * 2) : (unsigned)(WS_KN + ((size_t)(cur.tok0 + row) * LDQ + cur.h * 128 + c * 8) * 2);
        kds[i] = rope ? (unsigned)(LDKR * 2) : (unsigned)(LDQ * 2); }
#pragma unroll
    for (int i = 0; i < 2; ++i) { const int L = (wid * 2 + i) * 1024 + lane * 16, st = L >> 9, in = L & 511, kk = (st >> 2) * 8 + (in >> 6), k = (kk & ~0xC) | ((kk & 4) << 1) | ((kk & 8) >> 1), col = (st & 3) * 32 + ((in & 63) >> 1);
        vdo[i] = (unsigned)(WS_V + ((size_t)(cur.tok0 + k) * LDQ + cur.h * 128 + col) * 2); }
    const int vb0 = (int)(uintptr_t)V_lds + v_rd_base(lane);
#if ATT_PF
    const unsigned ldsb_ = (unsigned)(uintptr_t)lds;
    unsigned pfo_, pfs_;
    { const int j_ = tid & 127, jr_ = tid & 63;
      if (tid < 256) { pfo_ = (unsigned)((tid < 128 ? WS_KN : WS_V) + ((size_t)(cur.tok0 + (j_ >> 1)) * LDQ + cur.h * 128 + (j_ & 1) * 64) * 2); pfs_ = 4096u; }
      else { pfo_ = (unsigned)(WS_KR + ((size_t)(cur.tok0 + jr_) * LDKR) * 2); pfs_ = (unsigned)(LDKR * 2); } }
#endif
    char* qrl = lds + QR_LDS_OFF + wid * 4096 + lane * 16;
    if (wid >= 4) __builtin_amdgcn_s_setprio(1);
    QLOAD(cur);
    DMA_TILE(0, 0, 0); PF_TILE(64);
    VMW3(); __syncthreads();
    float m_reg = -1e30f, l_reg = 0; f32x16 o[4] = {};
    f32x16 pA0, pA1, pB0, pB1; float mnA, mnB, alA, alB; bf16x8 pa0, pa1, pa2, pa3;
#define RESC(a) do { if (__any((a) < 1.f)) { if (hi == 0) al_l[r32] = (a); asm volatile("s_waitcnt lgkmcnt(0)" ::: "memory");              \
                     for (int d_ = 0; d_ < 4; ++d_) for (int r = 0; r < 16; ++r) o[d_][r] *= al_l[crow(r, hi)]; } } while (0)
#define KBASE(t) ((t) * KVBLK)
#define MASKT(P0_, P1_, t) do { const int kb_ = KBASE(t); if (kb_ + KVBLK - 1 > qlo) { asm volatile("" ::: "memory"); mask_tile(P0_, P1_, qm - kb_); } } while (0)
    int vs_prev = 0, vs_cur = 1, vs_next = 2;
    DMA_TILE(KBASE(1), 1, 1); PF_TILE(KBASE(2 < NT ? 2 : NT - 1));
    qkt<0>(pA0, pA1, K_lds, r32, hi, S.qr, qrl);
    MASKT(pA0, pA1, 0); partialSM(pA0, pA1, m_reg, mnA, alA);
    VMW3(); __syncthreads();
    const int tlast = (qlo + QBLK - 1) / KVBLK;
#define TACT(t) (!ATT_SKIP || (t) <= tlast)
#define HALF_STEP(PX0, PX1, mnX, alX, PY0, PY1, alY, t, KB) do {                                                             \
        if ((t) + 1 < NT) DMA_K(KBASE((t) + 1), (KB) ^ 1);                                                                       \
        if constexpr (SWAP) {           \
            if ((t) + 1 < NT) DMA_V(KBASE((t) + 1), vs_next);                                                                    \
            PF_TILE(KBASE((t) + 2 < NT ? (t) + 2 : NT - 1));                                                                     \
            if (TACT((t) - 1)) { finishSM(PY0, PY1, alY, l_reg, pa0, pa1, pa2, pa3);                                             \
                                 pv_tile(o, vb0 + vs_prev * SHM_V, pa0, pa1, pa2, pa3); }                                        \
            if (TACT(t)) qkt<KB>(PX0, PX1, K_lds, r32, hi, S.qr, qrl);                                                          \
        } else {                                                                                                                 \
            if (TACT(t)) qkt<KB>(PX0, PX1, K_lds, r32, hi, S.qr, qrl);                                                          \
            if ((t) + 1 < NT) DMA_V(KBASE((t) + 1), vs_next);        \
            PF_TILE(KBASE((t) + 2 < NT ? (t) + 2 : NT - 1));                                                                     \
            if (TACT((t) - 1)) { finishSM(PY0, PY1, alY, l_reg, pa0, pa1, pa2, pa3);                                             \
                                 pv_tile(o, vb0 + vs_prev * SHM_V, pa0, pa1, pa2, pa3); }                                        \
        }                                                                                                                        \
        if (TACT(t)) { MASKT(PX0, PX1, (t)); partialSM(PX0, PX1, m_reg, mnX, alX); RESC(alX); }                                  \
        { const int tmp_ = vs_prev; vs_prev = vs_cur; vs_cur = vs_next; vs_next = tmp_; }                                        \
        if ((t) + 1 < NT) VMW3(); else VMW1(); __syncthreads(); } while (0)
    for (int t = 1; t + 1 < NT; t += 2) {
        HALF_STEP(pB0, pB1, mnB, alB, pA0, pA1, alA, t, 1);
        HALF_STEP(pA0, pA1, mnA, alA, pB0, pB1, alB, t + 1, 0);
    }
    HALF_STEP(pB0, pB1, mnB, alB, pA0, pA1, alA, NT - 1, 1);
    if (TACT(NT - 1)) { finishSM(pB0, pB1, alB, l_reg, pa0, pa1, pa2, pa3);
                        pv_tile(o, vb0 + vs_prev * SHM_V, pa0, pa1, pa2, pa3); }
#undef HALF_STEP
#undef TACT
    if (hi == 0) li_l[r32] = l_reg; asm volatile("s_waitcnt lgkmcnt(0)" ::: "memory");
    float rli[16];
#pragma unroll
    for (int r = 0; r < 16; ++r) rli[r] = __builtin_amdgcn_rcpf(li_l[crow(r, hi)]);
    bf16_t* Ow = T_O(cur) + (size_t)(wid * QBLK) * LDQ;
    char* ost = lds + QR_LDS_OFF + wid * 4096;
#pragma unroll
    for (int pass = 0; pass < 2; ++pass) {
#pragma unroll
        for (int r8 = 0; r8 < 8; ++r8) { const int r = pass * 8 + r8, rl = crow(r, hi) - 16 * pass;
#pragma unroll
            for (int d0 = 0; d0 < 4; ++d0) { const float v = o[d0][r] * rli[r]; const float vn = dpp_xor1(v);
                if ((r32 & 1) == 0) *(unsigned*)(ost + rl * 256 + (d0 * 32 + r32) * 2) = cvtpk(v, vn); } }
        asm volatile("s_waitcnt lgkmcnt(0)" ::: "memory");
#pragma unroll
        for (int i = 0; i < 4; ++i) { const int c = lane + 64 * i; const u32x4 w = *(const u32x4*)(ost + c * 16);
            *(u32x4*)(Ow + (size_t)(16 * pass + (c >> 4)) * LDQ + (c & 15) * 8) = w; }
        asm volatile("s_waitcnt lgkmcnt(0)" ::: "memory");
    }
    __builtin_amdgcn_s_setprio(0);
    __syncthreads();
#undef RESC
#undef KBASE
#undef MASKT
}
__device__ __forceinline__ void block(const BlockRef& cur, char* lds, int wv) {
    if (ATT_SWAP == 1 && wv >= 4) block_t<true>(cur, lds, wv); else if (ATT_SWAP == 3 && wv < 4) block_t<true>(cur, lds, wv); else block_t<false>(cur, lds, wv);
}
#undef VMW
#undef QLOAD
#undef DMA_TILE

__device__ __forceinline__ void attn_phase(char* lds, unsigned char* wsb, int vcu, int G, int wv) {
    constexpr int total = 512;
    for (int L = vcu; L < total; L += G) {
        for (int pass = 0; pass < 2; ++pass) {
            const int bh = L >> 3, x = L & 7, b = bh >> 4, h = bh & 15, qb = pass ? 15 - x : x;
            BlockRef cur; cur.wsb = wsb; cur.tok0 = b * 4096; cur.row0 = b * 4096 + qb * QB; cur.h = h; cur.P0 = qb * QB;
            block(cur, lds, wv);
        }
    }
}
#undef T_QN
#undef T_QR
#undef T_KN
#undef T_KR
#undef T_V
#undef T_O
#undef SBAR
}
#ifndef PROBE_REP
#define PROBE_REP 0
#endif
#ifndef EPI_STAGGER
#define EPI_STAGGER 0
#endif
#ifndef IDLE_FILL
#define IDLE_FILL 1
#endif
#ifndef L2PF_FFN1
#define L2PF_FFN1 false
#endif
#ifndef L2PF_FFN2
#define L2PF_FFN2 false
#endif
#ifndef FFN1_SIM
#define FFN1_SIM false
#endif
#ifndef FFN1_SP2
#define FFN1_SP2 true
#endif
#ifndef EPI_ALIGN_RES
#define EPI_ALIGN_RES true
#endif
struct Args { const void* in[25]; float* out; unsigned char* ws; int ph_lo, ph_hi; };
struct Frame {
    LAS unsigned char* lds; volatile LAS unsigned* MISC; gu32* ctl; unsigned char* ws;
    int vcu, G, wv;
    const Args* a;
    float* xw;
    rs_t* rs;
    float* modp;
    float* modv; float* kvmod;
    float* dv; float2* tab;
};
__device__ const double kInvFreqTurns[32] = {
1.59154943091895346e-01, 1.19349370211248862e-01, 8.94994016088910133e-02, 6.71150830052272551e-02, 5.03292121044870353e-02, 3.77415847174197711e-02, 2.83021958306233987e-02, 2.12236527647776604e-02,
1.59154943091895339e-02, 1.19349370211248862e-02, 8.94994016088910237e-03, 6.71150830052272534e-03, 5.03292121044870370e-03, 3.77415847174197719e-03, 2.83021958306233987e-03, 2.12236527647776622e-03,
1.59154943091895356e-03, 1.19349370211248849e-03, 8.94994016088910237e-04, 6.71150830052272599e-04, 5.03292121044870326e-04, 3.77415847174197741e-04, 2.83021958306233954e-04, 2.12236527647776605e-04,
1.59154943091895351e-04, 1.19349370211248862e-04, 8.94994016088910182e-05, 6.71150830052272545e-05, 5.03292121044870354e-05, 3.77415847174197768e-05, 2.83021958306233961e-05, 2.12236527647776592e-05};

__device__ __forceinline__ void tr_item(const float* W, int ldw, int col0, int k0, bf16_t* dst, int ldd, int drow0, const float* kscale, LAS float* scr, int lane) {
#pragma unroll 8
    for (int i = 0; i < 32; ++i) { const int kk = 2 * i + (lane >> 5); const float* wp_ = W + (size_t)(k0 + kk) * ldw + col0 + (lane & 31); float v = NT_LOADS0 ? __builtin_nontemporal_load(wp_) : *wp_; if (kscale) v *= kscale[k0 + kk]; scr[kk * 33 + (lane & 31)] = v; }
    LDS_WAIT(); asm volatile("" ::: "memory");
    const int c = lane & 7;
#pragma unroll
    for (int j = 0; j < 4; ++j) { const int n = (lane >> 3) + 8 * j; const LAS float* s = scr + (8 * c) * 33 + n;
        u32x4 o; o.x = pk2(s[0 * 33], s[1 * 33]); o.y = pk2(s[2 * 33], s[3 * 33]); o.z = pk2(s[4 * 33], s[5 * 33]); o.w = pk2(s[6 * 33], s[7 * 33]);
        *(GAS u32x4*)(dst + (size_t)(drow0 + n) * ldd + k0 + 8 * c) = o; }
    LDS_WAIT(); asm volatile("" ::: "memory");
}
__device__ __forceinline__ void modgemv_item(const float* c, const float* W, int N, const float* bias, float* out  , int n0, int kc, LAS float* scr, int lane) {
    const int kb = kc * 256;
#pragma unroll
    for (int j = 0; j < 16; ++j) { const int e = lane + 64 * j; const int b = e >> 8, kk = e & 255; const float v = c[b * 2048 + kb + kk]; scr[e] = v / (1.f + __expf(-v)); }
    LDS_WAIT(); asm volatile("" ::: "memory");
    f32x4 a0 = {0, 0, 0, 0}, a1 = a0, a2 = a0, a3 = a0;
    const float* wp = W + (size_t)kb * N + n0 + 4 * lane;
#pragma unroll 8
    for (int kk = 0; kk < 256; ++kk) { const f32x4 w = NT_LOADS0 ? __builtin_nontemporal_load((const f32x4*)(wp + (size_t)kk * N)) : *(const f32x4*)(wp + (size_t)kk * N);
        a0 += w * scr[kk]; a1 += w * scr[256 + kk]; a2 += w * scr[512 + kk]; a3 += w * scr[768 + kk]; }
    if (kc == 0) { const f32x4 bb = *(const f32x4*)(bias + n0 + 4 * lane); a0 += bb; a1 += bb; a2 += bb; a3 += bb; }
    float* o = out + n0 + 4 * lane;
    *(f32x4*)o = a0; *(f32x4*)(o + N) = a1; *(f32x4*)(o + 2 * N) = a2; *(f32x4*)(o + 3 * N) = a3;
    LDS_WAIT(); asm volatile("" ::: "memory");
}
__device__ __forceinline__ void ph0_prologue(Frame& F) {
    const int tid = opaque_tid(F.wv), lane = tid & 63, wave = F.wv;
    LAS float* scr = (LAS float*)(F.lds + wave * 16384);
    const int gw = F.vcu * NWAVES + wave, NGW = F.G * NWAVES;
    unsigned char* ws = F.ws;
    constexpr int N_MG = 208 * 8, N_F1 = 32 * 352, N_F2 = 88 * 64, N_PL = 128, N_DKV = 512, N_KR = 64, N_DQ = 512, N_UK = 512, N_UQ = 768, N_WO = 2048, N_Z = 192, N_R = 8192;
    constexpr int NITEMS = N_MG + 4 * N_F1 + 4 * N_F2 + 8 * N_PL + N_DKV + N_KR + 2 * N_DQ + 2 * N_UK + 2 * N_UQ + 2 * N_WO + N_Z + N_R;
    for (int rep0 = 0; rep0 < (PROBE_REP == 7 ? 2 : 1); ++rep0)
    for (int it = gw; it < NITEMS; it += NGW) {
        int r = it;
        if (rep0 == 1 && (r < N_MG || r >= NITEMS - N_R)) continue;
        if (r < N_MG) { const int cb = r >> 3, kc = r & 7;
            if (cb < 192) { const int l = cb / 48, n0 = (cb % 48) * 256; modgemv_item(((const float*)F.a->in[1]), ((const float*)F.a->in[3]) + (size_t)l * 2048 * 12288, 12288, ((const float*)F.a->in[4]) + l * 12288, F.modp + (size_t)kc * MODN + (size_t)l * 4 * 12288, n0, kc, scr, lane); }
            else { const int n0 = (cb - 192) * 256; modgemv_item(((const float*)F.a->in[1]), ((const float*)F.a->in[9]), 4096, ((const float*)F.a->in[10]), F.modp + (size_t)kc * MODN + 4 * 4 * 12288, n0, kc, scr, lane); }
            continue; } r -= N_MG;
        if (r < 4 * N_F1) { const int l = r / N_F1, q = r % N_F1, kb = q / 352, nb = q % 352, tile = nb >> 3, qq = nb & 7;
            const float* src = ((qq >> 2) ? ((const float*)F.a->in[22]) : ((const float*)F.a->in[21])) + (size_t)l * 2048 * 5632;
            tr_item(src, 5632, tile * 128 + (qq & 3) * 32, kb * 64, (bf16_t*)(ws + WS_WFFN1 + l * SZ_WFFN1), 2048, nb * 32, nullptr, scr, lane); continue; } r -= 4 * N_F1;
        if (r < 4 * N_F2) { const int l = r / N_F2, q = r % N_F2, kb = q / 64, nb = q % 64;
            tr_item(((const float*)F.a->in[23]) + (size_t)l * 5632 * 2048, 2048, nb * 32, kb * 64, (bf16_t*)(ws + WS_WFFN2 + l * SZ_WFFN2), 5632, nb * 32, nullptr, scr, lane); continue; } r -= 4 * N_F2;
        if (r < 8 * N_PL) { const int lg = r / N_PL, q = r % N_PL, kb = q / 16, nb = q % 16, l = lg >> 2, g = lg & 3;
            tr_item(((const float*)F.a->in[7]) + (size_t)lg * 512 * 512, 512, nb * 32, kb * 64, (bf16_t*)(ws + WS_WPOOL + l * SZ_WPOOL), 512, g * 512 + nb * 32, nullptr, scr, lane); continue; } r -= 8 * N_PL;
        if (r < N_DKV) { const int kb = r / 16, nb = r % 16; tr_item(((const float*)F.a->in[12]), 512, nb * 32, kb * 64, (bf16_t*)(ws + WS_WD2), 2048, nb * 32, nullptr, scr, lane); continue; } r -= N_DKV;
        if (r < N_KR) { const int kb = r / 2, nb = r % 2; tr_item(((const float*)F.a->in[16]), 64, nb * 32, kb * 64, (bf16_t*)(ws + WS_WD2), 2048, 512 + nb * 128, nullptr, scr, lane); continue; } r -= N_KR;
        if (r < 2 * N_DQ) { const int j = r / N_DQ, q = r % N_DQ, kb = q / 16, nb = q % 16;
            tr_item(((const float*)F.a->in[17]) + (size_t)j * 2048 * 512, 512, nb * 32, kb * 64, (bf16_t*)(ws + (j ? WS_WD3 : WS_WD2)), 2048, (j ? 0 : 768) + nb * 32, nullptr, scr, lane); continue; } r -= 2 * N_DQ;
        if (r < 2 * N_UK) { const int j = r / N_UK, q = r % N_UK, kb = q / 64, nb = q % 64;
            tr_item(j ? ((const float*)F.a->in[15]) : ((const float*)F.a->in[14]), 2048, nb * 32, kb * 64, (bf16_t*)(ws + WS_WU2), 512, j * 2048 + nb * 32, ((const float*)F.a->in[13]), scr, lane); continue; } r -= 2 * N_UK;
        if (r < 2 * N_UQ) { const int j = r / N_UQ, q = r % N_UQ, kb = q / 96, db = q % 96; int col0, drow;
            if (db < 64) { col0 = (db >> 2) * 192 + (db & 3) * 32; drow = db * 32; }
            else { const int e = db - 64, tt = e >> 3, r8 = e & 7, bj = r8 >> 2, wcp = r8 & 3; col0 = (4 * tt + wcp) * 192 + 128 + bj * 32; drow = 2048 + e * 32; }
            tr_item(((const float*)F.a->in[19]) + (size_t)j * 512 * 3072, 3072, col0, kb * 64, (bf16_t*)(ws + (j ? WS_WU3 : WS_WU2)), 512, (j ? 0 : 4096) + drow, ((const float*)F.a->in[18]) + j * 512, scr, lane); continue; } r -= 2 * N_UQ;
        if (r < 2 * N_WO) { const int j = r / N_WO, q = r % N_WO, kb = q / 64, nb = q % 64;
            tr_item(((const float*)F.a->in[20]) + (size_t)j * 2048 * 2048, 2048, nb * 32, kb * 64, (bf16_t*)(ws + WS_WO + j * SZ_WO), 2048, nb * 32, nullptr, scr, lane); continue; } r -= 2 * N_WO;
        if (r < N_Z) { const int row = r < 96 ? 544 + r : 672 + (r - 96); GAS u32x4* p = (GAS u32x4*)((bf16_t*)(ws + WS_WD2) + (size_t)row * 2048);
#pragma unroll
            for (int j = 0; j < 4; ++j) p[lane + 64 * j] = (u32x4){0u, 0u, 0u, 0u};
            continue; } r -= N_Z;
        { const int row = r * 2 + (lane >> 5), i = lane & 31;
          const double t = (double)((const int*)F.a->in[2])[row] * kInvFreqTurns[i]; const double fr = t - __builtin_rint(t);
          const float a = (float)(fr * 6.283185307179586476925);
          F.tab[(size_t)row * 32 + i] = make_float2(cosf(a), sinf(a)); }
    }
}

typedef float f32x2 __attribute__((ext_vector_type(2)));
template <int W, bool XB>
__device__ __forceinline__ void pool_cols(const void* xcv, const unsigned char* xlv, const LAS float* rsl, const f32x2 gm, int tb, int start, bf16_t* dp) {
    f32x2 hp[16], hc[16];
    auto ldx = [&](int pos) -> f32x2 { if constexpr (XB) { const unsigned r = *(const unsigned*)((const bf16_t*)xcv + (size_t)pos * DM); unsigned lo = 0u; if (XBF16 == 2) lo = *(const unsigned short*)(xlv + (size_t)pos * DM); return (f32x2){__builtin_bit_cast(float, (r << 16) | ((lo << 8) & 0xff00u)), __builtin_bit_cast(float, (r & 0xffff0000u) | (lo & 0xff00u))}; } else return *(const f32x2*)((const float*)xcv + (size_t)pos * DM); };
#pragma unroll
    for (int i = 0; i < 16; ++i) hp[i] = (f32x2){0.f, 0.f};
    if (tb > 0) {
#pragma unroll
        for (int i = 0; i < 16; ++i) hp[i] = ldx(tb - 16 + i);
#pragma unroll
        for (int i = 0; i < 16; ++i) hp[i] = hp[i] * (gm * rsl[tb - 16 + i - start]);
    }
    f32x2 S = {0.f, 0.f};
#pragma unroll
    for (int i = 16 - W; i < 16; ++i) S += hp[i];
    for (int ch = 0; ch < 4; ++ch) {
        const int p0 = tb + ch * 16;
#pragma unroll
        for (int i = 0; i < 16; ++i) hc[i] = ldx(p0 + i);
#pragma unroll
        for (int i = 0; i < 16; ++i) hc[i] = hc[i] * (gm * rsl[p0 + i - start]);
#pragma unroll
        for (int i = 0; i < 16; ++i) {
            const int pos = p0 + i;
            S += hc[i]; S -= (i >= W) ? hc[i - W] : hp[16 + i - W];
            const float inv = 1.f / (float)(pos + 1 < W ? pos + 1 : W);
            const f32x2 d = S * inv - hc[i];
            *(GAS unsigned*)(dp + (size_t)pos * DM) = cvt_pk_bf16(d[0], d[1]);
        }
#pragma unroll
        for (int i = 0; i < 16; ++i) hp[i] = hc[i];
    }
}
template <bool XB>
__device__ __forceinline__ void pool_unit(Frame& F, const void* xsrc, const float* gnorm, const float* scale_m  , int unit, bf16_t* Dout) {
    LAS float* rsl = (LAS float*)F.lds;
    const int tid = opaque_tid(F.wv), lane = tid & 63, wave = F.wv;
    const int t0 = unit * 64, b = t0 >> 12, tb = t0 & 4095;
    const int start = tb >= 16 ? tb - 16 : 0, nrows = tb + 64 - start;
    const size_t xboff = (size_t)b * 4096 * DM;
    for (int ri = wave; ri < nrows; ri += 2 * NWAVES) {
        const int r2 = ri + NWAVES < nrows ? ri + NWAVES : ri;
        float sa = 0.f, sb = 0.f;
        if constexpr (XB) {
            const GAS u32x4* xa = (const GAS u32x4*)((const bf16_t*)xsrc + xboff + (size_t)(start + ri) * DM) + lane; const GAS u32x4* xq = (const GAS u32x4*)((const bf16_t*)xsrc + xboff + (size_t)(start + r2) * DM) + lane;
            const GAS u32x2* la = (const GAS u32x2*)(F.ws + WS_XL + xboff + (size_t)(start + ri) * DM) + lane; const GAS u32x2* lq = (const GAS u32x2*)(F.ws + WS_XL + xboff + (size_t)(start + r2) * DM) + lane;
            u32x4 va[4], vb[4]; u32x2 wa[4], wb[4];
#pragma unroll
            for (int j = 0; j < 4; ++j) { va[j] = xa[64 * j]; vb[j] = xq[64 * j]; if (XBF16 == 2) { wa[j] = la[64 * j]; wb[j] = lq[64 * j]; } }
#pragma unroll
            for (int j = 0; j < 4; ++j) { f32x4 a0, a1, b0, b1;
                if (XBF16 == 2) { x8_unpack24(va[j], wa[j], a0, a1); x8_unpack24(vb[j], wb[j], b0, b1); } else { x8_unpack16(va[j], a0, a1); x8_unpack16(vb[j], b0, b1); }
                sa += (a0[0] * a0[0] + a0[1] * a0[1]) + (a0[2] * a0[2] + a0[3] * a0[3]) + (a1[0] * a1[0] + a1[1] * a1[1]) + (a1[2] * a1[2] + a1[3] * a1[3]);
                sb += (b0[0] * b0[0] + b0[1] * b0[1]) + (b0[2] * b0[2] + b0[3] * b0[3]) + (b1[0] * b1[0] + b1[1] * b1[1]) + (b1[2] * b1[2] + b1[3] * b1[3]); }
        } else {
            const GAS f32x4* xa = (const GAS f32x4*)((const float*)xsrc + xboff + (size_t)(start + ri) * DM) + lane; const GAS f32x4* xq = (const GAS f32x4*)((const float*)xsrc + xboff + (size_t)(start + r2) * DM) + lane;
            f32x4 va[8], vb[8];
#pragma unroll
            for (int j = 0; j < 8; ++j) { va[j] = xa[64 * j]; vb[j] = xq[64 * j]; }
#pragma unroll
            for (int j = 0; j < 8; ++j) { sa += (va[j][0] * va[j][0] + va[j][1] * va[j][1]) + (va[j][2] * va[j][2] + va[j][3] * va[j][3]); sb += (vb[j][0] * vb[j][0] + vb[j][1] * vb[j][1]) + (vb[j][2] * vb[j][2] + vb[j][3] * vb[j][3]); }
        }
        sa = wave_sum(sa); sb = wave_sum(sb);
        if (lane == 0) { rsl[ri] = rsqrtf(sa * (1.f / DM) + EPS); rsl[r2] = rsqrtf(sb * (1.f / DM) + EPS); }
    }
    __syncthreads();
    for (int pass = 0; pass < 2; ++pass) {
        const int c = pass * 1024 + 2 * tid, g = pass * 2 + __builtin_amdgcn_readfirstlane(tid >> 8);
        f32x2 gm = *(const f32x2*)(gnorm + c); { const f32x2 sm = *(const f32x2*)(scale_m + (size_t)b * 12288 + c); gm = gm * (sm + 1.f); }
        const void* xc = XB ? (const void*)((const bf16_t*)xsrc + xboff + c) : (const void*)((const float*)xsrc + xboff + c); bf16_t* dp = Dout + (size_t)b * 4096 * DM + c; const unsigned char* xl = F.ws + WS_XL + xboff + c;
        if (g == 0) pool_cols<2, XB>(xc, xl, rsl, gm, tb, start, dp);
        else if (g == 1) pool_cols<4, XB>(xc, xl, rsl, gm, tb, start, dp);
        else if (g == 2) pool_cols<8, XB>(xc, xl, rsl, gm, tb, start, dp);
        else pool_cols<16, XB>(xc, xl, rsl, gm, tb, start, dp);
    }
    __syncthreads();
}
__device__ __forceinline__ void modv_convert_phase(Frame& F) {
    const int tid = opaque_tid(F.wv); const int gt = F.vcu * NWAVES * 64 + tid, NGT = F.G * NWAVES * 64;
    for (int i = gt; i < MODN; i += NGT) { float s = F.modp[i];
#pragma unroll
        for (int kc = 1; kc < 8; ++kc) s += F.modp[(size_t)kc * MODN + i];
        F.modv[i] = s; }
}
__device__ __forceinline__ void bias_rows(const bf16_t* W, int nrows, const float* shift, int sstride, float* out, int ostride, int w0, int nw, int lane) {
    if (w0 >= nrows) return;
    f32x4 sh[4][4][2];
#pragma unroll
    for (int bb = 0; bb < 4; ++bb)
#pragma unroll
        for (int j = 0; j < 4; ++j) { const float* sp = shift + (size_t)bb * sstride + (lane + 64 * j) * 8; sh[bb][j][0] = *(const f32x4*)sp; sh[bb][j][1] = *(const f32x4*)(sp + 4); }
    for (int n = w0; n < nrows; n += nw) {
        const bf16_t* wrow = W + (size_t)n * 2048;
        bf16x8 wv[4];
#pragma unroll
        for (int j = 0; j < 4; ++j) wv[j] = *(const bf16x8*)(wrow + (lane + 64 * j) * 8);
        float a[4] = {0.f, 0.f, 0.f, 0.f};
#pragma unroll
        for (int j = 0; j < 4; ++j)
#pragma unroll
            for (int e = 0; e < 8; ++e) { const float w = bf2f((unsigned short)wv[j][e]);
#pragma unroll
                for (int bb = 0; bb < 4; ++bb) a[bb] += sh[bb][j][e >> 2][e & 3] * w; }
#pragma unroll
        for (int bb = 0; bb < 4; ++bb) a[bb] = wave_sum(a[bb]);
        if (lane == 0) { out[n] = a[0]; out[ostride + n] = a[1]; out[2 * ostride + n] = a[2]; out[3 * ostride + n] = a[3]; }
    }
}
__device__ __forceinline__ void ph1_prologue(Frame& F) {
    for (int u = F.vcu; u < 256; u += F.G) pool_unit<false>(F, ((const float*)F.a->in[0]), ((const float*)F.a->in[5]), F.modv + 2048, u, (bf16_t*)(F.ws + WS_AKV));
    const int tid = opaque_tid(F.wv), lane = tid & 63, wave = F.wv;
    const int gt = F.vcu * NWAVES * 64 + tid, NGT = F.G * NWAVES * 64;
    for (int i = gt; i < 4 * 4 * 2048; i += NGT) { const int col = i & 2047, lb = i >> 11, l = lb >> 2;
        const float* mv = F.modv + (size_t)lb * 12288;
        F.dv[DV_GM + i] = ((const float*)F.a->in[5])[l * 2048 + col] * (1.f + mv[2048 + col]);
        F.dv[DV_GF + i] = ((const float*)F.a->in[6])[l * 2048 + col] * (1.f + mv[8192 + col]);
        F.dv[DV_GATEM + i] = mv[4096 + col] * (l < 2 ? ((const float*)F.a->in[8])[l * 2048 + col] : 1.f);
        F.dv[DV_GATEF + i] = mv[10240 + col];
        if (i < 4 * 2048) F.dv[DV_GKV + i] = ((const float*)F.a->in[11])[col] * (1.f + F.kvmod[(size_t)lb * 4096 + 2048 + col]); }
    const int gw = F.vcu * NWAVES + wave, NGW = F.G * NWAVES;
    for (int l = 0; l < (IDLE_FILL ? 2 : 4); ++l)
        bias_rows((const bf16_t*)(F.ws + WS_WFFN1 + l * SZ_WFFN1), 11264, F.modv + (size_t)l * 4 * 12288 + 6144, 12288, F.dv + DV_BFFN + (size_t)l * 4 * 11264, 11264, gw, NGW, lane);
    bias_rows((const bf16_t*)(F.ws + WS_WD2), 768, F.kvmod, 4096, F.dv + DV_BD2, 1280, gw, NGW, lane);
    bias_rows((const bf16_t*)(F.ws + WS_WD2) + (size_t)768 * 2048, 512, F.modv + (size_t)2 * 4 * 12288, 12288, F.dv + DV_BD2 + 768, 1280, gw, NGW, lane);
    bias_rows((const bf16_t*)(F.ws + WS_WD3), 512, F.modv + (size_t)3 * 4 * 12288, 12288, F.dv + DV_BD3, 512, gw, NGW, lane);
}
__device__ __forceinline__ void final_norm_phase(Frame& F) {
    const int tid = opaque_tid(F.wv), lane = tid & 63, wave = F.wv;
    const int gw = F.vcu * NWAVES + wave, NGW = F.G * NWAVES;
    f32x4 g[8];
#pragma unroll
    for (int j = 0; j < 8; ++j) g[j] = *((const GAS f32x4*)((const float*)F.a->in[24]) + lane + 64 * j);
    for (int m = gw; m < MROWS; m += NGW) {
        GAS f32x4* xr = (GAS f32x4*)(F.xw + (size_t)m * DM) + lane; f32x4 v[8]; float s = 0.f;
#if XBF16
        const GAS u32x2* xb = (const GAS u32x2*)((const bf16_t*)(F.ws + WS_XB) + (size_t)m * DM) + lane;
        const GAS unsigned* xlw = (const GAS unsigned*)(F.ws + WS_XL + (size_t)m * DM) + lane;
#pragma unroll
        for (int j = 0; j < 8; ++j) { const u32x2 r = xb[64 * j]; unsigned lo = 0u; if (XBF16 == 2) lo = xlw[64 * j];
            v[j] = (f32x4){__builtin_bit_cast(float, (r.x << 16) | ((lo << 8) & 0xff00u)), __builtin_bit_cast(float, (r.x & 0xffff0000u) | (lo & 0xff00u)),
                           __builtin_bit_cast(float, (r.y << 16) | ((lo >> 8) & 0xff00u)), __builtin_bit_cast(float, (r.y & 0xffff0000u) | ((lo >> 16) & 0xff00u))}; }
#else
#pragma unroll
        for (int j = 0; j < 8; ++j) v[j] = xr[64 * j];
#endif
#pragma unroll
        for (int j = 0; j < 8; ++j) s += (v[j][0] * v[j][0] + v[j][1] * v[j][1]) + (v[j][2] * v[j][2] + v[j][3] * v[j][3]);
        const float rstd = rsqrtf(wave_sum(s) * (1.f / DM) + EPS);
#pragma unroll
        for (int j = 0; j < 8; ++j) xr[64 * j] = v[j] * rstd * g[j];
    }
}

constexpr int NPHASES = 28;
__global__ void __launch_bounds__(NWAVES * 64, 2) fwd_kernel(Args args) {
    extern __shared__ __attribute__((aligned(16))) unsigned char lds_raw[];
    Frame F;
    F.lds = (LAS unsigned char*)lds_raw; F.MISC = (volatile LAS unsigned*)(F.lds + MISC_OFF);
    F.G = gridDim.x; { const int bx = blockIdx.x; F.vcu = (F.G % 8 == 0) ? (bx % 8) * (F.G / 8) + bx / 8 : bx; }
    unsigned char* const ws0_ = args.ws; float* const xw0_ = args.out;
    F.a = &args;
#define FRAME_PTRS(w_) do { F.ws = (w_); F.ctl = (gu32*)((w_) + WS_CTL); F.rs = (rs_t*)((float*)((w_) + WS_CTL) + CW_RS); F.modp = (float*)((w_) + WS_MODP); F.modv = (float*)((w_) + WS_CTL) + CW_MODV; F.kvmod = (float*)((w_) + WS_CTL) + CW_KVMOD; \
        F.dv = (float*)((w_) + WS_DV); F.tab = (float2*)((w_) + WS_TAB); } while (0)
    FRAME_PTRS(ws0_); F.xw = xw0_;
    if (threadIdx.x < 64) F.MISC[threadIdx.x] = 0u;
    __syncthreads();
    F.wv = __builtin_amdgcn_readfirstlane((int)threadIdx.x >> 6);
    XcdBarrier bar = xcd_barrier_post((unsigned*)(F.ctl + CW_BAR), F.MISC, threadIdx.x == 0);
#if MODE == 2
    constexpr int lo = 0, hi = NPHASES;
#else
    const int lo = args.ph_lo, hi = args.ph_hi;
#endif
    bool need_bar = false;
#define REPK(kind) for (int rep_ = 0; rep_ < ((PROBE_REP == (kind)) ? 2 : 1); ++rep_)
#define PH_BEGIN(p) if (lo <= (p) && (p) < hi) { if (need_bar) { XcdBarrier b_ = bar; asm volatile("" : "+s"(b_.bar), "+s"(b_.x)); { const bool t0_ = (F.wv == 0) && (opaque_lane() == 0); xcd_barrier(b_, t0_); if (PROBE_REP == 15) xcd_barrier(b_, t0_); } } need_bar = true; \
        unsigned char* ws = ws0_; float* xw_ = xw0_; asm volatile("" : "+s"(ws), "+s"(xw_)); FRAME_PTRS(ws); F.xw = xw_;
#define PH_END }
#define AQ ((bf16_t*)(ws + WS_AQ))
#define AKV ((bf16_t*)(ws + WS_AKV))
#define ACT ((bf16_t*)(ws + WS_ACT))
#define KN ((bf16_t*)(ws + WS_KN))
#define VV ((bf16_t*)(ws + WS_V))
#define KR ((bf16_t*)(ws + WS_KR))
#define CKV ((bf16_t*)(ws + WS_CKV))
#define CQ ((bf16_t*)(ws + WS_CQ))
#define QN ((bf16_t*)(ws + WS_QN))
#define QR ((bf16_t*)(ws + WS_QR))
#define OO ((bf16_t*)(ws + WS_O))

    #ifndef SK0
    PH_BEGIN(0) ph0_prologue(F); PH_END
#endif
    #ifndef SK1
    PH_BEGIN(27) modv_convert_phase(F); PH_END
    PH_BEGIN(1) REPK(8) ph1_prologue(F); PH_END
#endif
    for (int l = 0; l < 4; ++l) {
        const int base = 2 + 6 * l;
        if (l == 1) {
            PH_BEGIN(base) REPK(9) for (int u = F.vcu; u < 256; u += F.G) pool_unit<XBF16 != 0>(F, XBF16 ? (const void*)(ws + WS_XB) : (const void*)F.xw, ((const float*)F.a->in[5]) + 2048, F.modv + (size_t)4 * 12288 + 2048, u, AKV); PH_END
        }
        if (l >= 2) {
#ifndef SKD
            PH_BEGIN(base) {
                const bool first = (l == 2);
                pg8::Gemm g{first ? AKV : AQ, AQ, first ? 3 : 0, 2048, 0, (const bf16_t*)(ws + (first ? WS_WD2 : WS_WD3)), 2048, 2048, 64, first ? 5 : 2};
                pg8::StaticOrder S; S.init(g.nM, g.nN, F.G, (int)blockIdx.x);
                pg8::EpiDown E{F.rs + (first ? RS_M2 : RS_M3) * 16384, F.dv + (first ? DV_BD2 : DV_BD3), first ? 1280 : 512, first ? 3 : 0, ws, F.rs, first ? RS_Q2 : RS_Q3, F.tab};
                pg8::gemm_phase<pg8::EpiDown>(F.lds, g, S, E, F.wv);
                if (IDLE_FILL) {
                    const int c_ = (int)blockIdx.x, c0_ = (g.nM * g.nN) % F.G;
                    if (c0_ > 0 && c_ >= c0_) { const int lane_ = opaque_lane();
                        bias_rows((const bf16_t*)(ws + WS_WFFN1 + l * SZ_WFFN1), 11264, F.modv + (size_t)l * 4 * 12288 + 6144, 12288, F.dv + DV_BFFN + (size_t)l * 4 * 11264, 11264,
                                  (c_ - c0_) * NWAVES + F.wv, (F.G - c0_) * NWAVES, lane_); }
                }
            } PH_END
#endif
#ifndef SKU
            PH_BEGIN(base + 1) {
                const bool first = (l == 2);
                pg8::Gemm g{first ? CKV : CQ, CQ, first ? 16 : 0, 512, 0, (const bf16_t*)(ws + (first ? WS_WU2 : WS_WU3)), 512, 512, 64, first ? 28 : 12};
                pg8::StaticOrder S; S.init(g.nM, g.nN, F.G, (int)blockIdx.x);
                pg8::EpiUp E{ws, F.rs, first ? RS_Q2 : RS_Q3, first ? 16 : 0, F.tab};
                REPK(5) pg8::gemm_phase<pg8::EpiUp>(F.lds, g, S, E, F.wv);
            } PH_END
#endif
#ifndef SKA
            PH_BEGIN(base + 2) {
                REPK(3) att::attn_phase((char*)lds_raw, ws, F.vcu, F.G, F.wv);
            } PH_END
#endif
        }
#ifndef SKM
        PH_BEGIN(base + 3) {
            const bool pool = l < 2;
            pg8::Gemm g{pool ? AKV : OO, pool ? AKV : OO, 0, 2048, pool ? 1 : 0, (const bf16_t*)(ws + (pool ? WS_WPOOL + l * SZ_WPOOL : WS_WO + (l - 2) * SZ_WO)), pool ? 512 : 2048, pool ? 512 : 2048, 64, 8};
            pg8::StaticOrder S; S.init(g.nM, g.nN, F.G, (int)blockIdx.x, 4);
            pg8::EpiRes E{l == 0 ? ((const float*)F.a->in[0]) : (XBF16 ? nullptr : F.xw), (const bf16_t*)(ws + WS_XB), XBF16 ? nullptr : F.xw, (bf16_t*)(ws + WS_XB), ws + WS_XL, F.dv + DV_GATEM + l * 4 * 2048, F.dv + DV_GF + l * 4 * 2048, AQ, nullptr, nullptr, F.rs + (RS_F0 + l) * 16384, (unsigned)(size_t)(F.lds + 131072)};
            if (PROBE_REP == 4) { pg8::EpiRes E2 = E; E2.xout32 = (float*)(ws + WS_FAST_END); E2.rowss = nullptr; E2.a0 = (bf16_t*)(ws + WS_FAST_END + (size_t)MROWS * DM * 4); pg8::gemm_phase<pg8::EpiRes, EPI_ALIGN_RES>(F.lds, g, S, E2, F.wv); }
            if (EPI_STAGGER && ([&]{ pg8::Unit u0_; return S.next(0, u0_) && (u0_.pm & 1); })()) { for (int i_ = 0; i_ < EPI_STAGGER; ++i_) __builtin_amdgcn_s_sleep(127); }
            pg8::gemm_phase<pg8::EpiRes, EPI_ALIGN_RES>(F.lds, g, S, E, F.wv);
        } PH_END
#endif
#ifndef SKF1
        PH_BEGIN(base + 4) {
            pg8::Gemm g{AQ, AQ, 0, 2048, 0, (const bf16_t*)(ws + WS_WFFN1 + l * SZ_WFFN1), 2048, 2048, 64, 44};
            pg8::StaticOrder S; S.init(g.nM, g.nN, F.G, (int)blockIdx.x);
            pg8::EpiSwi E{F.rs + (RS_F0 + l) * 16384, F.dv + DV_BFFN + (size_t)l * 4 * 11264, ACT};
            REPK(1) pg8::gemm_phase<pg8::EpiSwi, true, FFN1_SP2, FFN1_SIM, L2PF_FFN1>(F.lds, g, S, E, F.wv);
        } PH_END
#endif
#ifndef SKF2
        PH_BEGIN(base + 5) {
            pg8::Gemm g{ACT, ACT, 0, 5632, 0, (const bf16_t*)(ws + WS_WFFN2 + l * SZ_WFFN2), 5632, 5632, 64, 8};
            pg8::StaticOrder S; S.init(g.nM, g.nN, F.G, (int)blockIdx.x, 4);
            const bool hasA = (l == 1 || l == 2);
            pg8::EpiRes E{XBF16 ? nullptr : F.xw, (const bf16_t*)(ws + WS_XB), XBF16 ? nullptr : F.xw, (bf16_t*)(ws + WS_XB), ws + WS_XL, F.dv + DV_GATEF + l * 4 * 2048, hasA ? F.dv + DV_GM + (l + 1) * 4 * 2048 : nullptr, hasA ? AQ : nullptr,
                          l == 1 ? F.dv + DV_GKV : nullptr, l == 1 ? AKV : nullptr, hasA ? F.rs + (l == 1 ? RS_M2 : RS_M3) * 16384 : nullptr, (unsigned)(size_t)(F.lds + 131072)};
            if (PROBE_REP == 10) { pg8::EpiNull E0{(float*)(ws + WS_FAST_END)}; pg8::gemm_phase<pg8::EpiNull, true>(F.lds, g, S, E0, F.wv); }
            if (PROBE_REP == 14) { pg8::EpiNull E0{(float*)(ws + WS_FAST_END)}; pg8::Gemm g2 = g; g2.grouped = 2; pg8::gemm_phase<pg8::EpiNull, true>(F.lds, g2, S, E0, F.wv); }
            if (PROBE_REP == 2) { pg8::EpiRes E2 = E; E2.xout32 = (float*)(ws + WS_FAST_END); E2.rowss = nullptr; pg8::gemm_phase<pg8::EpiRes, EPI_ALIGN_RES>(F.lds, g, S, E2, F.wv); }
            if (EPI_STAGGER && ([&]{ pg8::Unit u0_; return S.next(0, u0_) && (u0_.pm & 1); })()) { for (int i_ = 0; i_ < EPI_STAGGER; ++i_) __builtin_amdgcn_s_sleep(127); }
            pg8::gemm_phase<pg8::EpiRes, EPI_ALIGN_RES, true, false, L2PF_FFN2>(F.lds, g, S, E, F.wv);
        } PH_END
#endif
    }
    PH_BEGIN(26) REPK(12) final_norm_phase(F); PH_END
#undef PH_BEGIN
#undef PH_END
#undef FRAME_PTRS
#undef AQ
#undef AKV
#undef ACT
#undef KN
#undef VV
#undef KR
#undef CKV
#undef CQ
#undef QN
#undef QR
#undef OO
}
#if MODE >= 2
extern "C" void kernel_launch(void* const* d_in, const int* in_sizes, int n_in, void* d_out, int out_size, void* d_ws, size_t ws_size, hipStream_t stream) {
    static int grid = 0;
    if (grid == 0) {
        if (n_in != 25 || out_size != MROWS * DM || ws_size < WS_NEED) { fprintf(stderr, "kernel_launch: unexpected shapes / workspace (%d inputs, out %d, ws %zu < %zu)\n", n_in, out_size, ws_size, (size_t)WS_FAST_END); grid = -1; return; }
        int dev = 0, cus = 0, per_cu = 0;
        if (hipGetDevice(&dev) != hipSuccess || hipDeviceGetAttribute(&cus, hipDeviceAttributeMultiprocessorCount, dev) != hipSuccess) { grid = -1; return; }
        if (hipFuncSetAttribute((const void*)fwd_kernel, hipFuncAttributeMaxDynamicSharedMemorySize, LDS_BYTES) != hipSuccess) { fprintf(stderr, "kernel_launch: hipFuncSetAttribute failed\n"); grid = -1; return; }
        if (hipOccupancyMaxActiveBlocksPerMultiprocessor(&per_cu, (const void*)fwd_kernel, NWAVES * 64, LDS_BYTES) != hipSuccess || per_cu < 1) { fprintf(stderr, "kernel_launch: occupancy query says %d\n", per_cu); }
        (void)hipGetLastError();
        grid = cus;
    }
    if (grid < 0) return;
    (void)hipMemsetAsync((char*)d_ws + WS_CTL, 0, CTL_ZERO_BYTES, stream);
    Args a{};
    for (int i = 0; i < 25; ++i) a.in[i] = d_in[i];
    a.out = (float*)d_out; a.ws = (unsigned char*)d_ws;
#if MODE == 2
    a.ph_lo = 0; a.ph_hi = NPHASES;
    hipLaunchKernelGGL(fwd_kernel, dim3(grid), dim3(NWAVES * 64), LDS_BYTES, stream, a);
#else
    for (int p = 0; p < NPHASES; ++p) {
        const int k = p < 2 ? -1 : (p - 2) % 6, l = p < 2 ? -1 : (p - 2) / 6;
        if (p >= 2 && p < 26) { if (k == 0 && l == 0) continue; if ((k == 1 || k == 2) && l < 2) continue; }
        a.ph_lo = p; a.ph_hi = p + 1;
        hipLaunchKernelGGL(fwd_kernel, dim3(grid), dim3(NWAVES * 64), LDS_BYTES, stream, a);
    }
#endif
}
#endif
```

```cpp
#include <hip/hip_runtime.h>
#include <cstdio>
#include <cstdint>
#ifndef MODE
#define MODE 2
#define PROBE_REP 0
#endif
#define GAS __attribute__((address_space(1)))
#define LAS __attribute__((address_space(3)))
typedef unsigned short bf16_t;
typedef short bf16x8 __attribute__((ext_vector_type(8)));
typedef short s16x4 __attribute__((ext_vector_type(4)));
typedef float f32x4 __attribute__((ext_vector_type(4)));
typedef float f32x16 __attribute__((ext_vector_type(16)));
typedef unsigned u32x4 __attribute__((ext_vector_type(4)));
typedef unsigned u32x2 __attribute__((ext_vector_type(2)));
typedef GAS unsigned gu32;

#ifndef NT_LOADS0
#define NT_LOADS0 0
#endif
#ifndef NT_STORES
#define NT_STORES 0
#endif
#ifndef XBF16
#define XBF16 1
#endif
constexpr int NWAVES = 8;
constexpr int BATCH = 4, SEQ = 4096, DM = 2048, MROWS = BATCH * SEQ, FF = 5632, NH = 16;
constexpr float EPS = 1e-6f;
constexpr size_t MiB = 1u << 20;

constexpr size_t WS_CTL = 0, CTL_ZERO_BYTES = 2 * MiB;
constexpr int CW_TMO = 0;
constexpr int CW_BAR = 4096;
constexpr int CW_RS = 16384;
constexpr int RS_F0 = 0, RS_M2 = 4, RS_M3 = 5, RS_KV = 6, RS_Q2 = 7, RS_Q3 = 8;
constexpr int CW_MODV = CW_RS + 2 * 12 * 16384;
constexpr int CW_KVMOD = CW_MODV + 4 * 4 * 12288;
constexpr int CW_END = CW_KVMOD + 4 * 4096;
static_assert((size_t)CW_MODV * 4 <= CTL_ZERO_BYTES && (size_t)CW_END * 4 <= 4 * MiB, "CTL region: the barrier words and the row-sum accumulators are zeroed per call; the mod vectors behind them are fully written before they are read");
constexpr size_t WS_DV = 4 * MiB;
constexpr int DV_GM = 0;
constexpr int DV_GF = DV_GM + 4 * 4 * 2048;
constexpr int DV_GKV = DV_GF + 4 * 4 * 2048;
constexpr int DV_GATEM = DV_GKV + 4 * 2048;
constexpr int DV_GATEF = DV_GATEM + 4 * 4 * 2048;
constexpr int DV_BFFN = DV_GATEF + 4 * 4 * 2048;
constexpr int DV_BD2 = DV_BFFN + 4 * 4 * 11264;
constexpr int DV_BD3 = DV_BD2 + 4 * 1280;
constexpr int DV_END = DV_BD3 + 4 * 512;
static_assert((size_t)DV_END * 4 <= 2 * MiB, "DV region");
constexpr size_t WS_TAB = 6 * MiB;
constexpr size_t WS_WFFN1 = 10 * MiB;
constexpr size_t SZ_WFFN1 = (size_t)11264 * 2048 * 2;
constexpr size_t WS_WFFN2 = WS_WFFN1 + 4 * SZ_WFFN1;
constexpr size_t SZ_WFFN2 = (size_t)2048 * 5632 * 2;
constexpr size_t WS_WPOOL = WS_WFFN2 + 4 * SZ_WFFN2;
constexpr size_t SZ_WPOOL = (size_t)2048 * 512 * 2;
constexpr size_t WS_WD2 = WS_WPOOL + 2 * SZ_WPOOL;
constexpr size_t WS_WD3 = WS_WD2 + (size_t)1280 * 2048 * 2;
constexpr size_t WS_WU2 = WS_WD3 + (size_t)512 * 2048 * 2;
constexpr size_t WS_WU3 = WS_WU2 + (size_t)7168 * 512 * 2;
constexpr size_t WS_WO = WS_WU3 + (size_t)3072 * 512 * 2;
constexpr size_t SZ_WO = (size_t)2048 * 2048 * 2;
constexpr size_t WS_WEND = WS_WO + 2 * SZ_WO;
constexpr size_t SZ_MD = (size_t)MROWS * DM * 2;
constexpr size_t WS_AQ = (WS_WEND + MiB - 1) / MiB * MiB;
constexpr size_t WS_AKV = WS_AQ + SZ_MD;
constexpr size_t WS_KN = WS_AKV + SZ_MD;
constexpr size_t WS_V = WS_KN + SZ_MD;
constexpr size_t WS_KR = WS_V + SZ_MD;
constexpr size_t WS_CKV = WS_KR + (size_t)MROWS * 64 * 2;
constexpr size_t WS_CQ = WS_CKV + (size_t)MROWS * 512 * 2;
constexpr size_t WS_ACT = WS_CQ + (size_t)MROWS * 512 * 2;
constexpr size_t WS_QN = WS_ACT, WS_QR = WS_QN + SZ_MD, WS_O = WS_QR + (size_t)MROWS * 1024 * 2;
constexpr size_t WS_XB = WS_ACT + (size_t)MROWS * FF * 2;
constexpr size_t WS_XL = WS_XB + SZ_MD;
constexpr size_t WS_FAST_END = WS_XL + SZ_MD / 2;
constexpr int MODN = 4 * 4 * 12288 + 4 * 4096;
constexpr size_t WS_MODP = WS_FAST_END;
constexpr size_t WS_NEED = WS_MODP + (size_t)8 * MODN * 4;
static_assert(WS_O + SZ_MD <= WS_XB, "attention overlays inside act");

constexpr int RING_BYTES = 131072;
constexpr int LDS_BYTES = 147456;
constexpr int MISC_OFF = LDS_BYTES - 256;

#define RLX_AGENT __ATOMIC_RELAXED, __HIP_MEMORY_SCOPE_AGENT
#define LDS_WAIT() asm volatile("s_waitcnt lgkmcnt(0)" ::: "memory")
#define VM_WAIT() asm volatile("s_waitcnt vmcnt(0)" ::: "memory")
__device__ __forceinline__ unsigned f2bf(float f) { unsigned u = __builtin_bit_cast(unsigned, f); return (u + 0x7fffu + ((u >> 16) & 1u)) >> 16; }
__device__ __forceinline__ unsigned pk2(float lo, float hi) { return f2bf(lo) | (f2bf(hi) << 16); }
__device__ __forceinline__ float bf2f(unsigned short b) { return __builtin_bit_cast(float, (unsigned)b << 16); }
__device__ __forceinline__ unsigned cvt_pk_bf16(float lo, float hi) { unsigned r; asm volatile("v_cvt_pk_bf16_f32 %0, %1, %2" : "=v"(r) : "v"(lo), "v"(hi)); return r; }
__device__ __forceinline__ int opaque_lane() { int l; asm volatile("v_mbcnt_lo_u32_b32 %0, -1, 0\n\tv_mbcnt_hi_u32_b32 %0, -1, %0" : "=v"(l)); return l; }
typedef unsigned long long rs_t;
constexpr float RS_SCALE = 1048576.f, RS_INV = 1.f / 1048576.f, MA_SCALE = 4294967296.f, MA_INV = 1.f / 4294967296.f;
__device__ __forceinline__ void rs_add(rs_t* p, float s) { (void)__hip_atomic_fetch_add((GAS rs_t*)p, (rs_t)(long long)(s * RS_SCALE), __ATOMIC_RELAXED, __HIP_MEMORY_SCOPE_AGENT); }
__device__ __forceinline__ float rs_get(const rs_t* p) { return (float)(long long)*(const GAS rs_t*)p * RS_INV; }
__device__ __forceinline__ int opaque_tid(int wv) { return wv * 64 + opaque_lane(); }
__device__ __forceinline__ void x8_unpack16(const u32x4 h, f32x4& a, f32x4& b) {
    a = (f32x4){__builtin_bit_cast(float, h.x << 16), __builtin_bit_cast(float, h.x & 0xffff0000u), __builtin_bit_cast(float, h.y << 16), __builtin_bit_cast(float, h.y & 0xffff0000u)};
    b = (f32x4){__builtin_bit_cast(float, h.z << 16), __builtin_bit_cast(float, h.z & 0xffff0000u), __builtin_bit_cast(float, h.w << 16), __builtin_bit_cast(float, h.w & 0xffff0000u)}; }
__device__ __forceinline__ void x8_unpack24(const u32x4 h, const u32x2 l, f32x4& a, f32x4& b) {
    a = (f32x4){__builtin_bit_cast(float, (h.x << 16) | ((l.x << 8) & 0xff00u)), __builtin_bit_cast(float, (h.x & 0xffff0000u) | (l.x & 0xff00u)),
                __builtin_bit_cast(float, (h.y << 16) | ((l.x >> 8) & 0xff00u)), __builtin_bit_cast(float, (h.y & 0xffff0000u) | ((l.x >> 16) & 0xff00u))};
    b = (f32x4){__builtin_bit_cast(float, (h.z << 16) | ((l.y << 8) & 0xff00u)), __builtin_bit_cast(float, (h.z & 0xffff0000u) | (l.y & 0xff00u)),
                __builtin_bit_cast(float, (h.w << 16) | ((l.y >> 8) & 0xff00u)), __builtin_bit_cast(float, (h.w & 0xffff0000u) | ((l.y >> 16) & 0xff00u))}; }
__device__ __forceinline__ void x8_pack24(const f32x4 a, const f32x4 b, u32x4& h, u32x2& l) {
    unsigned t[8];
#pragma unroll
    for (int i = 0; i < 4; ++i) { const float fa = a[i], fb = b[i];
        t[i] = (__builtin_bit_cast(unsigned, fa) + 0x80u) >> 8; t[4 + i] = (__builtin_bit_cast(unsigned, fb) + 0x80u) >> 8; }
    h.x = (t[0] >> 8) | ((t[1] << 8) & 0xffff0000u); h.y = (t[2] >> 8) | ((t[3] << 8) & 0xffff0000u); h.z = (t[4] >> 8) | ((t[5] << 8) & 0xffff0000u); h.w = (t[6] >> 8) | ((t[7] << 8) & 0xffff0000u);
    l.x = (t[0] & 0xffu) | ((t[1] & 0xffu) << 8) | ((t[2] & 0xffu) << 16) | (t[3] << 24); l.y = (t[4] & 0xffu) | ((t[5] & 0xffu) << 8) | ((t[6] & 0xffu) << 16) | (t[7] << 24); }
template <class T> __device__ __forceinline__ void st_stream(T* p, const T& v) { if (NT_STORES) __builtin_nontemporal_store(v, p); else *p = v; }
__device__ __forceinline__ float dpp_xor1(float v) { return __builtin_bit_cast(float, __builtin_amdgcn_mov_dpp(__builtin_bit_cast(int, v), 0xB1, 0xF, 0xF, true)); }
__device__ __forceinline__ float dpp_xor2(float v) { return __builtin_bit_cast(float, __builtin_amdgcn_mov_dpp(__builtin_bit_cast(int, v), 0x4E, 0xF, 0xF, true)); }
__device__ __forceinline__ float dpp_hmirror(float v) { return __builtin_bit_cast(float, __builtin_amdgcn_mov_dpp(__builtin_bit_cast(int, v), 0x141, 0xF, 0xF, true)); }
__device__ __forceinline__ float dpp_mirror(float v) { return __builtin_bit_cast(float, __builtin_amdgcn_mov_dpp(__builtin_bit_cast(int, v), 0x140, 0xF, 0xF, true)); }
__device__ __forceinline__ float swz_xor16(float v) { return __builtin_bit_cast(float, __builtin_amdgcn_ds_swizzle(__builtin_bit_cast(int, v), 0x401F)); }
__device__ __forceinline__ float add_xor32(float v) {
    auto rr = __builtin_amdgcn_permlane32_swap(__builtin_bit_cast(unsigned, v), __builtin_bit_cast(unsigned, v), false, false);
    const unsigned a = rr[0], b = rr[1];
    return __builtin_bit_cast(float, a) + __builtin_bit_cast(float, b); }
__device__ __forceinline__ float wave_sum(float v) {
    v += dpp_xor1(v); v += dpp_xor2(v); v += dpp_hmirror(v); v += dpp_mirror(v); v += swz_xor16(v); return add_xor32(v);
}

#define XB_TMO      128
#define XB_XCNT(j)  (256  + 64 * (j))
#define XB_XSUB(j)  (1280 + 64 * (j))
#define XB_XGEN(j)  (2304 + 64 * (j))
#define XB_TOP      3328
#define XB_TOPGEN   3392
#define XCD_BAR_WORDS 3456
#define XB_SPIN_CAP (1u << 18)
__device__ __forceinline__ unsigned xb_ld(unsigned* p)              { return __hip_atomic_load(p, __ATOMIC_RELAXED, __HIP_MEMORY_SCOPE_AGENT); }
__device__ __forceinline__ unsigned xb_add(unsigned* p, unsigned v) { return __hip_atomic_fetch_add(p, v, __ATOMIC_RELAXED, __HIP_MEMORY_SCOPE_AGENT); }
__device__ __forceinline__ unsigned xb_xcc_id() { return (unsigned)__builtin_amdgcn_s_getreg((3 << 11) | 20) & 0xFu; }
#define XB_SPIN(cond, bar) do { unsigned _sp = 0; while (cond) { __builtin_amdgcn_s_sleep(1); \
    if ((++_sp & 255u) == 0u) { if (xb_ld(&(bar)[XB_TMO])) break; if (_sp > XB_SPIN_CAP) { atomicAdd(&(bar)[XB_TMO], 1u); break; } } } } while (0)
struct XcdBarrier { unsigned* bar; unsigned x; volatile LAS unsigned* st; };
__device__ __forceinline__ XcdBarrier xcd_barrier_post(unsigned* bar, volatile LAS unsigned* st, bool t0  ) {
    XcdBarrier b; b.bar = bar; b.x = xb_xcc_id(); b.st = st;
    if (t0) (void)xb_add(&bar[XB_XCNT(b.x)], 1u);
    return b;
}
__device__ __forceinline__ void xcd_barrier_complete(unsigned* bar, unsigned x, unsigned& nloc, unsigned& nx) {
    const unsigned G = gridDim.x * gridDim.y * gridDim.z;
    unsigned sum, cnt, mine, sp = 0u;
    for (;;) {
        sum = 0u; cnt = 0u; mine = 0u;
#pragma unroll
        for (unsigned j = 0; j < 16; ++j) { const unsigned c = xb_ld(&bar[XB_XCNT(j)]); sum += c; cnt += (c > 0u) ? 1u : 0u; mine = (j == x) ? c : mine; }
        if (sum == G) break;
        __builtin_amdgcn_s_sleep(1);
        if ((++sp & 255u) == 0u) { if (xb_ld(&bar[XB_TMO])) break; if (sp > XB_SPIN_CAP) { atomicAdd(&bar[XB_TMO], 1u); break; } }
    }
    nloc = mine > 0u ? mine : 1u; nx = cnt > 0u ? cnt : 1u;
}
__device__ __forceinline__ void xcd_barrier(const XcdBarrier& b, bool t0  ) {
    asm volatile("s_waitcnt vmcnt(0)" ::: "memory");
    __syncthreads();
    if (t0) {
        unsigned* bar = b.bar;
        __builtin_amdgcn_s_waitcnt(0);
        unsigned nloc = b.st[0], nx = b.st[1];
        if (nloc == 0u) { xcd_barrier_complete(bar, b.x, nloc, nx); b.st[0] = nloc; b.st[1] = nx; }
        const unsigned old = xb_add(&bar[XB_XSUB(b.x)], 1u);
        const unsigned gen = old / nloc;
        if (old + 1u == (gen + 1u) * nloc) {
            __builtin_amdgcn_fence(__ATOMIC_RELEASE, "agent");
            asm volatile("s_waitcnt vmcnt(0)" ::: "memory");
            const unsigned og = xb_add(&bar[XB_TOP], 1u);
            const unsigned tg = og / nx;
            if (og + 1u == (tg + 1u) * nx) xb_add(&bar[XB_TOPGEN], 1u);
            else XB_SPIN(xb_ld(&bar[XB_TOPGEN]) == tg, bar);
            __builtin_amdgcn_fence(__ATOMIC_ACQUIRE, "agent");
            xb_add(&bar[XB_XGEN(b.x)], 1u);
            asm volatile("s_waitcnt vmcnt(0)" ::: "memory");
        } else {
            XB_SPIN(xb_ld(&bar[XB_XGEN(b.x)]) == gen, bar);
            __builtin_amdgcn_fence(__ATOMIC_ACQUIRE, "agent");
            asm volatile("s_waitcnt vmcnt(0)" ::: "memory");
        }
    }
    __syncthreads();
}
#ifndef EPI_RELAX
#define EPI_RELAX 1
#endif
#ifndef EPI_RES_2G
#define EPI_RES_2G 0
#endif
#ifndef EPI_PF_LEAD
#define EPI_PF_LEAD 8
#endif
#ifndef EPI_RES_PF
#define EPI_RES_PF 0
#endif
#ifndef PG8_L2PF_DEFAULT
#define PG8_L2PF_DEFAULT false
#endif
namespace pg8 {
constexpr int BM = 256, BK = 64, HALF = 128, HTB = HALF * BK * 2, NXCD = 8;
__host__ __device__ __forceinline__ int lds_byte(int r, int c) { const int st = (r >> 4) * 2 + (c >> 5), rr = r & 15, cc = c & 31, ob = rr * 64 + cc * 2; return st * 1024 + (ob ^ (((ob >> 9) & 1) << 5)); }
__host__ __device__ __forceinline__ void stage_rc(int b, int& R, int& C) { const int st = b / 1024, sb = b % 1024, swz = sb ^ (((sb >> 9) & 1) << 5); R = (st >> 1) * 16 + swz / 64; C = (st & 1) * 32 + (swz % 64) / 2; }
__host__ __device__ __forceinline__ int perm32(int rho) { const int n = rho >> 4, i = rho & 15; return 8 * (i >> 2) + 4 * n + (i & 3); }

struct Unit { int pm, pn; };
struct Gemm { const bf16_t* A0; const bf16_t* A1; int pn_split; int lda; int grouped; const bf16_t* Bt; int ldb; int K; int nM, nN; };
__device__ __forceinline__ const char* a_ptr(const Gemm& g, const Unit& u) {
    const bf16_t* a = (u.pn < g.pn_split) ? g.A0 : g.A1;
    return (const char*)(a + (size_t)u.pm * BM * g.lda + (g.grouped ? (u.pn >> 1) * 512 : 0));
}
__device__ __forceinline__ const char* b_ptr(const Gemm& g, const Unit& u) { return (const char*)(g.Bt + (size_t)u.pn * BM * g.ldb); }

struct StaticOrder {
    int nM, nN, nwg, G, c, WGM;
    __device__ void init(int nM_, int nN_, int G_, int c_, int wgm = 8) { nM = nM_; nN = nN_; nwg = nM * nN; G = G_; c = c_; WGM = wgm; }
    __device__ bool next(int i, Unit& u) const {
        const long L = (long)i * G + c; if (L >= nwg) return false;
        int wgid = (int)L; { const int q = nwg / NXCD, r = nwg % NXCD, xcd = wgid % NXCD, off = wgid / NXCD; wgid = (xcd < r ? xcd * (q + 1) : r * (q + 1) + (xcd - r) * q) + off; }
        const int nig = WGM * nN, gid = wgid / nig, fm = gid * WGM, gsz = (nM - fm) < WGM ? (nM - fm) : WGM;
        u.pm = fm + ((wgid % nig) % gsz); u.pn = (wgid % nig) / gsz; return true;
    }
};

template <class Epi, bool ALIGN_EPI = true, bool SP2 = true, bool STAGE_IN_MMA = false, bool L2PF = PG8_L2PF_DEFAULT>
__device__ __forceinline__ void gemm_phase(LAS unsigned char* lds, const Gemm g, const StaticOrder& S, const Epi& E, int wv) {
    const int tid = opaque_tid(wv), wid = wv, lane = tid & 63, wr = wid >> 2, wc = wid & 3, fr = lane & 15, fq = lane >> 4;
    const int K = g.K, nt = K / BK;
    const int tpf = nt > EPI_PF_LEAD ? nt - EPI_PF_LEAD : 0;
    unsigned voffA[2], voffB[2];
#pragma unroll
    for (int i = 0; i < 2; ++i) { int R, C; stage_rc(tid * 16 + i * 8192, R, C); const int Rb = (R & ~31) + perm32(R & 31);
        voffA[i] = (unsigned)(R * g.lda + C) * 2u; voffB[i] = (unsigned)(Rb * g.ldb + C) * 2u; }
    const size_t kstep = (size_t)(BK * 2);
    const size_t hstepA = (size_t)HALF * g.lda * 2, hstepB = (size_t)HALF * g.ldb * 2;
    const unsigned ldsw = (unsigned)wid * 1024u;
    const int wu = __builtin_amdgcn_readfirstlane(wid);
    const int aoff = lds_byte(wr * 64 + fr, fq * 8), boff = lds_byte(wc * 32 + fr, fq * 8);
#define PG8_SA(b, h) (((b) * 2 + (h)) * HTB)
#define PG8_SB(b, h) ((4 + (b) * 2 + (h)) * HTB)
#ifndef PG8_ASM_STAGE
#define PG8_ASM_STAGE 1
#endif
#if PG8_ASM_STAGE
    const unsigned ldsb = (unsigned)(size_t)lds + (unsigned)wu * 1024u;
#define PG8_STAGE(bufoff, gbase, voff) do { _Pragma("unroll") for (int _i = 0; _i < 2; ++_i) { const unsigned m0v_ = ldsb + (unsigned)(bufoff) + (unsigned)(_i * 8192); \
        asm volatile("s_mov_b32 m0, %0\n\ts_nop 0\n\tglobal_load_lds_dwordx4 %1, %2" :: "s"(m0v_), "v"((voff)[_i]), "s"((const char*)(gbase)) : "memory", "m0"); } } while (0)
#else
#define PG8_STAGE(bufoff, gbase, voff) do { _Pragma("unroll") for (int _i = 0; _i < 2; ++_i) \
        __builtin_amdgcn_global_load_lds((const unsigned*)((const char*)(gbase) + (voff)[_i]), (LAS unsigned*)(lds + (bufoff) + ldsw + _i * 8192), 16, 0, 0); } while (0)
#endif
#define PG8_LDA(dst, b, h) do { _Pragma("unroll") for (int m = 0; m < 4; ++m) _Pragma("unroll") for (int k = 0; k < 2; ++k) dst[m][k] = *(const LAS bf16x8*)(lds + PG8_SA(b, h) + aoff + m * 2048 + k * 1024); } while (0)
#define PG8_LDB(dst, b, h) do { _Pragma("unroll") for (int n = 0; n < 2; ++n) _Pragma("unroll") for (int k = 0; k < 2; ++k) dst[n][k] = *(const LAS bf16x8*)(lds + PG8_SB(b, h) + boff + n * 2048 + k * 1024); } while (0)
#ifndef PG8_STAGE_FIRST
#define PG8_STAGE_FIRST 0
#endif
#ifndef PG8_PRIO
#define PG8_PRIO 1
#endif
#define PG8_MMA(ai, bj, At, Bt) do { if (PG8_PRIO) __builtin_amdgcn_s_setprio(1); _Pragma("unroll") for (int m = 0; m < 4; ++m) _Pragma("unroll") for (int n = 0; n < 2; ++n) _Pragma("unroll") for (int k = 0; k < 2; ++k) \
        acc[ai][bj][m][n] = __builtin_amdgcn_mfma_f32_16x16x32_bf16(Bt[n][k], At[m][k], acc[ai][bj][m][n], 0, 0, 0); if (PG8_PRIO) __builtin_amdgcn_s_setprio(0); } while (0)
#define PG8_WAIT_V(n) asm volatile("s_waitcnt vmcnt(" #n ")" ::: "memory")
#define PG8_WAIT_L(n) asm volatile("s_waitcnt lgkmcnt(" #n ")" ::: "memory")
#define PG8_BAR __builtin_amdgcn_s_barrier()
#define PG8_SCHED __builtin_amdgcn_sched_barrier(0)
    Unit cur, nxt; int ui = 0;
    if (!S.next(0, cur)) return;
    f32x4 acc[2][2][4][2];
#pragma unroll
    for (int a = 0; a < 2; ++a)
#pragma unroll
        for (int b = 0; b < 2; ++b)
#pragma unroll
            for (int m = 0; m < 4; ++m)
#pragma unroll
                for (int n = 0; n < 2; ++n) acc[a][b][m][n] = (f32x4){0.f, 0.f, 0.f, 0.f};
    bf16x8 At[4][2], B0[2][2], B1[2][2];
    const char* cA = a_ptr(g, cur); const char* cB = b_ptr(g, cur);
    if constexpr (SP2) {
    PG8_STAGE(PG8_SB(0, 0), cB, voffB); PG8_STAGE(PG8_SB(0, 1), cB + hstepB, voffB); PG8_STAGE(PG8_SA(0, 0), cA, voffA); PG8_STAGE(PG8_SA(0, 1), cA + hstepA, voffA);
    if (wr == 1) PG8_BAR;
    PG8_WAIT_V(2); PG8_BAR;
    PG8_STAGE(PG8_SB(1, 0), cB + kstep, voffB); PG8_STAGE(PG8_SA(1, 0), cA + kstep, voffA); PG8_STAGE(PG8_SB(1, 1), cB + hstepB + kstep, voffB);
    PG8_WAIT_V(6); PG8_BAR;
    } else {
    PG8_STAGE(PG8_SB(0, 0), cB, voffB); PG8_STAGE(PG8_SA(0, 0), cA, voffA); PG8_STAGE(PG8_SB(0, 1), cB + hstepB, voffB); PG8_STAGE(PG8_SA(0, 1), cA + hstepA, voffA);
    if (wr == 1) PG8_BAR;
    PG8_WAIT_V(4); PG8_BAR;
    PG8_STAGE(PG8_SB(1, 0), cB + kstep, voffB); PG8_STAGE(PG8_SA(1, 0), cA + kstep, voffA); PG8_STAGE(PG8_SB(1, 1), cB + hstepB + kstep, voffB);
    PG8_WAIT_V(6); PG8_BAR;
    }
    for (;;) {
        const bool has_next = S.next(ui + 1, nxt);
        const char* nA = has_next ? a_ptr(g, nxt) : cA; const char* nB = has_next ? b_ptr(g, nxt) : cB;
        int pf_id = 0; const int pf_sh = (S.WGM == 8) ? (wu < 4 ? 6 : 5) : (wu < 4 ? 5 : 6);
        if constexpr (L2PF) pf_id = (S.WGM == 8) ? (wu < 4 ? (cur.pn & 3) : (cur.pm & 7)) : (wu < 4 ? (cur.pn & 7) : (cur.pm & 3));
        for (int t = 0; t < nt; t += 2) {
            const bool last = (t == nt - 2);
            const char* a1 = cA + (size_t)(t + 1) * kstep;
            const char* a2 = last ? nA : cA + (size_t)(t + 2) * kstep; const char* b2 = last ? nB : cB + (size_t)(t + 2) * kstep;
            const char* a3 = a2 + kstep; const char* b3 = b2 + kstep;
            if constexpr (!SP2) {
            PG8_LDB(B0, 0, 0); PG8_SCHED; PG8_LDA(At, 0, 0); PG8_STAGE(PG8_SA(1, 1), a1 + hstepA, voffA);
            PG8_WAIT_L(8); PG8_BAR; PG8_WAIT_L(0); PG8_MMA(0, 0, At, B0); PG8_BAR; PG8_SCHED;
            PG8_LDB(B1, 0, 1); PG8_STAGE(PG8_SB(0, 0), b2, voffB);
            PG8_BAR; PG8_WAIT_L(0); PG8_MMA(0, 1, At, B1); PG8_BAR;
            PG8_LDA(At, 0, 1); PG8_STAGE(PG8_SA(0, 0), a2, voffA);
            PG8_BAR; PG8_WAIT_L(0); PG8_MMA(1, 0, At, B0); PG8_BAR; PG8_SCHED;
            PG8_STAGE(PG8_SB(0, 1), b2 + hstepB, voffB);
            PG8_WAIT_V(6); PG8_BAR; PG8_MMA(1, 1, At, B1); PG8_BAR;
            PG8_LDB(B0, 1, 0); PG8_SCHED; PG8_LDA(At, 1, 0); PG8_STAGE(PG8_SA(0, 1), a2 + hstepA, voffA);
            PG8_WAIT_L(8); PG8_BAR; PG8_WAIT_L(0); PG8_MMA(0, 0, At, B0); PG8_BAR; PG8_SCHED;
            PG8_LDB(B1, 1, 1); PG8_STAGE(PG8_SB(1, 0), b3, voffB);
            PG8_BAR; PG8_WAIT_L(0); PG8_MMA(0, 1, At, B1); PG8_BAR;
            PG8_LDA(At, 1, 1); PG8_STAGE(PG8_SA(1, 0), a3, voffA);
            PG8_BAR; PG8_WAIT_L(0); PG8_MMA(1, 0, At, B0); PG8_BAR; PG8_SCHED;
            PG8_STAGE(PG8_SB(1, 1), b3 + hstepB, voffB);
            PG8_WAIT_V(6); PG8_BAR; PG8_MMA(1, 1, At, B1); PG8_BAR;
            } else if constexpr (STAGE_IN_MMA) {
            PG8_LDB(B0, 0, 0); PG8_LDB(B1, 0, 1); PG8_SCHED; PG8_LDA(At, 0, 0);
            PG8_WAIT_V(6); PG8_WAIT_L(0); PG8_BAR; PG8_MMA(0, 0, At, B0); PG8_STAGE(PG8_SA(1, 1), a1 + hstepA, voffA); PG8_MMA(0, 1, At, B1); PG8_BAR; PG8_SCHED;
            PG8_LDA(At, 0, 1);
            PG8_WAIT_V(2); PG8_WAIT_L(0); PG8_BAR; PG8_MMA(1, 0, At, B0); PG8_STAGE(PG8_SB(0, 0), b2, voffB); PG8_STAGE(PG8_SB(0, 1), b2 + hstepB, voffB); PG8_STAGE(PG8_SA(0, 0), a2, voffA); PG8_MMA(1, 1, At, B1); PG8_BAR; PG8_SCHED;
            PG8_LDB(B0, 1, 0); PG8_LDB(B1, 1, 1); PG8_SCHED; PG8_LDA(At, 1, 0);
            PG8_WAIT_V(6); PG8_WAIT_L(0); PG8_BAR; PG8_MMA(0, 0, At, B0); PG8_STAGE(PG8_SA(0, 1), a2 + hstepA, voffA); PG8_MMA(0, 1, At, B1); PG8_BAR; PG8_SCHED;
            PG8_LDA(At, 1, 1);
            PG8_WAIT_V(2); PG8_WAIT_L(0); PG8_BAR; PG8_MMA(1, 0, At, B0); PG8_STAGE(PG8_SB(1, 0), b3, voffB); PG8_STAGE(PG8_SB(1, 1), b3 + hstepB, voffB); PG8_STAGE(PG8_SA(1, 0), a3, voffA); PG8_MMA(1, 1, At, B1); PG8_BAR; PG8_SCHED;
            } else {
#if PG8_STAGE_FIRST
            PG8_STAGE(PG8_SA(1, 1), a1 + hstepA, voffA); PG8_SCHED; PG8_LDB(B0, 0, 0); PG8_LDB(B1, 0, 1); PG8_SCHED; PG8_LDA(At, 0, 0);
            PG8_WAIT_V(8); PG8_WAIT_L(0); PG8_BAR; PG8_MMA(0, 0, At, B0); PG8_MMA(0, 1, At, B1); PG8_BAR; PG8_SCHED;
            PG8_STAGE(PG8_SB(0, 0), b2, voffB); PG8_STAGE(PG8_SB(0, 1), b2 + hstepB, voffB); PG8_STAGE(PG8_SA(0, 0), a2, voffA); PG8_SCHED; PG8_LDA(At, 0, 1);
            PG8_WAIT_V(8); PG8_WAIT_L(0); PG8_BAR; PG8_MMA(1, 0, At, B0); PG8_MMA(1, 1, At, B1); PG8_BAR; PG8_SCHED;
            PG8_STAGE(PG8_SA(0, 1), a2 + hstepA, voffA); PG8_SCHED; PG8_LDB(B0, 1, 0); PG8_LDB(B1, 1, 1); PG8_SCHED; PG8_LDA(At, 1, 0);
            PG8_WAIT_V(8); PG8_WAIT_L(0); PG8_BAR; PG8_MMA(0, 0, At, B0); PG8_MMA(0, 1, At, B1); PG8_BAR; PG8_SCHED;
            PG8_STAGE(PG8_SB(1, 0), b3, voffB); PG8_STAGE(PG8_SB(1, 1), b3 + hstepB, voffB); PG8_STAGE(PG8_SA(1, 0), a3, voffA); PG8_SCHED; PG8_LDA(At, 1, 1);
            PG8_WAIT_V(8); PG8_WAIT_L(0); PG8_BAR; PG8_MMA(1, 0, At, B0); PG8_MMA(1, 1, At, B1); PG8_BAR; PG8_SCHED;
#else
#define PG8_PF(tt) do { if constexpr (L2PF) { const int tp_ = (tt) + 4 < nt ? (tt) + 4 : nt - 1; const bool isA_ = wu < 4; \
                const int r_ = (wu & 3) * 64 + opaque_lane(); const unsigned o_ = ((r_ >> pf_sh) == pf_id) ? (unsigned)r_ * ((unsigned)(isA_ ? g.lda : g.ldb) * 2u) : 0u; \
                const unsigned m0v_ = (unsigned)(size_t)lds + 131072u + (unsigned)wu * 256u; \
                asm volatile("s_mov_b32 m0, %0\n\ts_nop 0\n\tglobal_load_lds_dword %1, %2" :: "s"(m0v_), "v"(o_), "s"((isA_ ? cA : cB) + (size_t)tp_ * kstep) : "memory", "m0"); } } while (0)
#define PG8_WAIT_VP() do { if constexpr (L2PF) PG8_WAIT_V(9); else PG8_WAIT_V(8); } while (0)
#define PG8_WAIT_VF() do { if constexpr (Epi::NVM > 0 && !L2PF) { if (t == 0 && ui > 0) asm volatile("s_waitcnt vmcnt(%0)" :: "i"(8 + Epi::NVM) : "memory"); else PG8_WAIT_V(8); } else PG8_WAIT_VP(); } while (0)
            if constexpr (Epi::HAS_PF) { if (t == tpf) { E.prefetch(cur, wu, opaque_lane()); PG8_SCHED; } }
            PG8_PF(t); PG8_SCHED; PG8_LDB(B0, 0, 0); PG8_LDB(B1, 0, 1); PG8_SCHED; PG8_LDA(At, 0, 0); PG8_STAGE(PG8_SA(1, 1), a1 + hstepA, voffA);
            PG8_WAIT_VF(); PG8_WAIT_L(0); PG8_BAR; PG8_MMA(0, 0, At, B0); PG8_MMA(0, 1, At, B1); PG8_BAR; PG8_SCHED;
            PG8_LDA(At, 0, 1); PG8_STAGE(PG8_SB(0, 0), b2, voffB); PG8_STAGE(PG8_SB(0, 1), b2 + hstepB, voffB); PG8_STAGE(PG8_SA(0, 0), a2, voffA);
            PG8_WAIT_VF(); PG8_WAIT_L(0); PG8_BAR; PG8_MMA(1, 0, At, B0); PG8_MMA(1, 1, At, B1); PG8_BAR; PG8_SCHED;
            PG8_PF(t + 1); PG8_SCHED; PG8_LDB(B0, 1, 0); PG8_LDB(B1, 1, 1); PG8_SCHED; PG8_LDA(At, 1, 0); PG8_STAGE(PG8_SA(0, 1), a2 + hstepA, voffA);
            PG8_WAIT_VP(); PG8_WAIT_L(0); PG8_BAR; PG8_MMA(0, 0, At, B0); PG8_MMA(0, 1, At, B1); PG8_BAR; PG8_SCHED;
            PG8_LDA(At, 1, 1); PG8_STAGE(PG8_SB(1, 0), b3, voffB); PG8_STAGE(PG8_SB(1, 1), b3 + hstepB, voffB); PG8_STAGE(PG8_SA(1, 0), a3, voffA);
            PG8_WAIT_VP(); PG8_WAIT_L(0); PG8_BAR; PG8_MMA(1, 0, At, B0); PG8_MMA(1, 1, At, B1); PG8_BAR; PG8_SCHED;
#undef PG8_PF
#undef PG8_WAIT_VP
#undef PG8_WAIT_VF
#endif
            }
        }
        if constexpr (ALIGN_EPI) { if (wr == 0) PG8_BAR; }
        { const int te = opaque_lane(); E(acc, cur, wr, wc, te & 15, (te >> 4) & 3); }
        if (!has_next) break;
#pragma unroll
        for (int a = 0; a < 2; ++a)
#pragma unroll
            for (int b = 0; b < 2; ++b)
#pragma unroll
                for (int m = 0; m < 4; ++m)
#pragma unroll
                    for (int n = 0; n < 2; ++n) acc[a][b][m][n] = (f32x4){0.f, 0.f, 0.f, 0.f};
        cur = nxt; cA = nA; cB = nB; ++ui;
        if constexpr (ALIGN_EPI) { if (wr == 1) PG8_BAR; }
    }
    PG8_WAIT_V(0);
    if constexpr (!ALIGN_EPI) { if (wr == 0) PG8_BAR; }
    PG8_BAR;
#undef PG8_SA
#undef PG8_SB
#undef PG8_STAGE
#undef PG8_LDA
#undef PG8_LDB
#undef PG8_MMA
#undef PG8_WAIT_V
#undef PG8_WAIT_L
#undef PG8_BAR
#undef PG8_SCHED
}

__device__ __forceinline__ u32x4 pack8bf(const f32x4& a, const f32x4& b) { u32x4 w; w.x = cvt_pk_bf16(a[0], a[1]); w.y = cvt_pk_bf16(a[2], a[3]); w.z = cvt_pk_bf16(b[0], b[1]); w.w = cvt_pk_bf16(b[2], b[3]); return w; }
__device__ __forceinline__ float sumsq4(const f32x4& a) { return (a[0] * a[0] + a[1] * a[1]) + (a[2] * a[2] + a[3] * a[3]); }

struct EpiRes {
    const float* xin32; const bf16_t* xin16; float* xout32; bf16_t* xout16; unsigned char* xlo; const float* gate; const float* gm0; bf16_t* a0; const float* gm1; bf16_t* a1; rs_t* rowss;
    unsigned pfl;
    static constexpr bool HAS_PF = EPI_RES_PF != 0;
    static constexpr int NVM = EPI_RELAX ? 32 : 0;
    __device__ __forceinline__ void prefetch(const Unit& u, int wv_  , int ln_) const {
        if (pfl && !xin32 && XBF16 == 2) {
            const unsigned prow = (unsigned)(u.pm * BM + (wv_ & 1) * HALF + (wv_ >> 2) * 64 + ln_);
            const unsigned oh0 = (prow * DM + (unsigned)(u.pn * BM + ((wv_ >> 1) & 1) * 64)) * 2u, oh1 = oh0 + 256u;
            const unsigned ol = prow * DM + (unsigned)(u.pn * BM + ((wv_ >> 1) & 1) * HALF);
            const unsigned m0v = pfl + (unsigned)wv_ * 256u;
            asm volatile("s_mov_b32 m0, %0\n\ts_nop 0\n\tglobal_load_lds_dword %1, %4\n\tglobal_load_lds_dword %2, %4\n\tglobal_load_lds_dword %3, %5"
                         :: "s"(m0v), "v"(oh0), "v"(oh1), "v"(ol), "s"(xin16), "s"(xlo) : "memory", "m0");
        }
    }
    __device__ __forceinline__ void operator()(const f32x4 (&acc)[2][2][4][2], const Unit& u, int wr, int wc, int fr, int fq) const {
        const int b = u.pm >> 4; const int row0 = u.pm * BM + wr * 64 + fr;
        float ss[2][4];
#pragma unroll
        for (int ai = 0; ai < 2; ++ai)
#pragma unroll
            for (int m = 0; m < 4; ++m) ss[ai][m] = 0.f;
#pragma unroll
        for (int bj = 0; bj < 2; ++bj) {
            const int col = u.pn * BM + bj * HALF + wc * 32 + 8 * fq; const int vo = b * DM + col;
            const f32x4 g0 = *(const f32x4*)(gate + vo), g1 = *(const f32x4*)(gate + vo + 4);
            f32x4 m00 = {0, 0, 0, 0}, m01 = {0, 0, 0, 0}, m10 = {0, 0, 0, 0}, m11 = {0, 0, 0, 0};
            if (a0) { m00 = *(const f32x4*)(gm0 + vo); m01 = *(const f32x4*)(gm0 + vo + 4); }
            if (a1) { m10 = *(const f32x4*)(gm1 + vo); m11 = *(const f32x4*)(gm1 + vo + 4); }
#if EPI_RES_2G
            u32x4 xr2[4];
            if (!xin32) {
#pragma unroll
                for (int m = 0; m < 4; ++m) { const size_t off = (size_t)(row0 + HALF + m * 16) * DM + col; xr2[m] = *(const u32x4*)(xin16 + off); }
            }
#endif
#pragma unroll
            for (int ai = 0; ai < 2; ++ai) {
                f32x4 xv[4][2];
                if (xin32) {
#pragma unroll
                    for (int m = 0; m < 4; ++m) { const size_t off = (size_t)(row0 + ai * HALF + m * 16) * DM + col; xv[m][0] = *(const f32x4*)(xin32 + off); xv[m][1] = *(const f32x4*)(xin32 + off + 4); }
                } else {
                    u32x4 xr[4]; u32x2 xl[4];
#if EPI_RES_2G
#pragma unroll
                    for (int m = 0; m < 4; ++m) { const size_t off = (size_t)(row0 + ai * HALF + m * 16) * DM + col; if (ai == 0) xr[m] = *(const u32x4*)(xin16 + off); else xr[m] = xr2[m];
                        if (XBF16 == 2) xl[m] = *(const u32x2*)(xlo + off); }
#else
#pragma unroll
                    for (int m = 0; m < 4; ++m) { const size_t off = (size_t)(row0 + ai * HALF + m * 16) * DM + col; xr[m] = *(const u32x4*)(xin16 + off);
                        if (XBF16 == 2) xl[m] = *(const u32x2*)(xlo + off); }
#endif
#pragma unroll
                    for (int m = 0; m < 4; ++m) { if (XBF16 == 2) x8_unpack24(xr[m], xl[m], xv[m][0], xv[m][1]); else x8_unpack16(xr[m], xv[m][0], xv[m][1]); }
                }
#pragma unroll
                for (int m = 0; m < 4; ++m) {
                    const size_t off = (size_t)(row0 + ai * HALF + m * 16) * DM + col;
                    const f32x4 v0 = xv[m][0] + g0 * acc[ai][bj][m][0], v1 = xv[m][1] + g1 * acc[ai][bj][m][1];
                    if (xout32) { *(f32x4*)(xout32 + off) = v0; *(f32x4*)(xout32 + off + 4) = v1; }
                    else if (XBF16 == 2) { u32x4 hh; u32x2 ll; x8_pack24(v0, v1, hh, ll); st_stream((u32x4*)(xout16 + off), hh); st_stream((u32x2*)(xlo + off), ll); }
                    else *(u32x4*)(xout16 + off) = pack8bf(v0, v1);
                    ss[ai][m] += sumsq4(v0) + sumsq4(v1);
                    if (a0) *(u32x4*)(a0 + off) = pack8bf(v0 * m00, v1 * m01);
                    if (a1) *(u32x4*)(a1 + off) = pack8bf(v0 * m10, v1 * m11);
                }
            }
        }
        if (rowss) {
#pragma unroll
            for (int ai = 0; ai < 2; ++ai)
#pragma unroll
                for (int m = 0; m < 4; ++m) { float s = ss[ai][m]; s += swz_xor16(s); s = add_xor32(s); if (fq == 0) rs_add(rowss + row0 + ai * HALF + m * 16, s); }
        }
    }
};

struct EpiNull { float* sink;
    static constexpr bool HAS_PF = false; __device__ __forceinline__ void prefetch(const Unit&, int, int) const {} static constexpr int NVM = 0;
    __device__ __forceinline__ void operator()(const f32x4 (&acc)[2][2][4][2], const Unit& u, int wr, int wc, int fr, int fq) const {
        f32x4 t = {0.f, 0.f, 0.f, 0.f};
#pragma unroll
        for (int ai = 0; ai < 2; ++ai)
#pragma unroll
            for (int bj = 0; bj < 2; ++bj)
#pragma unroll
                for (int m = 0; m < 4; ++m) t += acc[ai][bj][m][0] + acc[ai][bj][m][1];
        *(f32x4*)(sink + ((size_t)(blockIdx.x * 512 + threadIdx.x) * 4)) = t;
    }
};

struct EpiSwi {
    static constexpr bool HAS_PF = false; __device__ __forceinline__ void prefetch(const Unit&, int, int) const {} static constexpr int NVM = EPI_RELAX ? 16 : 0;
    const rs_t* rowss; const float* bias; bf16_t* act;
    __device__ __forceinline__ void operator()(const f32x4 (&acc)[2][2][4][2], const Unit& u, int wr, int wc, int fr, int fq) const {
        const int b = u.pm >> 4; const int row0 = u.pm * BM + wr * 64 + fr;
        const int vc = u.pn * BM + wc * 32 + 8 * fq; const int ac = u.pn * HALF + wc * 32 + 8 * fq;
        const float* bp = bias + (size_t)b * 11264 + vc;
        const f32x4 bg0 = *(const f32x4*)bp, bg1 = *(const f32x4*)(bp + 4), bu0 = *(const f32x4*)(bp + HALF), bu1 = *(const f32x4*)(bp + HALF + 4);
        const f32x4 bgl0 = bg0 * -1.4426950408889634f, bgl1 = bg1 * -1.4426950408889634f;
        float rsv[8];
#pragma unroll
        for (int r = 0; r < 8; ++r) rsv[r] = rs_get(rowss + row0 + (r >> 2) * HALF + (r & 3) * 16);
#pragma unroll
        for (int ai = 0; ai < 2; ++ai)
#pragma unroll
            for (int m = 0; m < 4; ++m) {
                const int row = row0 + ai * HALF + m * 16;
                const float rstd = rsqrtf(rsv[ai * 4 + m] * (1.f / DM) + EPS);
                const float rl = rstd * -1.4426950408889634f;
                const f32x4 ga = acc[ai][0][m][0] * rstd + bg0, gb = acc[ai][0][m][1] * rstd + bg1, ua = acc[ai][1][m][0] * rstd + bu0, ub = acc[ai][1][m][1] * rstd + bu1;
                f32x4 ea = acc[ai][0][m][0] * rl + bgl0, eb = acc[ai][0][m][1] * rl + bgl1;
#pragma unroll
                for (int j = 0; j < 4; ++j) { ea[j] = __builtin_amdgcn_exp2f(ea[j]); eb[j] = __builtin_amdgcn_exp2f(eb[j]); }
                ea = ea + 1.f; eb = eb + 1.f;
#pragma unroll
                for (int j = 0; j < 4; ++j) { ea[j] = __builtin_amdgcn_rcpf(ea[j]); eb[j] = __builtin_amdgcn_rcpf(eb[j]); }
                const f32x4 r0 = (ga * ua) * ea, r1 = (gb * ub) * eb;
                st_stream((u32x4*)(act + (size_t)row * FF + ac), pack8bf(r0, r1));
            }
    }
};

struct EpiDown {
    static constexpr bool HAS_PF = false; __device__ __forceinline__ void prefetch(const Unit&, int, int) const {} static constexpr int NVM = 0;
    const rs_t* rowss1; const float* bias; int ldbias; int pn_q0;
    unsigned char* ws; rs_t* rsb; int rsq;
    const float2* tab;
    __device__ __forceinline__ void operator()(const f32x4 (&acc)[2][2][4][2], const Unit& u, int wr, int wc, int fr, int fq) const {
        const int b = u.pm >> 4; const int row0 = u.pm * BM + wr * 64 + fr;
        const float* bp = bias + (size_t)b * ldbias + u.pn * BM + wc * 32 + 8 * fq;
        const f32x4 b00 = *(const f32x4*)bp, b01 = *(const f32x4*)(bp + 4), b10 = *(const f32x4*)(bp + HALF), b11 = *(const f32x4*)(bp + HALF + 4);
        const bool is_q = u.pn >= pn_q0;
        if (is_q || u.pn < 2) {
            bf16_t* dst = (bf16_t*)(ws + (is_q ? WS_CQ : WS_CKV)); rs_t* rs = rsb + (size_t)(is_q ? rsq : RS_KV) * 16384;
            const int col = (is_q ? (u.pn - pn_q0) : u.pn) * BM + wc * 32 + 8 * fq;
#pragma unroll
            for (int ai = 0; ai < 2; ++ai)
#pragma unroll
                for (int m = 0; m < 4; ++m) {
                    const int row = row0 + ai * HALF + m * 16;
                    const float rstd = rsqrtf(rs_get(rowss1 + row) * (1.f / DM) + EPS);
                    const f32x4 v00 = acc[ai][0][m][0] * rstd + b00, v01 = acc[ai][0][m][1] * rstd + b01, v10 = acc[ai][1][m][0] * rstd + b10, v11 = acc[ai][1][m][1] * rstd + b11;
                    *(u32x4*)(dst + (size_t)row * 512 + col) = pack8bf(v00, v01);
                    *(u32x4*)(dst + (size_t)row * 512 + col + HALF) = pack8bf(v10, v11);
                    float s = (sumsq4(v00) + sumsq4(v01)) + (sumsq4(v10) + sumsq4(v11));
                    s += swz_xor16(s); s = add_xor32(s); if (fq == 0) rs_add(rs + row, s);
                }
        } else if (wc == 0) {
            bf16_t* kr = (bf16_t*)(ws + WS_KR);
#pragma unroll
            for (int ai = 0; ai < 2; ++ai)
#pragma unroll
                for (int m = 0; m < 4; ++m) {
                    const int row = row0 + ai * HALF + m * 16;
                    const float rstd = rsqrtf(rs_get(rowss1 + row) * (1.f / DM) + EPS);
                    const f32x4 t10 = acc[ai][0][m][0] * rstd + b00, t11 = acc[ai][0][m][1] * rstd + b01, t20 = acc[ai][1][m][0] * rstd + b10, t21 = acc[ai][1][m][1] * rstd + b11;
                    const float2* tp = tab + (size_t)row * 32 + 8 * fq;
                    f32x4 o10, o11, o20, o21;
#pragma unroll
                    for (int j = 0; j < 4; ++j) { const float2 ca = tp[j], cb = tp[4 + j];
                        o10[j] = t10[j] * ca.x - t20[j] * ca.y; o20[j] = t20[j] * ca.x + t10[j] * ca.y;
                        o11[j] = t11[j] * cb.x - t21[j] * cb.y; o21[j] = t21[j] * cb.x + t11[j] * cb.y; }
                    *(u32x4*)(kr + (size_t)row * 64 + 8 * fq) = pack8bf(o10, o11);
                    *(u32x4*)(kr + (size_t)row * 64 + 32 + 8 * fq) = pack8bf(o20, o21);
                }
        }
    }
};

struct EpiUp {
    static constexpr bool HAS_PF = false; __device__ __forceinline__ void prefetch(const Unit&, int, int) const {} static constexpr int NVM = EPI_RELAX ? 16 : 0;
    unsigned char* ws; const rs_t* rsb; int rsq; int pn_q0; const float2* tab;
    __device__ __forceinline__ void operator()(const f32x4 (&acc)[2][2][4][2], const Unit& u, int wr, int wc, int fr, int fq) const {
        const int row0 = u.pm * BM + wr * 64 + fr;
        const bool is_q = u.pn >= pn_q0; const int p = is_q ? u.pn - pn_q0 : u.pn;
        const rs_t* rs = rsb + (size_t)(is_q ? rsq : RS_KV) * 16384;
        if (!(is_q && p >= 8)) {
            bf16_t* dst = (bf16_t*)(ws + (is_q ? WS_QN : (p < 8 ? WS_KN : WS_V)));
            const int col = (p & 7) * BM + wc * 32 + 8 * fq;
#pragma unroll
            for (int ai = 0; ai < 2; ++ai)
#pragma unroll
                for (int m = 0; m < 4; ++m) {
                    const int row = row0 + ai * HALF + m * 16;
                    const float rstd = rsqrtf(rs_get(rs + row) * (1.f / 512.f) + EPS);
                    st_stream((u32x4*)(dst + (size_t)row * DM + col), pack8bf(acc[ai][0][m][0] * rstd, acc[ai][0][m][1] * rstd));
                    st_stream((u32x4*)(dst + (size_t)row * DM + col + HALF), pack8bf(acc[ai][1][m][0] * rstd, acc[ai][1][m][1] * rstd));
                }
        } else {
            bf16_t* qr = (bf16_t*)(ws + WS_QR);
            const int hh = 4 * (p - 8) + wc;
#pragma unroll
            for (int ai = 0; ai < 2; ++ai)
#pragma unroll
                for (int m = 0; m < 4; ++m) {
                    const int row = row0 + ai * HALF + m * 16;
                    const float rstd = rsqrtf(rs_get(rs + row) * (1.f / 512.f) + EPS);
                    const f32x4 t10 = acc[ai][0][m][0] * rstd, t11 = acc[ai][0][m][1] * rstd, t20 = acc[ai][1][m][0] * rstd, t21 = acc[ai][1][m][1] * rstd;
                    const float2* tp = tab + (size_t)row * 32 + 8 * fq;
                    f32x4 o10, o11, o20, o21;
#pragma unroll
                    for (int j = 0; j < 4; ++j) { const float2 ca = tp[j], cb = tp[4 + j];
                        o10[j] = t10[j] * ca.x - t20[j] * ca.y; o20[j] = t20[j] * ca.x + t10[j] * ca.y;
                        o11[j] = t11[j] * cb.x - t21[j] * cb.y; o21[j] = t21[j] * cb.x + t11[j] * cb.y; }
                    st_stream((u32x4*)(qr + (size_t)row * 1024 + hh * 64 + 8 * fq), pack8bf(o10, o11));
                    st_stream((u32x4*)(qr + (size_t)row * 1024 + hh * 64 + 32 + 8 * fq), pack8bf(o20, o21));
                }
        }
    }
};
}
namespace att {
constexpr int D = 128, DQK = 192, NW = 8, QBLK = 32, KVBLK = 64, QB = NW * QBLK;
constexpr int LDQ = 2048, LDQR = 1024, LDKR = 64;
constexpr float SCALE = 0.07216878364870322f;
constexpr float THR = 8.f;
constexpr int KROW = 400;
constexpr int SHM_V = KVBLK * D * 2, SHM_K = KVBLK * KROW;
constexpr int NVS = 3;
constexpr int K_LDS_OFF = NVS * SHM_V, WS_LDS_OFF = K_LDS_OFF + 2 * SHM_K;
constexpr int QR_LDS_OFF = WS_LDS_OFF + NW * 64 * 4;
constexpr int ATT_LDS_BYTES = QR_LDS_OFF + NW * 4096;
constexpr int PF_LDS_OFF = ATT_LDS_BYTES;
static_assert(ATT_LDS_BYTES + 2048 <= MISC_OFF, "attention LDS map");
#ifndef ATT_SKIP
#define ATT_SKIP 1
#endif
#ifndef ATT_SWAP
#define ATT_SWAP 3
#endif
#define SBAR() __builtin_amdgcn_sched_barrier(0)
__device__ __forceinline__ int v_st(int k, int c) { const int kk = (k & ~0xC) | ((k & 4) << 1) | ((k & 8) >> 1); return ((kk >> 3) * 4 + (c >> 5)) * 512 + ((kk & 7) * 32 + (c & 31)) * 2; }
__device__ __forceinline__ int v_rd_base(int lane) { return ((lane & 3) << 3) | (((lane >> 2) & 3) << 6) | (((lane >> 4) & 1) << 5) | (((lane >> 5) & 1) << 8); }
constexpr int v_rd_off(int d0, int ks, int half) { return d0 * 512 + ks * 4096 + half * 2048; }
__device__ __forceinline__ int crow(int r, int hi) { return (r & 3) + 8 * (r >> 2) + 4 * hi; }
__device__ __forceinline__ unsigned cvtpk(float lo, float hi) { unsigned r; asm volatile("v_cvt_pk_bf16_f32 %0, %1, %2" : "=v"(r) : "v"(lo), "v"(hi)); return r; }
__device__ __forceinline__ bf16x8 load8(const bf16_t* p) { return *reinterpret_cast<const bf16x8*>(p); }
__device__ __forceinline__ void mask_tile(f32x16& p0, f32x16& p1, int dq) {
    const float NEG = -__builtin_inff();
#pragma unroll
    for (int r = 0; r < 16; ++r) {
        const int c = (r & 3) + 8 * (r >> 2);
        if (dq - c < 0) p0[r] = NEG;
        if (dq - c - 32 < 0) p1[r] = NEG;
    }
}
__device__ __forceinline__ void partialSM(f32x16& p0, f32x16& p1, float& m_reg, float& mn, float& alpha) {
    float pmax = p0[0]; for (int r = 1; r < 16; ++r) pmax = fmaxf(pmax, p0[r]); for (int r = 0; r < 16; ++r) pmax = fmaxf(pmax, p1[r]);
    { auto rr = __builtin_amdgcn_permlane32_swap(__float_as_uint(pmax), __float_as_uint(pmax), false, false);
      pmax = fmaxf(__uint_as_float(rr[0]), __uint_as_float(rr[1])); }
    constexpr float C2 = 1.4426950408889634f * SCALE;
    if (__builtin_expect(__all((pmax - m_reg) * SCALE <= THR), 1)) { mn = m_reg; alpha = 1.f; }
    else { mn = fmaxf(m_reg, pmax); alpha = __builtin_amdgcn_exp2f((m_reg - mn) * C2); m_reg = mn; }
    const float mnL = -mn * C2;
    for (int r = 0; r < 16; ++r) p0[r] = fmaf(p0[r], C2, mnL); for (int r = 0; r < 16; ++r) p1[r] = fmaf(p1[r], C2, mnL);
    for (int r = 0; r < 16; ++r) p0[r] = __builtin_amdgcn_exp2f(p0[r]);
}
__device__ __forceinline__ void finishSM(f32x16& p0, f32x16& p1, float alpha, float& l_reg, bf16x8& pa0, bf16x8& pa1, bf16x8& pa2, bf16x8& pa3) {
    for (int r = 0; r < 16; ++r) p1[r] = __builtin_amdgcn_exp2f(p1[r]);
    float ps = 0; for (int r = 0; r < 16; ++r) ps += p0[r]; for (int r = 0; r < 16; ++r) ps += p1[r];
    { auto rr = __builtin_amdgcn_permlane32_swap(__float_as_uint(ps), __float_as_uint(ps), false, false);
      ps = __uint_as_float(rr[0]) + __uint_as_float(rr[1]); }
    l_reg = l_reg * alpha + ps;
#define PK4(P, B_, OUT) do { unsigned a0 = cvtpk(P[B_+0], P[B_+1]), a1 = cvtpk(P[B_+2], P[B_+3]);                          \
        unsigned b0 = cvtpk(P[B_+4], P[B_+5]), b1 = cvtpk(P[B_+6], P[B_+7]);                                             \
        auto r0 = __builtin_amdgcn_permlane32_swap(a0, b0, false, false); auto r1 = __builtin_amdgcn_permlane32_swap(a1, b1, false, false); \
        u32x4 w = {r0[0], r1[0], r0[1], r1[1]}; OUT = *reinterpret_cast<bf16x8*>(&w); } while (0)
    PK4(p0, 0, pa0); PK4(p0, 8, pa1); PK4(p1, 0, pa2); PK4(p1, 8, pa3);
#undef PK4
}
template <int KB>
__device__ __forceinline__ void qkt(f32x16& p0, f32x16& p1, const char* K_lds, int r32, int hi, const bf16x8* qr, const char* qrl) {
    p0 = f32x16{}; p1 = f32x16{};
    const int kb0 = (int)(uintptr_t)K_lds + r32 * KROW + hi * 16;
    const int qb = (int)(uintptr_t)qrl;
    bf16x8 ka[12], kc[12], qq[4];
#define QK_LDR(dst, base, off) asm volatile("ds_read_b128 %0, %1 offset:%2" : "=&v"(dst) : "v"(base), "i"(off) : "memory")
#define QK_RD(d0) do { QK_LDR(ka[d0], kb0, KB * SHM_K + (d0) * 32); QK_LDR(kc[d0], kb0, KB * SHM_K + (d0) * 32 + 32 * KROW); \
        if ((d0) >= 8) QK_LDR(qq[(d0) >= 8 ? (d0) - 8 : 0], qb, ((d0) >= 8 ? (d0) - 8 : 0) * 1024); } while (0)
#define QK_N1(j) ((j) <= 11 ? 2 + ((j) >= 8 ? 1 : 0) : 0)
#define QK_STEP(d0) do { if ((d0) + 3 < 12) QK_RD((d0) + 3 < 12 ? (d0) + 3 : 0); \
        if ((d0) >= 8) asm volatile("s_waitcnt lgkmcnt(%3)" : "+v"(ka[d0]), "+v"(kc[d0]), "+v"(qq[(d0) >= 8 ? (d0) - 8 : 0]) : "i"(QK_N1((d0) + 1) + QK_N1((d0) + 2) + QK_N1((d0) + 3)) : "memory"); \
        else asm volatile("s_waitcnt lgkmcnt(%2)" : "+v"(ka[d0]), "+v"(kc[d0]) : "i"(QK_N1((d0) + 1) + QK_N1((d0) + 2) + QK_N1((d0) + 3)) : "memory"); \
        { const bf16x8 q = (d0) < 8 ? qr[(d0) < 8 ? (d0) : 0] : qq[(d0) >= 8 ? (d0) - 8 : 0]; \
          p0 = __builtin_amdgcn_mfma_f32_32x32x16_bf16(ka[d0], q, p0, 0, 0, 0); p1 = __builtin_amdgcn_mfma_f32_32x32x16_bf16(kc[d0], q, p1, 0, 0, 0); } } while (0)
    QK_RD(0); QK_RD(1); QK_RD(2);
    QK_STEP(0); QK_STEP(1); QK_STEP(2); QK_STEP(3); QK_STEP(4); QK_STEP(5); QK_STEP(6); QK_STEP(7); QK_STEP(8); QK_STEP(9); QK_STEP(10); QK_STEP(11);
#undef QK_STEP
#undef QK_N1
#undef QK_RD
#undef QK_LDR
}
__device__ __forceinline__ void pv_tile(f32x16* o, int vb, bf16x8 pa0, bf16x8 pa1, bf16x8 pa2, bf16x8 pa3) {
#define TRRD(dst, off) asm volatile("ds_read_b64_tr_b16 %0, %1 offset:%2" : "=&v"(dst) : "v"(vb), "i"(off) : "memory")
#define PV_RD(d0, S_) do { constexpr int b_ = v_rd_off(d0, 0, 0); \
        TRRD(S_##l0, b_); TRRD(S_##h0, b_ + 2048); TRRD(S_##l1, b_ + 4096); TRRD(S_##h1, b_ + 6144); TRRD(S_##l2, b_ + 8192); TRRD(S_##h2, b_ + 10240); TRRD(S_##l3, b_ + 12288); TRRD(S_##h3, b_ + 14336); } while (0)
#define PV_MM(d0, S_) do { \
        o[d0] = __builtin_amdgcn_mfma_f32_32x32x16_bf16(pa0, (bf16x8){S_##l0[0], S_##l0[1], S_##l0[2], S_##l0[3], S_##h0[0], S_##h0[1], S_##h0[2], S_##h0[3]}, o[d0], 0, 0, 0);   \
        o[d0] = __builtin_amdgcn_mfma_f32_32x32x16_bf16(pa1, (bf16x8){S_##l1[0], S_##l1[1], S_##l1[2], S_##l1[3], S_##h1[0], S_##h1[1], S_##h1[2], S_##h1[3]}, o[d0], 0, 0, 0);   \
        o[d0] = __builtin_amdgcn_mfma_f32_32x32x16_bf16(pa2, (bf16x8){S_##l2[0], S_##l2[1], S_##l2[2], S_##l2[3], S_##h2[0], S_##h2[1], S_##h2[2], S_##h2[3]}, o[d0], 0, 0, 0);   \
        o[d0] = __builtin_amdgcn_mfma_f32_32x32x16_bf16(pa3, (bf16x8){S_##l3[0], S_##l3[1], S_##l3[2], S_##l3[3], S_##h3[0], S_##h3[1], S_##h3[2], S_##h3[3]}, o[d0], 0, 0, 0); } while (0)
#define PV_WAIT(n, S_) asm volatile("s_waitcnt lgkmcnt(%8)" : "+v"(S_##l0), "+v"(S_##h0), "+v"(S_##l1), "+v"(S_##h1), "+v"(S_##l2), "+v"(S_##h2), "+v"(S_##l3), "+v"(S_##h3) : "i"(n) : "memory")
    s16x4 Al0, Al1, Al2, Al3, Ah0, Ah1, Ah2, Ah3, Bl0, Bl1, Bl2, Bl3, Bh0, Bh1, Bh2, Bh3;
    PV_RD(0, A); PV_RD(1, B); PV_WAIT(8, A); PV_MM(0, A);
    PV_RD(2, A); PV_WAIT(8, B); PV_MM(1, B);
    PV_RD(3, B); PV_WAIT(8, A); PV_MM(2, A);
    PV_WAIT(0, B); PV_MM(3, B);
#undef PV_WAIT
#undef PV_MM
#undef PV_RD
#undef TRRD
}

struct BlockRef { unsigned char* wsb; int tok0, row0, h, P0; };
#define T_QN(R_) ((const bf16_t*)((R_).wsb + WS_QN) + (size_t)(R_).row0 * LDQ + (R_).h * 128)
#define T_QR(R_) ((const bf16_t*)((R_).wsb + WS_QR) + (size_t)(R_).row0 * LDQR + (R_).h * 64)
#define T_KN(R_) ((const bf16_t*)((R_).wsb + WS_KN) + (size_t)(R_).tok0 * LDQ + (R_).h * 128)
#define T_KR(R_) ((const bf16_t*)((R_).wsb + WS_KR) + (size_t)(R_).tok0 * LDKR)
#define T_V(R_)  ((const bf16_t*)((R_).wsb + WS_V) + (size_t)(R_).tok0 * LDQ + (R_).h * 128)
#define T_O(R_)  ((bf16_t*)((R_).wsb + WS_O) + (size_t)(R_).row0 * LDQ + (R_).h * 128)
struct Seam { bf16x8 qr[8]; };
#define VMW() asm volatile("s_waitcnt vmcnt(0)" ::: "memory")
#ifndef ATT_PF
#define ATT_PF 1
#endif
#if ATT_PF
#define DMA_ASM(m0v, voff, OP) asm volatile("s_mov_b32 m0, %0\n\ts_nop 0\n\t" OP " %1, %2" :: "s"(m0v), "v"(voff), "s"(cur.wsb) : "memory", "m0")
#define DMA_TILE(k0, kbf, vslot) do { _Pragma("unroll") for (int i_ = 0; i_ < 4; ++i_) if (i_ < 3 || wid == 0) { \
            const unsigned m0_ = ldsb_ + (unsigned)(K_LDS_OFF + (kbf) * SHM_K + (wid + 8 * i_) * 1024); DMA_ASM(m0_, kdo[i_] + (unsigned)(k0) * kds[i_], "global_load_lds_dwordx4"); } \
        _Pragma("unroll") for (int i_ = 0; i_ < 2; ++i_) { const unsigned m0_ = ldsb_ + (unsigned)((vslot) * SHM_V + (wid * 2 + i_) * 1024); DMA_ASM(m0_, vdo[i_] + (unsigned)(k0) * 4096u, "global_load_lds_dwordx4"); } } while (0)
#define DMA_K(k0, kbf) do { _Pragma("unroll") for (int i_ = 0; i_ < 4; ++i_) if (i_ < 3 || wid == 0) { \
            const unsigned m0_ = ldsb_ + (unsigned)(K_LDS_OFF + (kbf) * SHM_K + (wid + 8 * i_) * 1024); DMA_ASM(m0_, kdo[i_] + (unsigned)(k0) * kds[i_], "global_load_lds_dwordx4"); } } while (0)
#define DMA_V(k0, vslot) do { _Pragma("unroll") for (int i_ = 0; i_ < 2; ++i_) { const unsigned m0_ = ldsb_ + (unsigned)((vslot) * SHM_V + (wid * 2 + i_) * 1024); DMA_ASM(m0_, vdo[i_] + (unsigned)(k0) * 4096u, "global_load_lds_dwordx4"); } } while (0)
#if ATT_PF >= 2
#define PF_TILE(k0) do { const unsigned m0_ = ldsb_ + (unsigned)(PF_LDS_OFF + wid * 256); DMA_ASM(m0_, pfo_ + (unsigned)(k0) * pfs_, "global_load_lds_dword"); } while (0)
#define PFN 1
#else
#define PF_TILE(k0) do { (void)pfo_; (void)pfs_; } while (0)
#define PFN 0
#endif
#define VMW1() asm volatile("s_waitcnt vmcnt(%0)" :: "i"(PFN) : "memory")
#define VMW3() asm volatile("s_waitcnt vmcnt(%0)" :: "i"(2 + PFN) : "memory")
#else
#define DMA_TILE(k0, kbf, vslot) do { _Pragma("unroll") for (int i_ = 0; i_ < 4; ++i_) if (i_ < 3 || wid == 0) \
            __builtin_amdgcn_global_load_lds((const unsigned*)(cur.wsb + (size_t)kdo[i_] + (size_t)(k0) * kds[i_]), (LAS unsigned*)(lds + K_LDS_OFF + (kbf) * SHM_K + (wid + 8 * i_) * 1024), 16, 0, 0); \
        _Pragma("unroll") for (int i_ = 0; i_ < 2; ++i_) \
            __builtin_amdgcn_global_load_lds((const unsigned*)(cur.wsb + (size_t)vdo[i_] + (size_t)(k0) * 4096), (LAS unsigned*)(lds + (vslot) * SHM_V + (wid * 2 + i_) * 1024), 16, 0, 0); } while (0)
#define PF_TILE(k0) do { } while (0)
#define VMW1() do { } while (0)
#define VMW3() do { } while (0)
#endif
#define QLOAD(R_) do { _Pragma("unroll") for (int d0 = 0; d0 < 8; ++d0) S.qr[d0] = load8(T_QN(R_) + (size_t)(wid * QBLK + r32) * LDQ + d0 * 16 + hi * 8); \
                       _Pragma("unroll") for (int d0 = 0; d0 < 4; ++d0) *(bf16x8*)(qrl + d0 * 1024) = load8(T_QR(R_) + (size_t)(wid * QBLK + r32) * LDQR + d0 * 16 + hi * 8); } while (0)

template <bool SWAP>
__device__ __forceinline__ void block_t(const BlockRef& cur, char* lds, int wv) {
    const int tid = opaque_tid(wv), wid = wv, lane = tid & 63, r32 = lane & 31, hi = lane >> 5;
    const int NT = cur.P0 / KVBLK + QB / KVBLK;
    const int qlo = cur.P0 + wid * QBLK, qm = qlo + r32 - 4 * hi;
    char* V_lds = lds; char* K_lds = lds + K_LDS_OFF;
    float* ws = (float*)(lds + WS_LDS_OFF) + wid * 64; float* li_l = ws, * al_l = ws + 32;
    Seam S;
    unsigned kdo[4], kds[4], vdo[2];
#pragma unroll
    for (int i = 0; i < 4; ++i) { const int L = (wid + 8 * i) * 1024 + lane * 16, row = (L / KROW) & 63, pos = L % KROW, c = pos < 384 ? pos >> 4 : 0;
        const bool rope = c >= 16;
        kdo[i] = rope ? (unsigned)(WS_KR + ((size_t)(cur.tok0 + row) * LDKR + (c - 16) * 8) * 2) : (unsigned)(WS_KN + ((size_t)(cur.tok0 + row) * LDQ + cur.h * 128 + c * 8) * 2);
        kds[i] = rope ? (unsigned)(LDKR * 2) : (unsigned)(LDQ * 2); }
#pragma unroll
    for (int i = 0; i < 2; ++i) { const int L = (wid * 2 + i) * 1024 + lane * 16, st = L >> 9, in = L & 511, kk = (st >> 2) * 8 + (in >> 6), k = (kk & ~0xC) | ((kk & 4) << 1) | ((kk & 8) >> 1), col = (st & 3) * 32 + ((in & 63) >> 1);
        vdo[i] = (unsigned)(WS_V + ((size_t)(cur.tok0 + k) * LDQ + cur.h * 128 + col) * 2); }
    const int vb0 = (int)(uintptr_t)V_lds + v_rd_base(lane);
#if ATT_PF
    const unsigned ldsb_ = (unsigned)(uintptr_t)lds;
    unsigned pfo_, pfs_;
    { const int j_ = tid & 127, jr_ = tid & 63;
      if (tid < 256) { pfo_ = (unsigned)((tid < 128 ? WS_KN : WS_V) + ((size_t)(cur.tok0 + (j_ >> 1)) * LDQ + cur.h * 128 + (j_ & 1) * 64) * 2); pfs_ = 4096u; }
      else { pfo_ = (unsigned)(WS_KR + ((size_t)(cur.tok0 + jr_) * LDKR) * 2); pfs_ = (unsigned)(LDKR * 2); } }
#endif
    char* qrl = lds + QR_LDS_OFF + wid * 4096 + lane * 16;
    if (wid >= 4) __builtin_amdgcn_s_setprio(1);
    QLOAD(cur);
    DMA_TILE(0, 0, 0); PF_TILE(64);
    VMW3(); __syncthreads();
    float m_reg = -1e30f, l_reg = 0; f32x16 o[4] = {};
    f32x16 pA0, pA1, pB0, pB1; float mnA, mnB, alA, alB; bf16x8 pa0, pa1, pa2, pa3;
#define RESC(a) do { if (__any((a) < 1.f)) { if (hi == 0) al_l[r32] = (a); asm volatile("s_waitcnt lgkmcnt(0)" ::: "memory");              \
                     for (int d_ = 0; d_ < 4; ++d_) for (int r = 0; r < 16; ++r) o[d_][r] *= al_l[crow(r, hi)]; } } while (0)
#define KBASE(t) ((t) * KVBLK)
#define MASKT(P0_, P1_, t) do { const int kb_ = KBASE(t); if (kb_ + KVBLK - 1 > qlo) { asm volatile("" ::: "memory"); mask_tile(P0_, P1_, qm - kb_); } } while (0)
    int vs_prev = 0, vs_cur = 1, vs_next = 2;
    DMA_TILE(KBASE(1), 1, 1); PF_TILE(KBASE(2 < NT ? 2 : NT - 1));
    qkt<0>(pA0, pA1, K_lds, r32, hi, S.qr, qrl);
    MASKT(pA0, pA1, 0); partialSM(pA0, pA1, m_reg, mnA, alA);
    VMW3(); __syncthreads();
    const int tlast = (qlo + QBLK - 1) / KVBLK;
#define TACT(t) (!ATT_SKIP || (t) <= tlast)
#define HALF_STEP(PX0, PX1, mnX, alX, PY0, PY1, alY, t, KB) do {                                                             \
        if ((t) + 1 < NT) DMA_K(KBASE((t) + 1), (KB) ^ 1);                                                                       \
        if constexpr (SWAP) {           \
            if ((t) + 1 < NT) DMA_V(KBASE((t) + 1), vs_next);                                                                    \
            PF_TILE(KBASE((t) + 2 < NT ? (t) + 2 : NT - 1));                                                                     \
            if (TACT((t) - 1)) { finishSM(PY0, PY1, alY, l_reg, pa0, pa1, pa2, pa3);                                             \
                                 pv_tile(o, vb0 + vs_prev * SHM_V, pa0, pa1, pa2, pa3); }                                        \
            if (TACT(t)) qkt<KB>(PX0, PX1, K_lds, r32, hi, S.qr, qrl);                                                          \
        } else {                                                                                                                 \
            if (TACT(t)) qkt<KB>(PX0, PX1, K_lds, r32, hi, S.qr, qrl);                                                          \
            if ((t) + 1 < NT) DMA_V(KBASE((t) + 1), vs_next);        \
            PF_TILE(KBASE((t) + 2 < NT ? (t) + 2 : NT - 1));                                                                     \
            if (TACT((t) - 1)) { finishSM(PY0, PY1, alY, l_reg, pa0, pa1, pa2, pa3);                                             \
                                 pv_tile(o, vb0 + vs_prev * SHM_V, pa0, pa1, pa2, pa3); }                                        \
        }                                                                                                                        \
        if (TACT(t)) { MASKT(PX0, PX1, (t)); partialSM(PX0, PX1, m_reg, mnX, alX); RESC(alX); }                                  \
        { const int tmp_ = vs_prev; vs_prev = vs_cur; vs_cur = vs_next; vs_next = tmp_; }                                        \
        if ((t) + 1 < NT) VMW3(); else VMW1(); __syncthreads(); } while (0)
    for (int t = 1; t + 1 < NT; t += 2) {
        HALF_STEP(pB0, pB1, mnB, alB, pA0, pA1, alA, t, 1);
        HALF_STEP(pA0, pA1, mnA, alA, pB0, pB1, alB, t + 1, 0);
    }
    HALF_STEP(pB0, pB1, mnB, alB, pA0, pA1, alA, NT - 1, 1);
    if (TACT(NT - 1)) { finishSM(pB0, pB1, alB, l_reg, pa0, pa1, pa2, pa3);
                        pv_tile(o, vb0 + vs_prev * SHM_V, pa0, pa1, pa2, pa3); }
#undef HALF_STEP
#undef TACT
    if (hi == 0) li_l[r32] = l_reg; asm volatile("s_waitcnt lgkmcnt(0)" ::: "memory");
    float rli[16];
#pragma unroll
    for (int r = 0; r < 16; ++r) rli[r] = __builtin_amdgcn_rcpf(li_l[crow(r, hi)]);
    bf16_t* Ow = T_O(cur) + (size_t)(wid * QBLK) * LDQ;
    char* ost = lds + QR_LDS_OFF + wid * 4096;
#pragma unroll
    for (int pass = 0; pass < 2; ++pass) {
#pragma unroll
        for (int r8 = 0; r8 < 8; ++r8) { const int r = pass * 8 + r8, rl = crow(r, hi) - 16 * pass;
#pragma unroll
            for (int d0 = 0; d0 < 4; ++d0) { const float v = o[d0][r] * rli[r]; const float vn = dpp_xor1(v);
                if ((r32 & 1) == 0) *(unsigned*)(ost + rl * 256 + (d0 * 32 + r32) * 2) = cvtpk(v, vn); } }
        asm volatile("s_waitcnt lgkmcnt(0)" ::: "memory");
#pragma unroll
        for (int i = 0; i < 4; ++i) { const int c = lane + 64 * i; const u32x4 w = *(const u32x4*)(ost + c * 16);
            *(u32x4*)(Ow + (size_t)(16 * pass + (c >> 4)) * LDQ + (c & 15) * 8) = w; }
        asm volatile("s_waitcnt lgkmcnt(0)" ::: "memory");
    }
    __builtin_amdgcn_s_setprio(0);
    __syncthreads();
#undef RESC
#undef KBASE
#undef MASKT
}
__device__ __forceinline__ void block(const BlockRef& cur, char* lds, int wv) {
    if (ATT_SWAP == 1 && wv >= 4) block_t<true>(cur, lds, wv); else if (ATT_SWAP == 3 && wv < 4) block_t<true>(cur, lds, wv); else block_t<false>(cur, lds, wv);
}
#undef VMW
#undef QLOAD
#undef DMA_TILE

__device__ __forceinline__ void attn_phase(char* lds, unsigned char* wsb, int vcu, int G, int wv) {
    constexpr int total = 512;
    for (int L = vcu; L < total; L += G) {
        for (int pass = 0; pass < 2; ++pass) {
            const int bh = L >> 3, x = L & 7, b = bh >> 4, h = bh & 15, qb = pass ? 15 - x : x;
            BlockRef cur; cur.wsb = wsb; cur.tok0 = b * 4096; cur.row0 = b * 4096 + qb * QB; cur.h = h; cur.P0 = qb * QB;
            block(cur, lds, wv);
        }
    }
}
#undef T_QN
#undef T_QR
#undef T_KN
#undef T_KR
#undef T_V
#undef T_O
#undef SBAR
}
#ifndef PROBE_REP
#define PROBE_REP 0
#endif
#ifndef EPI_STAGGER
#define EPI_STAGGER 0
#endif
#ifndef IDLE_FILL
#define IDLE_FILL 1
#endif
#ifndef L2PF_FFN1
#define L2PF_FFN1 false
#endif
#ifndef L2PF_FFN2
#define L2PF_FFN2 false
#endif
#ifndef FFN1_SIM
#define FFN1_SIM false
#endif
#ifndef FFN1_SP2
#define FFN1_SP2 true
#endif
#ifndef EPI_ALIGN_RES
#define EPI_ALIGN_RES true
#endif
struct Args { const void* in[25]; float* out; unsigned char* ws; int ph_lo, ph_hi; };
struct Frame {
    LAS unsigned char* lds; volatile LAS unsigned* MISC; gu32* ctl; unsigned char* ws;
    int vcu, G, wv;
    const Args* a;
    float* xw;
    rs_t* rs;
    float* modp;
    float* modv; float* kvmod;
    float* dv; float2* tab;
};
__device__ const double kInvFreqTurns[32] = {
1.59154943091895346e-01, 1.19349370211248862e-01, 8.94994016088910133e-02, 6.71150830052272551e-02, 5.03292121044870353e-02, 3.77415847174197711e-02, 2.83021958306233987e-02, 2.12236527647776604e-02,
1.59154943091895339e-02, 1.19349370211248862e-02, 8.94994016088910237e-03, 6.71150830052272534e-03, 5.03292121044870370e-03, 3.77415847174197719e-03, 2.83021958306233987e-03, 2.12236527647776622e-03,
1.59154943091895356e-03, 1.19349370211248849e-03, 8.94994016088910237e-04, 6.71150830052272599e-04, 5.03292121044870326e-04, 3.77415847174197741e-04, 2.83021958306233954e-04, 2.12236527647776605e-04,
1.59154943091895351e-04, 1.19349370211248862e-04, 8.94994016088910182e-05, 6.71150830052272545e-05, 5.03292121044870354e-05, 3.77415847174197768e-05, 2.83021958306233961e-05, 2.12236527647776592e-05};

__device__ __forceinline__ void tr_item(const float* W, int ldw, int col0, int k0, bf16_t* dst, int ldd, int drow0, const float* kscale, LAS float* scr, int lane) {
#pragma unroll 8
    for (int i = 0; i < 32; ++i) { const int kk = 2 * i + (lane >> 5); const float* wp_ = W + (size_t)(k0 + kk) * ldw + col0 + (lane & 31); float v = NT_LOADS0 ? __builtin_nontemporal_load(wp_) : *wp_; if (kscale) v *= kscale[k0 + kk]; scr[kk * 33 + (lane & 31)] = v; }
    LDS_WAIT(); asm volatile("" ::: "memory");
    const int c = lane & 7;
#pragma unroll
    for (int j = 0; j < 4; ++j) { const int n = (lane >> 3) + 8 * j; const LAS float* s = scr + (8 * c) * 33 + n;
        u32x4 o; o.x = pk2(s[0 * 33], s[1 * 33]); o.y = pk2(s[2 * 33], s[3 * 33]); o.z = pk2(s[4 * 33], s[5 * 33]); o.w = pk2(s[6 * 33], s[7 * 33]);
        *(GAS u32x4*)(dst + (size_t)(drow0 + n) * ldd + k0 + 8 * c) = o; }
    LDS_WAIT(); asm volatile("" ::: "memory");
}
__device__ __forceinline__ void modgemv_item(const float* c, const float* W, int N, const float* bias, float* out  , int n0, int kc, LAS float* scr, int lane) {
    const int kb = kc * 256;
#pragma unroll
    for (int j = 0; j < 16; ++j) { const int e = lane + 64 * j; const int b = e >> 8, kk = e & 255; const float v = c[b * 2048 + kb + kk]; scr[e] = v / (1.f + __expf(-v)); }
    LDS_WAIT(); asm volatile("" ::: "memory");
    f32x4 a0 = {0, 0, 0, 0}, a1 = a0, a2 = a0, a3 = a0;
    const float* wp = W + (size_t)kb * N + n0 + 4 * lane;
#pragma unroll 8
    for (int kk = 0; kk < 256; ++kk) { const f32x4 w = NT_LOADS0 ? __builtin_nontemporal_load((const f32x4*)(wp + (size_t)kk * N)) : *(const f32x4*)(wp + (size_t)kk * N);
        a0 += w * scr[kk]; a1 += w * scr[256 + kk]; a2 += w * scr[512 + kk]; a3 += w * scr[768 + kk]; }
    if (kc == 0) { const f32x4 bb = *(const f32x4*)(bias + n0 + 4 * lane); a0 += bb; a1 += bb; a2 += bb; a3 += bb; }
    float* o = out + n0 + 4 * lane;
    *(f32x4*)o = a0; *(f32x4*)(o + N) = a1; *(f32x4*)(o + 2 * N) = a2; *(f32x4*)(o + 3 * N) = a3;
    LDS_WAIT(); asm volatile("" ::: "memory");
}
__device__ __forceinline__ void ph0_prologue(Frame& F) {
    const int tid = opaque_tid(F.wv), lane = tid & 63, wave = F.wv;
    LAS float* scr = (LAS float*)(F.lds + wave * 16384);
    const int gw = F.vcu * NWAVES + wave, NGW = F.G * NWAVES;
    unsigned char* ws = F.ws;
    constexpr int N_MG = 208 * 8, N_F1 = 32 * 352, N_F2 = 88 * 64, N_PL = 128, N_DKV = 512, N_KR = 64, N_DQ = 512, N_UK = 512, N_UQ = 768, N_WO = 2048, N_Z = 192, N_R = 8192;
    constexpr int NITEMS = N_MG + 4 * N_F1 + 4 * N_F2 + 8 * N_PL + N_DKV + N_KR + 2 * N_DQ + 2 * N_UK + 2 * N_UQ + 2 * N_WO + N_Z + N_R;
    for (int rep0 = 0; rep0 < (PROBE_REP == 7 ? 2 : 1); ++rep0)
    for (int it = gw; it < NITEMS; it += NGW) {
        int r = it;
        if (rep0 == 1 && (r < N_MG || r >= NITEMS - N_R)) continue;
        if (r < N_MG) { const int cb = r >> 3, kc = r & 7;
            if (cb < 192) { const int l = cb / 48, n0 = (cb % 48) * 256; modgemv_item(((const float*)F.a->in[1]), ((const float*)F.a->in[3]) + (size_t)l * 2048 * 12288, 12288, ((const float*)F.a->in[4]) + l * 12288, F.modp + (size_t)kc * MODN + (size_t)l * 4 * 12288, n0, kc, scr, lane); }
            else { const int n0 = (cb - 192) * 256; modgemv_item(((const float*)F.a->in[1]), ((const float*)F.a->in[9]), 4096, ((const float*)F.a->in[10]), F.modp + (size_t)kc * MODN + 4 * 4 * 12288, n0, kc, scr, lane); }
            continue; } r -= N_MG;
        if (r < 4 * N_F1) { const int l = r / N_F1, q = r % N_F1, kb = q / 352, nb = q % 352, tile = nb >> 3, qq = nb & 7;
            const float* src = ((qq >> 2) ? ((const float*)F.a->in[22]) : ((const float*)F.a->in[21])) + (size_t)l * 2048 * 5632;
            tr_item(src, 5632, tile * 128 + (qq & 3) * 32, kb * 64, (bf16_t*)(ws + WS_WFFN1 + l * SZ_WFFN1), 2048, nb * 32, nullptr, scr, lane); continue; } r -= 4 * N_F1;
        if (r < 4 * N_F2) { const int l = r / N_F2, q = r % N_F2, kb = q / 64, nb = q % 64;
            tr_item(((const float*)F.a->in[23]) + (size_t)l * 5632 * 2048, 2048, nb * 32, kb * 64, (bf16_t*)(ws + WS_WFFN2 + l * SZ_WFFN2), 5632, nb * 32, nullptr, scr, lane); continue; } r -= 4 * N_F2;
        if (r < 8 * N_PL) { const int lg = r / N_PL, q = r % N_PL, kb = q / 16, nb = q % 16, l = lg >> 2, g = lg & 3;
            tr_item(((const float*)F.a->in[7]) + (size_t)lg * 512 * 512, 512, nb * 32, kb * 64, (bf16_t*)(ws + WS_WPOOL + l * SZ_WPOOL), 512, g * 512 + nb * 32, nullptr, scr, lane); continue; } r -= 8 * N_PL;
        if (r < N_DKV) { const int kb = r / 16, nb = r % 16; tr_item(((const float*)F.a->in[12]), 512, nb * 32, kb * 64, (bf16_t*)(ws + WS_WD2), 2048, nb * 32, nullptr, scr, lane); continue; } r -= N_DKV;
        if (r < N_KR) { const int kb = r / 2, nb = r % 2; tr_item(((const float*)F.a->in[16]), 64, nb * 32, kb * 64, (bf16_t*)(ws + WS_WD2), 2048, 512 + nb * 128, nullptr, scr, lane); continue; } r -= N_KR;
        if (r < 2 * N_DQ) { const int j = r / N_DQ, q = r % N_DQ, kb = q / 16, nb = q % 16;
            tr_item(((const float*)F.a->in[17]) + (size_t)j * 2048 * 512, 512, nb * 32, kb * 64, (bf16_t*)(ws + (j ? WS_WD3 : WS_WD2)), 2048, (j ? 0 : 768) + nb * 32, nullptr, scr, lane); continue; } r -= 2 * N_DQ;
        if (r < 2 * N_UK) { const int j = r / N_UK, q = r % N_UK, kb = q / 64, nb = q % 64;
            tr_item(j ? ((const float*)F.a->in[15]) : ((const float*)F.a->in[14]), 2048, nb * 32, kb * 64, (bf16_t*)(ws + WS_WU2), 512, j * 2048 + nb * 32, ((const float*)F.a->in[13]), scr, lane); continue; } r -= 2 * N_UK;
        if (r < 2 * N_UQ) { const int j = r / N_UQ, q = r % N_UQ, kb = q / 96, db = q % 96; int col0, drow;
            if (db < 64) { col0 = (db >> 2) * 192 + (db & 3) * 32; drow = db * 32; }
            else { const int e = db - 64, tt = e >> 3, r8 = e & 7, bj = r8 >> 2, wcp = r8 & 3; col0 = (4 * tt + wcp) * 192 + 128 + bj * 32; drow = 2048 + e * 32; }
            tr_item(((const float*)F.a->in[19]) + (size_t)j * 512 * 3072, 3072, col0, kb * 64, (bf16_t*)(ws + (j ? WS_WU3 : WS_WU2)), 512, (j ? 0 : 4096) + drow, ((const float*)F.a->in[18]) + j * 512, scr, lane); continue; } r -= 2 * N_UQ;
        if (r < 2 * N_WO) { const int j = r / N_WO, q = r % N_WO, kb = q / 64, nb = q % 64;
            tr_item(((const float*)F.a->in[20]) + (size_t)j * 2048 * 2048, 2048, nb * 32, kb * 64, (bf16_t*)(ws + WS_WO + j * SZ_WO), 2048, nb * 32, nullptr, scr, lane); continue; } r -= 2 * N_WO;
        if (r < N_Z) { const int row = r < 96 ? 544 + r : 672 + (r - 96); GAS u32x4* p = (GAS u32x4*)((bf16_t*)(ws + WS_WD2) + (size_t)row * 2048);
#pragma unroll
            for (int j = 0; j < 4; ++j) p[lane + 64 * j] = (u32x4){0u, 0u, 0u, 0u};
            continue; } r -= N_Z;
        { const int row = r * 2 + (lane >> 5), i = lane & 31;
          const double t = (double)((const int*)F.a->in[2])[row] * kInvFreqTurns[i]; const double fr = t - __builtin_rint(t);
          const float a = (float)(fr * 6.283185307179586476925);
          F.tab[(size_t)row * 32 + i] = make_float2(cosf(a), sinf(a)); }
    }
}

typedef float f32x2 __attribute__((ext_vector_type(2)));
template <int W, bool XB>
__device__ __forceinline__ void pool_cols(const void* xcv, const unsigned char* xlv, const LAS float* rsl, const f32x2 gm, int tb, int start, bf16_t* dp) {
    f32x2 hp[16], hc[16];
    auto ldx = [&](int pos) -> f32x2 { if constexpr (XB) { const unsigned r = *(const unsigned*)((const bf16_t*)xcv + (size_t)pos * DM); unsigned lo = 0u; if (XBF16 == 2) lo = *(const unsigned short*)(xlv + (size_t)pos * DM); return (f32x2){__builtin_bit_cast(float, (r << 16) | ((lo << 8) & 0xff00u)), __builtin_bit_cast(float, (r & 0xffff0000u) | (lo & 0xff00u))}; } else return *(const f32x2*)((const float*)xcv + (size_t)pos * DM); };
#pragma unroll
    for (int i = 0; i < 16; ++i) hp[i] = (f32x2){0.f, 0.f};
    if (tb > 0) {
#pragma unroll
        for (int i = 0; i < 16; ++i) hp[i] = ldx(tb - 16 + i);
#pragma unroll
        for (int i = 0; i < 16; ++i) hp[i] = hp[i] * (gm * rsl[tb - 16 + i - start]);
    }
    f32x2 S = {0.f, 0.f};
#pragma unroll
    for (int i = 16 - W; i < 16; ++i) S += hp[i];
    for (int ch = 0; ch < 4; ++ch) {
        const int p0 = tb + ch * 16;
#pragma unroll
        for (int i = 0; i < 16; ++i) hc[i] = ldx(p0 + i);
#pragma unroll
        for (int i = 0; i < 16; ++i) hc[i] = hc[i] * (gm * rsl[p0 + i - start]);
#pragma unroll
        for (int i = 0; i < 16; ++i) {
            const int pos = p0 + i;
            S += hc[i]; S -= (i >= W) ? hc[i - W] : hp[16 + i - W];
            const float inv = 1.f / (float)(pos + 1 < W ? pos + 1 : W);
            const f32x2 d = S * inv - hc[i];
            *(GAS unsigned*)(dp + (size_t)pos * DM) = cvt_pk_bf16(d[0], d[1]);
        }
#pragma unroll
        for (int i = 0; i < 16; ++i) hp[i] = hc[i];
    }
}
template <bool XB>
__device__ __forceinline__ void pool_unit(Frame& F, const void* xsrc, const float* gnorm, const float* scale_m  , int unit, bf16_t* Dout) {
    LAS float* rsl = (LAS float*)F.lds;
    const int tid = opaque_tid(F.wv), lane = tid & 63, wave = F.wv;
    const int t0 = unit * 64, b = t0 >> 12, tb = t0 & 4095;
    const int start = tb >= 16 ? tb - 16 : 0, nrows = tb + 64 - start;
    const size_t xboff = (size_t)b * 4096 * DM;
    for (int ri = wave; ri < nrows; ri += 2 * NWAVES) {
        const int r2 = ri + NWAVES < nrows ? ri + NWAVES : ri;
        float sa = 0.f, sb = 0.f;
        if constexpr (XB) {
            const GAS u32x4* xa = (const GAS u32x4*)((const bf16_t*)xsrc + xboff + (size_t)(start + ri) * DM) + lane; const GAS u32x4* xq = (const GAS u32x4*)((const bf16_t*)xsrc + xboff + (size_t)(start + r2) * DM) + lane;
            const GAS u32x2* la = (const GAS u32x2*)(F.ws + WS_XL + xboff + (size_t)(start + ri) * DM) + lane; const GAS u32x2* lq = (const GAS u32x2*)(F.ws + WS_XL + xboff + (size_t)(start + r2) * DM) + lane;
            u32x4 va[4], vb[4]; u32x2 wa[4], wb[4];
#pragma unroll
            for (int j = 0; j < 4; ++j) { va[j] = xa[64 * j]; vb[j] = xq[64 * j]; if (XBF16 == 2) { wa[j] = la[64 * j]; wb[j] = lq[64 * j]; } }
#pragma unroll
            for (int j = 0; j < 4; ++j) { f32x4 a0, a1, b0, b1;
                if (XBF16 == 2) { x8_unpack24(va[j], wa[j], a0, a1); x8_unpack24(vb[j], wb[j], b0, b1); } else { x8_unpack16(va[j], a0, a1); x8_unpack16(vb[j], b0, b1); }
                sa += (a0[0] * a0[0] + a0[1] * a0[1]) + (a0[2] * a0[2] + a0[3] * a0[3]) + (a1[0] * a1[0] + a1[1] * a1[1]) + (a1[2] * a1[2] + a1[3] * a1[3]);
                sb += (b0[0] * b0[0] + b0[1] * b0[1]) + (b0[2] * b0[2] + b0[3] * b0[3]) + (b1[0] * b1[0] + b1[1] * b1[1]) + (b1[2] * b1[2] + b1[3] * b1[3]); }
        } else {
            const GAS f32x4* xa = (const GAS f32x4*)((const float*)xsrc + xboff + (size_t)(start + ri) * DM) + lane; const GAS f32x4* xq = (const GAS f32x4*)((const float*)xsrc + xboff + (size_t)(start + r2) * DM) + lane;
            f32x4 va[8], vb[8];
#pragma unroll
            for (int j = 0; j < 8; ++j) { va[j] = xa[64 * j]; vb[j] = xq[64 * j]; }
#pragma unroll
            for (int j = 0; j < 8; ++j) { sa += (va[j][0] * va[j][0] + va[j][1] * va[j][1]) + (va[j][2] * va[j][2] + va[j][3] * va[j][3]); sb += (vb[j][0] * vb[j][0] + vb[j][1] * vb[j][1]) + (vb[j][2] * vb[j][2] + vb[j][3] * vb[j][3]); }
        }
        sa = wave_sum(sa); sb = wave_sum(sb);
        if (lane == 0) { rsl[ri] = rsqrtf(sa * (1.f / DM) + EPS); rsl[r2] = rsqrtf(sb * (1.f / DM) + EPS); }
    }
    __syncthreads();
    for (int pass = 0; pass < 2; ++pass) {
        const int c = pass * 1024 + 2 * tid, g = pass * 2 + __builtin_amdgcn_readfirstlane(tid >> 8);
        f32x2 gm = *(const f32x2*)(gnorm + c); { const f32x2 sm = *(const f32x2*)(scale_m + (size_t)b * 12288 + c); gm = gm * (sm + 1.f); }
        const void* xc = XB ? (const void*)((const bf16_t*)xsrc + xboff + c) : (const void*)((const float*)xsrc + xboff + c); bf16_t* dp = Dout + (size_t)b * 4096 * DM + c; const unsigned char* xl = F.ws + WS_XL + xboff + c;
        if (g == 0) pool_cols<2, XB>(xc, xl, rsl, gm, tb, start, dp);
        else if (g == 1) pool_cols<4, XB>(xc, xl, rsl, gm, tb, start, dp);
        else if (g == 2) pool_cols<8, XB>(xc, xl, rsl, gm, tb, start, dp);
        else pool_cols<16, XB>(xc, xl, rsl, gm, tb, start, dp);
    }
    __syncthreads();
}
__device__ __forceinline__ void modv_convert_phase(Frame& F) {
    const int tid = opaque_tid(F.wv); const int gt = F.vcu * NWAVES * 64 + tid, NGT = F.G * NWAVES * 64;
    for (int i = gt; i < MODN; i += NGT) { float s = F.modp[i];
#pragma unroll
        for (int kc = 1; kc < 8; ++kc) s += F.modp[(size_t)kc * MODN + i];
        F.modv[i] = s; }
}
__device__ __forceinline__ void bias_rows(const bf16_t* W, int nrows, const float* shift, int sstride, float* out, int ostride, int w0, int nw, int lane) {
    if (w0 >= nrows) return;
    f32x4 sh[4][4][2];
#pragma unroll
    for (int bb = 0; bb < 4; ++bb)
#pragma unroll
        for (int j = 0; j < 4; ++j) { const float* sp = shift + (size_t)bb * sstride + (lane + 64 * j) * 8; sh[bb][j][0] = *(const f32x4*)sp; sh[bb][j][1] = *(const f32x4*)(sp + 4); }
    for (int n = w0; n < nrows; n += nw) {
        const bf16_t* wrow = W + (size_t)n * 2048;
        bf16x8 wv[4];
#pragma unroll
        for (int j = 0; j < 4; ++j) wv[j] = *(const bf16x8*)(wrow + (lane + 64 * j) * 8);
        float a[4] = {0.f, 0.f, 0.f, 0.f};
#pragma unroll
        for (int j = 0; j < 4; ++j)
#pragma unroll
            for (int e = 0; e < 8; ++e) { const float w = bf2f((unsigned short)wv[j][e]);
#pragma unroll
                for (int bb = 0; bb < 4; ++bb) a[bb] += sh[bb][j][e >> 2][e & 3] * w; }
#pragma unroll
        for (int bb = 0; bb < 4; ++bb) a[bb] = wave_sum(a[bb]);
        if (lane == 0) { out[n] = a[0]; out[ostride + n] = a[1]; out[2 * ostride + n] = a[2]; out[3 * ostride + n] = a[3]; }
    }
}
__device__ __forceinline__ void ph1_prologue(Frame& F) {
    for (int u = F.vcu; u < 256; u += F.G) pool_unit<false>(F, ((const float*)F.a->in[0]), ((const float*)F.a->in[5]), F.modv + 2048, u, (bf16_t*)(F.ws + WS_AKV));
    const int tid = opaque_tid(F.wv), lane = tid & 63, wave = F.wv;
    const int gt = F.vcu * NWAVES * 64 + tid, NGT = F.G * NWAVES * 64;
    for (int i = gt; i < 4 * 4 * 2048; i += NGT) { const int col = i & 2047, lb = i >> 11, l = lb >> 2;
        const float* mv = F.modv + (size_t)lb * 12288;
        F.dv[DV_GM + i] = ((const float*)F.a->in[5])[l * 2048 + col] * (1.f + mv[2048 + col]);
        F.dv[DV_GF + i] = ((const float*)F.a->in[6])[l * 2048 + col] * (1.f + mv[8192 + col]);
        F.dv[DV_GATEM + i] = mv[4096 + col] * (l < 2 ? ((const float*)F.a->in[8])[l * 2048 + col] : 1.f);
        F.dv[DV_GATEF + i] = mv[10240 + col];
        if (i < 4 * 2048) F.dv[DV_GKV + i] = ((const float*)F.a->in[11])[col] * (1.f + F.kvmod[(size_t)lb * 4096 + 2048 + col]); }
    const int gw = F.vcu * NWAVES + wave, NGW = F.G * NWAVES;
    for (int l = 0; l < (IDLE_FILL ? 2 : 4); ++l)
        bias_rows((const bf16_t*)(F.ws + WS_WFFN1 + l * SZ_WFFN1), 11264, F.modv + (size_t)l * 4 * 12288 + 6144, 12288, F.dv + DV_BFFN + (size_t)l * 4 * 11264, 11264, gw, NGW, lane);
    bias_rows((const bf16_t*)(F.ws + WS_WD2), 768, F.kvmod, 4096, F.dv + DV_BD2, 1280, gw, NGW, lane);
    bias_rows((const bf16_t*)(F.ws + WS_WD2) + (size_t)768 * 2048, 512, F.modv + (size_t)2 * 4 * 12288, 12288, F.dv + DV_BD2 + 768, 1280, gw, NGW, lane);
    bias_rows((const bf16_t*)(F.ws + WS_WD3), 512, F.modv + (size_t)3 * 4 * 12288, 12288, F.dv + DV_BD3, 512, gw, NGW, lane);
}
__device__ __forceinline__ void final_norm_phase(Frame& F) {
    const int tid = opaque_tid(F.wv), lane = tid & 63, wave = F.wv;
    const int gw = F.vcu * NWAVES + wave, NGW = F.G * NWAVES;
    f32x4 g[8];
#pragma unroll
    for (int j = 0; j < 8; ++j) g[j] = *((const GAS f32x4*)((const float*)F.a->in[24]) + lane + 64 * j);
#if XBF16 == 1
    { u32x2 rn[8];
      if (gw < MROWS) { const GAS u32x2* xb = (const GAS u32x2*)((const bf16_t*)(F.ws + WS_XB) + (size_t)gw * DM) + lane;
#pragma unroll
          for (int j = 0; j < 8; ++j) rn[j] = xb[64 * j]; }
      for (int m = gw; m < MROWS; m += NGW) {
          GAS f32x4* xr = (GAS f32x4*)(F.xw + (size_t)m * DM) + lane; f32x4 v[8]; float s = 0.f;
#pragma unroll
          for (int j = 0; j < 8; ++j) v[j] = (f32x4){__builtin_bit_cast(float, rn[j].x << 16), __builtin_bit_cast(float, rn[j].x & 0xffff0000u), __builtin_bit_cast(float, rn[j].y << 16), __builtin_bit_cast(float, rn[j].y & 0xffff0000u)};
          if (m + NGW < MROWS) { const GAS u32x2* xb = (const GAS u32x2*)((const bf16_t*)(F.ws + WS_XB) + (size_t)(m + NGW) * DM) + lane;
#pragma unroll
              for (int j = 0; j < 8; ++j) rn[j] = xb[64 * j]; }
#pragma unroll
          for (int j = 0; j < 8; ++j) s += (v[j][0] * v[j][0] + v[j][1] * v[j][1]) + (v[j][2] * v[j][2] + v[j][3] * v[j][3]);
          const float rstd = rsqrtf(wave_sum(s) * (1.f / DM) + EPS);
#pragma unroll
          for (int j = 0; j < 8; ++j) xr[64 * j] = v[j] * rstd * g[j];
      } }
    return;
#endif
    for (int m = gw; m < MROWS; m += NGW) {
        GAS f32x4* xr = (GAS f32x4*)(F.xw + (size_t)m * DM) + lane; f32x4 v[8]; float s = 0.f;
#if XBF16
        const GAS u32x2* xb = (const GAS u32x2*)((const bf16_t*)(F.ws + WS_XB) + (size_t)m * DM) + lane;
        const GAS unsigned* xlw = (const GAS unsigned*)(F.ws + WS_XL + (size_t)m * DM) + lane;
#pragma unroll
        for (int j = 0; j < 8; ++j) { const u32x2 r = xb[64 * j]; unsigned lo = 0u; if (XBF16 == 2) lo = xlw[64 * j];
            v[j] = (f32x4){__builtin_bit_cast(float, (r.x << 16) | ((lo << 8) & 0xff00u)), __builtin_bit_cast(float, (r.x & 0xffff0000u) | (lo & 0xff00u)),
                           __builtin_bit_cast(float, (r.y << 16) | ((lo >> 8) & 0xff00u)), __builtin_bit_cast(float, (r.y & 0xffff0000u) | ((lo >> 16) & 0xff00u))}; }
#else
#pragma unroll
        for (int j = 0; j < 8; ++j) v[j] = xr[64 * j];
#endif
#pragma unroll
        for (int j = 0; j < 8; ++j) s += (v[j][0] * v[j][0] + v[j][1] * v[j][1]) + (v[j][2] * v[j][2] + v[j][3] * v[j][3]);
        const float rstd = rsqrtf(wave_sum(s) * (1.f / DM) + EPS);
#pragma unroll
        for (int j = 0; j < 8; ++j) xr[64 * j] = v[j] * rstd * g[j];
    }
}

constexpr int NPHASES = 28;
__global__ void __launch_bounds__(NWAVES * 64, 2) fwd_kernel(Args args) {
    extern __shared__ __attribute__((aligned(16))) unsigned char lds_raw[];
    Frame F;
    F.lds = (LAS unsigned char*)lds_raw; F.MISC = (volatile LAS unsigned*)(F.lds + MISC_OFF);
    F.G = gridDim.x; { const int bx = blockIdx.x; F.vcu = (F.G % 8 == 0) ? (bx % 8) * (F.G / 8) + bx / 8 : bx; }
    unsigned char* const ws0_ = args.ws; float* const xw0_ = args.out;
    F.a = &args;
#define FRAME_PTRS(w_) do { F.ws = (w_); F.ctl = (gu32*)((w_) + WS_CTL); F.rs = (rs_t*)((float*)((w_) + WS_CTL) + CW_RS); F.modp = (float*)((w_) + WS_MODP); F.modv = (float*)((w_) + WS_CTL) + CW_MODV; F.kvmod = (float*)((w_) + WS_CTL) + CW_KVMOD; \
        F.dv = (float*)((w_) + WS_DV); F.tab = (float2*)((w_) + WS_TAB); } while (0)
    FRAME_PTRS(ws0_); F.xw = xw0_;
    if (threadIdx.x < 64) F.MISC[threadIdx.x] = 0u;
    __syncthreads();
    F.wv = __builtin_amdgcn_readfirstlane((int)threadIdx.x >> 6);
    XcdBarrier bar = xcd_barrier_post((unsigned*)(F.ctl + CW_BAR), F.MISC, threadIdx.x == 0);
#if MODE == 2
    constexpr int lo = 0, hi = NPHASES;
#else
    const int lo = args.ph_lo, hi = args.ph_hi;
#endif
    bool need_bar = false;
#define REPK(kind) for (int rep_ = 0; rep_ < ((PROBE_REP == (kind)) ? 2 : 1); ++rep_)
#define PH_BEGIN(p) if (lo <= (p) && (p) < hi) { if (need_bar) { XcdBarrier b_ = bar; asm volatile("" : "+s"(b_.bar), "+s"(b_.x)); { const bool t0_ = (F.wv == 0) && (opaque_lane() == 0); xcd_barrier(b_, t0_); if (PROBE_REP == 15) xcd_barrier(b_, t0_); } } need_bar = true; \
        unsigned char* ws = ws0_; float* xw_ = xw0_; asm volatile("" : "+s"(ws), "+s"(xw_)); FRAME_PTRS(ws); F.xw = xw_;
#define PH_END }
#define AQ ((bf16_t*)(ws + WS_AQ))
#define AKV ((bf16_t*)(ws + WS_AKV))
#define ACT ((bf16_t*)(ws + WS_ACT))
#define KN ((bf16_t*)(ws + WS_KN))
#define VV ((bf16_t*)(ws + WS_V))
#define KR ((bf16_t*)(ws + WS_KR))
#define CKV ((bf16_t*)(ws + WS_CKV))
#define CQ ((bf16_t*)(ws + WS_CQ))
#define QN ((bf16_t*)(ws + WS_QN))
#define QR ((bf16_t*)(ws + WS_QR))
#define OO ((bf16_t*)(ws + WS_O))

    #ifndef SK0
    PH_BEGIN(0) ph0_prologue(F); PH_END
#endif
    #ifndef SK1
    PH_BEGIN(27) modv_convert_phase(F); PH_END
    PH_BEGIN(1) REPK(8) ph1_prologue(F); PH_END
#endif
    for (int l = 0; l < 4; ++l) {
        const int base = 2 + 6 * l;
        if (l == 1) {
            PH_BEGIN(base) REPK(9) for (int u = F.vcu; u < 256; u += F.G) pool_unit<XBF16 != 0>(F, XBF16 ? (const void*)(ws + WS_XB) : (const void*)F.xw, ((const float*)F.a->in[5]) + 2048, F.modv + (size_t)4 * 12288 + 2048, u, AKV); PH_END
        }
        if (l >= 2) {
#ifndef SKD
            PH_BEGIN(base) {
                const bool first = (l == 2);
                pg8::Gemm g{first ? AKV : AQ, AQ, first ? 3 : 0, 2048, 0, (const bf16_t*)(ws + (first ? WS_WD2 : WS_WD3)), 2048, 2048, 64, first ? 5 : 2};
                pg8::StaticOrder S; S.init(g.nM, g.nN, F.G, (int)blockIdx.x);
                pg8::EpiDown E{F.rs + (first ? RS_M2 : RS_M3) * 16384, F.dv + (first ? DV_BD2 : DV_BD3), first ? 1280 : 512, first ? 3 : 0, ws, F.rs, first ? RS_Q2 : RS_Q3, F.tab};
                pg8::gemm_phase<pg8::EpiDown>(F.lds, g, S, E, F.wv);
                if (IDLE_FILL) {
                    const int c_ = (int)blockIdx.x, c0_ = (g.nM * g.nN) % F.G;
                    if (c0_ > 0 && c_ >= c0_) { const int lane_ = opaque_lane();
                        bias_rows((const bf16_t*)(ws + WS_WFFN1 + l * SZ_WFFN1), 11264, F.modv + (size_t)l * 4 * 12288 + 6144, 12288, F.dv + DV_BFFN + (size_t)l * 4 * 11264, 11264,
                                  (c_ - c0_) * NWAVES + F.wv, (F.G - c0_) * NWAVES, lane_); }
                }
            } PH_END
#endif
#ifndef SKU
            PH_BEGIN(base + 1) {
                const bool first = (l == 2);
                pg8::Gemm g{first ? CKV : CQ, CQ, first ? 16 : 0, 512, 0, (const bf16_t*)(ws + (first ? WS_WU2 : WS_WU3)), 512, 512, 64, first ? 28 : 12};
                pg8::StaticOrder S; S.init(g.nM, g.nN, F.G, (int)blockIdx.x);
                pg8::EpiUp E{ws, F.rs, first ? RS_Q2 : RS_Q3, first ? 16 : 0, F.tab};
                REPK(5) pg8::gemm_phase<pg8::EpiUp>(F.lds, g, S, E, F.wv);
            } PH_END
#endif
#ifndef SKA
            PH_BEGIN(base + 2) {
                REPK(3) att::attn_phase((char*)lds_raw, ws, F.vcu, F.G, F.wv);
            } PH_END
#endif
        }
#ifndef SKM
        PH_BEGIN(base + 3) {
            const bool pool = l < 2;
            pg8::Gemm g{pool ? AKV : OO, pool ? AKV : OO, 0, 2048, pool ? 1 : 0, (const bf16_t*)(ws + (pool ? WS_WPOOL + l * SZ_WPOOL : WS_WO + (l - 2) * SZ_WO)), pool ? 512 : 2048, pool ? 512 : 2048, 64, 8};
            pg8::StaticOrder S; S.init(g.nM, g.nN, F.G, (int)blockIdx.x, 4);
            pg8::EpiRes E{l == 0 ? ((const float*)F.a->in[0]) : (XBF16 ? nullptr : F.xw), (const bf16_t*)(ws + WS_XB), XBF16 ? nullptr : F.xw, (bf16_t*)(ws + WS_XB), ws + WS_XL, F.dv + DV_GATEM + l * 4 * 2048, F.dv + DV_GF + l * 4 * 2048, AQ, nullptr, nullptr, F.rs + (RS_F0 + l) * 16384, (unsigned)(size_t)(F.lds + 131072)};
            if (PROBE_REP == 4) { pg8::EpiRes E2 = E; E2.xout32 = (float*)(ws + WS_FAST_END); E2.rowss = nullptr; E2.a0 = (bf16_t*)(ws + WS_FAST_END + (size_t)MROWS * DM * 4); pg8::gemm_phase<pg8::EpiRes, EPI_ALIGN_RES>(F.lds, g, S, E2, F.wv); }
            if (EPI_STAGGER && ([&]{ pg8::Unit u0_; return S.next(0, u0_) && (u0_.pm & 1); })()) { for (int i_ = 0; i_ < EPI_STAGGER; ++i_) __builtin_amdgcn_s_sleep(127); }
            pg8::gemm_phase<pg8::EpiRes, EPI_ALIGN_RES>(F.lds, g, S, E, F.wv);
        } PH_END
#endif
#ifndef SKF1
        PH_BEGIN(base + 4) {
            pg8::Gemm g{AQ, AQ, 0, 2048, 0, (const bf16_t*)(ws + WS_WFFN1 + l * SZ_WFFN1), 2048, 2048, 64, 44};
            pg8::StaticOrder S; S.init(g.nM, g.nN, F.G, (int)blockIdx.x);
            pg8::EpiSwi E{F.rs + (RS_F0 + l) * 16384, F.dv + DV_BFFN + (size_t)l * 4 * 11264, ACT};
            REPK(1) pg8::gemm_phase<pg8::EpiSwi, true, FFN1_SP2, FFN1_SIM, L2PF_FFN1>(F.lds, g, S, E, F.wv);
        } PH_END
#endif
#ifndef SKF2
        PH_BEGIN(base + 5) {
            pg8::Gemm g{ACT, ACT, 0, 5632, 0, (const bf16_t*)(ws + WS_WFFN2 + l * SZ_WFFN2), 5632, 5632, 64, 8};
            pg8::StaticOrder S; S.init(g.nM, g.nN, F.G, (int)blockIdx.x, 4);
            const bool hasA = (l == 1 || l == 2);
            pg8::EpiRes E{XBF16 ? nullptr : F.xw, (const bf16_t*)(ws + WS_XB), XBF16 ? nullptr : F.xw, (bf16_t*)(ws + WS_XB), ws + WS_XL, F.dv + DV_GATEF + l * 4 * 2048, hasA ? F.dv + DV_GM + (l + 1) * 4 * 2048 : nullptr, hasA ? AQ : nullptr,
                          l == 1 ? F.dv + DV_GKV : nullptr, l == 1 ? AKV : nullptr, hasA ? F.rs + (l == 1 ? RS_M2 : RS_M3) * 16384 : nullptr, (unsigned)(size_t)(F.lds + 131072)};
            if (PROBE_REP == 10) { pg8::EpiNull E0{(float*)(ws + WS_FAST_END)}; pg8::gemm_phase<pg8::EpiNull, true>(F.lds, g, S, E0, F.wv); }
            if (PROBE_REP == 14) { pg8::EpiNull E0{(float*)(ws + WS_FAST_END)}; pg8::Gemm g2 = g; g2.grouped = 2; pg8::gemm_phase<pg8::EpiNull, true>(F.lds, g2, S, E0, F.wv); }
            if (PROBE_REP == 2) { pg8::EpiRes E2 = E; E2.xout32 = (float*)(ws + WS_FAST_END); E2.rowss = nullptr; pg8::gemm_phase<pg8::EpiRes, EPI_ALIGN_RES>(F.lds, g, S, E2, F.wv); }
            if (EPI_STAGGER && ([&]{ pg8::Unit u0_; return S.next(0, u0_) && (u0_.pm & 1); })()) { for (int i_ = 0; i_ < EPI_STAGGER; ++i_) __builtin_amdgcn_s_sleep(127); }
            pg8::gemm_phase<pg8::EpiRes, EPI_ALIGN_RES, true, false, L2PF_FFN2>(F.lds, g, S, E, F.wv);
        } PH_END
#endif
    }
    PH_BEGIN(26) REPK(12) final_norm_phase(F); PH_END
#undef PH_BEGIN
#undef PH_END
#undef FRAME_PTRS
#undef AQ
#undef AKV
#undef ACT
#undef KN
#undef VV
#undef KR
#undef CKV
#undef CQ
#undef QN
#undef QR
#undef OO
}
#if MODE >= 2
extern "C" void kernel_launch(void* const* d_in, const int* in_sizes, int n_in, void* d_out, int out_size, void* d_ws, size_t ws_size, hipStream_t stream) {
    static int grid = 0;
    if (grid == 0) {
        if (n_in != 25 || out_size != MROWS * DM || ws_size < WS_NEED) { fprintf(stderr, "kernel_launch: unexpected shapes / workspace (%d inputs, out %d, ws %zu < %zu)\n", n_in, out_size, ws_size, (size_t)WS_FAST_END); grid = -1; return; }
        int dev = 0, cus = 0, per_cu = 0;
        if (hipGetDevice(&dev) != hipSuccess || hipDeviceGetAttribute(&cus, hipDeviceAttributeMultiprocessorCount, dev) != hipSuccess) { grid = -1; return; }
        if (hipFuncSetAttribute((const void*)fwd_kernel, hipFuncAttributeMaxDynamicSharedMemorySize, LDS_BYTES) != hipSuccess) { fprintf(stderr, "kernel_launch: hipFuncSetAttribute failed\n"); grid = -1; return; }
        if (hipOccupancyMaxActiveBlocksPerMultiprocessor(&per_cu, (const void*)fwd_kernel, NWAVES * 64, LDS_BYTES) != hipSuccess || per_cu < 1) { fprintf(stderr, "kernel_launch: occupancy query says %d\n", per_cu); }
        (void)hipGetLastError();
        grid = cus;
    }
    if (grid < 0) return;
    (void)hipMemsetAsync((char*)d_ws + WS_CTL, 0, CTL_ZERO_BYTES, stream);
    Args a{};
    for (int i = 0; i < 25; ++i) a.in[i] = d_in[i];
    a.out = (float*)d_out; a.ws = (unsigned char*)d_ws;
#if MODE == 2
    a.ph_lo = 0; a.ph_hi = NPHASES;
    hipLaunchKernelGGL(fwd_kernel, dim3(grid), dim3(NWAVES * 64), LDS_BYTES, stream, a);
#else
    for (int p = 0; p < NPHASES; ++p) {
        const int k = p < 2 ? -1 : (p - 2) % 6, l = p < 2 ? -1 : (p - 2) / 6;
        if (p >= 2 && p < 26) { if (k == 0 && l == 0) continue; if ((k == 1 || k == 2) && l < 2) continue; }
        a.ph_lo = p; a.ph_hi = p + 1;
        hipLaunchKernelGGL(fwd_kernel, dim3(grid), dim3(NWAVES * 64), LDS_BYTES, stream, a);
    }
#endif
}
#endif
```

```cpp
#include <hip/hip_runtime.h>
#include <cstdio>
#include <cstdint>
#ifndef MODE
#define MODE 2
#define PROBE_REP 0
#endif
#define GAS __attribute__((address_space(1)))
#define LAS __attribute__((address_space(3)))
typedef unsigned short bf16_t;
typedef short bf16x8 __attribute__((ext_vector_type(8)));
typedef short s16x4 __attribute__((ext_vector_type(4)));
typedef float f32x4 __attribute__((ext_vector_type(4)));
typedef float f32x16 __attribute__((ext_vector_type(16)));
typedef unsigned u32x4 __attribute__((ext_vector_type(4)));
typedef unsigned u32x2 __attribute__((ext_vector_type(2)));
typedef GAS unsigned gu32;

#ifndef NT_LOADS0
#define NT_LOADS0 0
#endif
#ifndef NT_STORES
#define NT_STORES 0
#endif
#ifndef XBF16
#define XBF16 1
#endif
constexpr int NWAVES = 8;
constexpr int BATCH = 4, SEQ = 4096, DM = 2048, MROWS = BATCH * SEQ, FF = 5632, NH = 16;
constexpr float EPS = 1e-6f;
constexpr size_t MiB = 1u << 20;

constexpr size_t WS_CTL = 0, CTL_ZERO_BYTES = 2 * MiB;
constexpr int CW_TMO = 0;
constexpr int CW_BAR = 4096;
constexpr int CW_RS = 16384;
constexpr int RS_F0 = 0, RS_M2 = 4, RS_M3 = 5, RS_KV = 6, RS_Q2 = 7, RS_Q3 = 8;
constexpr int CW_MODV = CW_RS + 2 * 12 * 16384;
constexpr int CW_KVMOD = CW_MODV + 4 * 4 * 12288;
constexpr int CW_END = CW_KVMOD + 4 * 4096;
static_assert((size_t)CW_MODV * 4 <= CTL_ZERO_BYTES && (size_t)CW_END * 4 <= 4 * MiB, "CTL region: the barrier words and the row-sum accumulators are zeroed per call; the mod vectors behind them are fully written before they are read");
constexpr size_t WS_DV = 4 * MiB;
constexpr int DV_GM = 0;
constexpr int DV_GF = DV_GM + 4 * 4 * 2048;
constexpr int DV_GKV = DV_GF + 4 * 4 * 2048;
constexpr int DV_GATEM = DV_GKV + 4 * 2048;
constexpr int DV_GATEF = DV_GATEM + 4 * 4 * 2048;
constexpr int DV_BFFN = DV_GATEF + 4 * 4 * 2048;
constexpr int DV_BD2 = DV_BFFN + 4 * 4 * 11264;
constexpr int DV_BD3 = DV_BD2 + 4 * 1280;
constexpr int DV_END = DV_BD3 + 4 * 512;
static_assert((size_t)DV_END * 4 <= 2 * MiB, "DV region");
constexpr size_t WS_TAB = 6 * MiB;
constexpr size_t WS_WFFN1 = 10 * MiB;
constexpr size_t SZ_WFFN1 = (size_t)11264 * 2048 * 2;
constexpr size_t WS_WFFN2 = WS_WFFN1 + 4 * SZ_WFFN1;
constexpr size_t SZ_WFFN2 = (size_t)2048 * 5632 * 2;
constexpr size_t WS_WPOOL = WS_WFFN2 + 4 * SZ_WFFN2;
constexpr size_t SZ_WPOOL = (size_t)2048 * 512 * 2;
constexpr size_t WS_WD2 = WS_WPOOL + 2 * SZ_WPOOL;
constexpr size_t WS_WD3 = WS_WD2 + (size_t)1280 * 2048 * 2;
constexpr size_t WS_WU2 = WS_WD3 + (size_t)512 * 2048 * 2;
constexpr size_t WS_WU3 = WS_WU2 + (size_t)7168 * 512 * 2;
constexpr size_t WS_WO = WS_WU3 + (size_t)3072 * 512 * 2;
constexpr size_t SZ_WO = (size_t)2048 * 2048 * 2;
constexpr size_t WS_WEND = WS_WO + 2 * SZ_WO;
constexpr size_t SZ_MD = (size_t)MROWS * DM * 2;
constexpr size_t WS_AQ = (WS_WEND + MiB - 1) / MiB * MiB;
constexpr size_t WS_AKV = WS_AQ + SZ_MD;
constexpr size_t WS_KN = WS_AKV + SZ_MD;
constexpr size_t WS_V = WS_KN + SZ_MD;
constexpr size_t WS_KR = WS_V + SZ_MD;
constexpr size_t WS_CKV = WS_KR + (size_t)MROWS * 64 * 2;
constexpr size_t WS_CQ = WS_CKV + (size_t)MROWS * 512 * 2;
constexpr size_t WS_ACT = WS_CQ + (size_t)MROWS * 512 * 2;
constexpr size_t WS_QN = WS_ACT, WS_QR = WS_QN + SZ_MD, WS_O = WS_QR + (size_t)MROWS * 1024 * 2;
constexpr size_t WS_XB = WS_ACT + (size_t)MROWS * FF * 2;
constexpr size_t WS_XL = WS_XB + SZ_MD;
constexpr size_t WS_FAST_END = WS_XL + SZ_MD / 2;
constexpr int MODN = 4 * 4 * 12288 + 4 * 4096;
constexpr size_t WS_MODP = WS_FAST_END;
constexpr size_t WS_NEED = WS_MODP + (size_t)8 * MODN * 4;
static_assert(WS_O + SZ_MD <= WS_XB, "attention overlays inside act");

constexpr int RING_BYTES = 131072;
constexpr int LDS_BYTES = 147456;
constexpr int MISC_OFF = LDS_BYTES - 256;

#define RLX_AGENT __ATOMIC_RELAXED, __HIP_MEMORY_SCOPE_AGENT
#define LDS_WAIT() asm volatile("s_waitcnt lgkmcnt(0)" ::: "memory")
#define VM_WAIT() asm volatile("s_waitcnt vmcnt(0)" ::: "memory")
__device__ __forceinline__ unsigned f2bf(float f) { unsigned u = __builtin_bit_cast(unsigned, f); return (u + 0x7fffu + ((u >> 16) & 1u)) >> 16; }
__device__ __forceinline__ unsigned pk2(float lo, float hi) { return f2bf(lo) | (f2bf(hi) << 16); }
__device__ __forceinline__ float bf2f(unsigned short b) { return __builtin_bit_cast(float, (unsigned)b << 16); }
__device__ __forceinline__ unsigned cvt_pk_bf16(float lo, float hi) { unsigned r; asm volatile("v_cvt_pk_bf16_f32 %0, %1, %2" : "=v"(r) : "v"(lo), "v"(hi)); return r; }
__device__ __forceinline__ int opaque_lane() { int l; asm volatile("v_mbcnt_lo_u32_b32 %0, -1, 0\n\tv_mbcnt_hi_u32_b32 %0, -1, %0" : "=v"(l)); return l; }
typedef unsigned long long rs_t;
constexpr float RS_SCALE = 1048576.f, RS_INV = 1.f / 1048576.f, MA_SCALE = 4294967296.f, MA_INV = 1.f / 4294967296.f;
__device__ __forceinline__ void rs_add(rs_t* p, float s) { (void)__hip_atomic_fetch_add((GAS rs_t*)p, (rs_t)(long long)(s * RS_SCALE), __ATOMIC_RELAXED, __HIP_MEMORY_SCOPE_AGENT); }
__device__ __forceinline__ float rs_get(const rs_t* p) { return (float)(long long)*(const GAS rs_t*)p * RS_INV; }
__device__ __forceinline__ int opaque_tid(int wv) { return wv * 64 + opaque_lane(); }
__device__ __forceinline__ void x8_unpack16(const u32x4 h, f32x4& a, f32x4& b) {
    a = (f32x4){__builtin_bit_cast(float, h.x << 16), __builtin_bit_cast(float, h.x & 0xffff0000u), __builtin_bit_cast(float, h.y << 16), __builtin_bit_cast(float, h.y & 0xffff0000u)};
    b = (f32x4){__builtin_bit_cast(float, h.z << 16), __builtin_bit_cast(float, h.z & 0xffff0000u), __builtin_bit_cast(float, h.w << 16), __builtin_bit_cast(float, h.w & 0xffff0000u)}; }
__device__ __forceinline__ void x8_unpack24(const u32x4 h, const u32x2 l, f32x4& a, f32x4& b) {
    a = (f32x4){__builtin_bit_cast(float, (h.x << 16) | ((l.x << 8) & 0xff00u)), __builtin_bit_cast(float, (h.x & 0xffff0000u) | (l.x & 0xff00u)),
                __builtin_bit_cast(float, (h.y << 16) | ((l.x >> 8) & 0xff00u)), __builtin_bit_cast(float, (h.y & 0xffff0000u) | ((l.x >> 16) & 0xff00u))};
    b = (f32x4){__builtin_bit_cast(float, (h.z << 16) | ((l.y << 8) & 0xff00u)), __builtin_bit_cast(float, (h.z & 0xffff0000u) | (l.y & 0xff00u)),
                __builtin_bit_cast(float, (h.w << 16) | ((l.y >> 8) & 0xff00u)), __builtin_bit_cast(float, (h.w & 0xffff0000u) | ((l.y >> 16) & 0xff00u))}; }
__device__ __forceinline__ void x8_pack24(const f32x4 a, const f32x4 b, u32x4& h, u32x2& l) {
    unsigned t[8];
#pragma unroll
    for (int i = 0; i < 4; ++i) { const float fa = a[i], fb = b[i];
        t[i] = (__builtin_bit_cast(unsigned, fa) + 0x80u) >> 8; t[4 + i] = (__builtin_bit_cast(unsigned, fb) + 0x80u) >> 8; }
    h.x = (t[0] >> 8) | ((t[1] << 8) & 0xffff0000u); h.y = (t[2] >> 8) | ((t[3] << 8) & 0xffff0000u); h.z = (t[4] >> 8) | ((t[5] << 8) & 0xffff0000u); h.w = (t[6] >> 8) | ((t[7] << 8) & 0xffff0000u);
    l.x = (t[0] & 0xffu) | ((t[1] & 0xffu) << 8) | ((t[2] & 0xffu) << 16) | (t[3] << 24); l.y = (t[4] & 0xffu) | ((t[5] & 0xffu) << 8) | ((t[6] & 0xffu) << 16) | (t[7] << 24); }
template <class T> __device__ __forceinline__ void st_stream(T* p, const T& v) { if (NT_STORES) __builtin_nontemporal_store(v, p); else *p = v; }
__device__ __forceinline__ float dpp_xor1(float v) { return __builtin_bit_cast(float, __builtin_amdgcn_mov_dpp(__builtin_bit_cast(int, v), 0xB1, 0xF, 0xF, true)); }
__device__ __forceinline__ float dpp_xor2(float v) { return __builtin_bit_cast(float, __builtin_amdgcn_mov_dpp(__builtin_bit_cast(int, v), 0x4E, 0xF, 0xF, true)); }
__device__ __forceinline__ float dpp_hmirror(float v) { return __builtin_bit_cast(float, __builtin_amdgcn_mov_dpp(__builtin_bit_cast(int, v), 0x141, 0xF, 0xF, true)); }
__device__ __forceinline__ float dpp_mirror(float v) { return __builtin_bit_cast(float, __builtin_amdgcn_mov_dpp(__builtin_bit_cast(int, v), 0x140, 0xF, 0xF, true)); }
__device__ __forceinline__ float swz_xor16(float v) { return __builtin_bit_cast(float, __builtin_amdgcn_ds_swizzle(__builtin_bit_cast(int, v), 0x401F)); }
__device__ __forceinline__ float add_xor32(float v) {
    auto rr = __builtin_amdgcn_permlane32_swap(__builtin_bit_cast(unsigned, v), __builtin_bit_cast(unsigned, v), false, false);
    const unsigned a = rr[0], b = rr[1];
    return __builtin_bit_cast(float, a) + __builtin_bit_cast(float, b); }
__device__ __forceinline__ float wave_sum(float v) {
    v += dpp_xor1(v); v += dpp_xor2(v); v += dpp_hmirror(v); v += dpp_mirror(v); v += swz_xor16(v); return add_xor32(v);
}

#define XB_TMO      128
#define XB_XCNT(j)  (256  + 64 * (j))
#define XB_XSUB(j)  (1280 + 64 * (j))
#define XB_XGEN(j)  (2304 + 64 * (j))
#define XB_TOP      3328
#define XB_TOPGEN   3392
#define XCD_BAR_WORDS 3456
#define XB_SPIN_CAP (1u << 18)
__device__ __forceinline__ unsigned xb_ld(unsigned* p)              { return __hip_atomic_load(p, __ATOMIC_RELAXED, __HIP_MEMORY_SCOPE_AGENT); }
__device__ __forceinline__ unsigned xb_add(unsigned* p, unsigned v) { return __hip_atomic_fetch_add(p, v, __ATOMIC_RELAXED, __HIP_MEMORY_SCOPE_AGENT); }
__device__ __forceinline__ unsigned xb_xcc_id() { return (unsigned)__builtin_amdgcn_s_getreg((3 << 11) | 20) & 0xFu; }
#define XB_SPIN(cond, bar) do { unsigned _sp = 0; while (cond) { __builtin_amdgcn_s_sleep(1); \
    if ((++_sp & 255u) == 0u) { if (xb_ld(&(bar)[XB_TMO])) break; if (_sp > XB_SPIN_CAP) { atomicAdd(&(bar)[XB_TMO], 1u); break; } } } } while (0)
struct XcdBarrier { unsigned* bar; unsigned x; volatile LAS unsigned* st; };
__device__ __forceinline__ XcdBarrier xcd_barrier_post(unsigned* bar, volatile LAS unsigned* st, bool t0  ) {
    XcdBarrier b; b.bar = bar; b.x = xb_xcc_id(); b.st = st;
    if (t0) (void)xb_add(&bar[XB_XCNT(b.x)], 1u);
    return b;
}
__device__ __forceinline__ void xcd_barrier_complete(unsigned* bar, unsigned x, unsigned& nloc, unsigned& nx) {
    const unsigned G = gridDim.x * gridDim.y * gridDim.z;
    unsigned sum, cnt, mine, sp = 0u;
    for (;;) {
        sum = 0u; cnt = 0u; mine = 0u;
#pragma unroll
        for (unsigned j = 0; j < 16; ++j) { const unsigned c = xb_ld(&bar[XB_XCNT(j)]); sum += c; cnt += (c > 0u) ? 1u : 0u; mine = (j == x) ? c : mine; }
        if (sum == G) break;
        __builtin_amdgcn_s_sleep(1);
        if ((++sp & 255u) == 0u) { if (xb_ld(&bar[XB_TMO])) break; if (sp > XB_SPIN_CAP) { atomicAdd(&bar[XB_TMO], 1u); break; } }
    }
    nloc = mine > 0u ? mine : 1u; nx = cnt > 0u ? cnt : 1u;
}
__device__ __forceinline__ void xcd_barrier(const XcdBarrier& b, bool t0  ) {
    asm volatile("s_waitcnt vmcnt(0)" ::: "memory");
    __syncthreads();
    if (t0) {
        unsigned* bar = b.bar;
        __builtin_amdgcn_s_waitcnt(0);
        unsigned nloc = b.st[0], nx = b.st[1];
        if (nloc == 0u) { xcd_barrier_complete(bar, b.x, nloc, nx); b.st[0] = nloc; b.st[1] = nx; }
        const unsigned old = xb_add(&bar[XB_XSUB(b.x)], 1u);
        const unsigned gen = old / nloc;
        if (old + 1u == (gen + 1u) * nloc) {
            __builtin_amdgcn_fence(__ATOMIC_RELEASE, "agent");
            asm volatile("s_waitcnt vmcnt(0)" ::: "memory");
            const unsigned og = xb_add(&bar[XB_TOP], 1u);
            const unsigned tg = og / nx;
            if (og + 1u == (tg + 1u) * nx) xb_add(&bar[XB_TOPGEN], 1u);
            else XB_SPIN(xb_ld(&bar[XB_TOPGEN]) == tg, bar);
            __builtin_amdgcn_fence(__ATOMIC_ACQUIRE, "agent");
            xb_add(&bar[XB_XGEN(b.x)], 1u);
            asm volatile("s_waitcnt vmcnt(0)" ::: "memory");
        } else {
            XB_SPIN(xb_ld(&bar[XB_XGEN(b.x)]) == gen, bar);
            __builtin_amdgcn_fence(__ATOMIC_ACQUIRE, "agent");
            asm volatile("s_waitcnt vmcnt(0)" ::: "memory");
        }
    }
    __syncthreads();
}
#ifndef EPI_RELAX
#define EPI_RELAX 1
#endif
#ifndef EPI_RES_2G
#define EPI_RES_2G 0
#endif
#ifndef EPI_PF_LEAD
#define EPI_PF_LEAD 8
#endif
#ifndef EPI_RES_PF
#define EPI_RES_PF 0
#endif
#ifndef PG8_L2PF_DEFAULT
#define PG8_L2PF_DEFAULT false
#endif
namespace pg8 {
constexpr int BM = 256, BK = 64, HALF = 128, HTB = HALF * BK * 2, NXCD = 8;
__host__ __device__ __forceinline__ int lds_byte(int r, int c) { const int st = (r >> 4) * 2 + (c >> 5), rr = r & 15, cc = c & 31, ob = rr * 64 + cc * 2; return st * 1024 + (ob ^ (((ob >> 9) & 1) << 5)); }
__host__ __device__ __forceinline__ void stage_rc(int b, int& R, int& C) { const int st = b / 1024, sb = b % 1024, swz = sb ^ (((sb >> 9) & 1) << 5); R = (st >> 1) * 16 + swz / 64; C = (st & 1) * 32 + (swz % 64) / 2; }
__host__ __device__ __forceinline__ int perm32(int rho) { const int n = rho >> 4, i = rho & 15; return 8 * (i >> 2) + 4 * n + (i & 3); }

struct Unit { int pm, pn; };
struct Gemm { const bf16_t* A0; const bf16_t* A1; int pn_split; int lda; int grouped; const bf16_t* Bt; int ldb; int K; int nM, nN; };
__device__ __forceinline__ const char* a_ptr(const Gemm& g, const Unit& u) {
    const bf16_t* a = (u.pn < g.pn_split) ? g.A0 : g.A1;
    return (const char*)(a + (size_t)u.pm * BM * g.lda + (g.grouped ? (u.pn >> 1) * 512 : 0));
}
__device__ __forceinline__ const char* b_ptr(const Gemm& g, const Unit& u) { return (const char*)(g.Bt + (size_t)u.pn * BM * g.ldb); }

struct StaticOrder {
    int nM, nN, nwg, G, c, WGM;
    __device__ void init(int nM_, int nN_, int G_, int c_, int wgm = 8) { nM = nM_; nN = nN_; nwg = nM * nN; G = G_; c = c_; WGM = wgm; }
    __device__ bool next(int i, Unit& u) const {
        const long L = (long)i * G + c; if (L >= nwg) return false;
        int wgid = (int)L; { const int q = nwg / NXCD, r = nwg % NXCD, xcd = wgid % NXCD, off = wgid / NXCD; wgid = (xcd < r ? xcd * (q + 1) : r * (q + 1) + (xcd - r) * q) + off; }
        const int nig = WGM * nN, gid = wgid / nig, fm = gid * WGM, gsz = (nM - fm) < WGM ? (nM - fm) : WGM;
        u.pm = fm + ((wgid % nig) % gsz); u.pn = (wgid % nig) / gsz; return true;
    }
};

template <class Epi, bool ALIGN_EPI = true, bool SP2 = true, bool STAGE_IN_MMA = false, bool L2PF = PG8_L2PF_DEFAULT>
__device__ __forceinline__ void gemm_phase(LAS unsigned char* lds, const Gemm g, const StaticOrder& S, const Epi& E, int wv) {
    const int tid = opaque_tid(wv), wid = wv, lane = tid & 63, wr = wid >> 2, wc = wid & 3, fr = lane & 15, fq = lane >> 4;
    const int K = g.K, nt = K / BK;
    const int tpf = nt > EPI_PF_LEAD ? nt - EPI_PF_LEAD : 0;
    unsigned voffA[2], voffB[2];
#pragma unroll
    for (int i = 0; i < 2; ++i) { int R, C; stage_rc(tid * 16 + i * 8192, R, C); const int Rb = (R & ~31) + perm32(R & 31);
        voffA[i] = (unsigned)(R * g.lda + C) * 2u; voffB[i] = (unsigned)(Rb * g.ldb + C) * 2u; }
    const size_t kstep = (size_t)(BK * 2);
    const size_t hstepA = (size_t)HALF * g.lda * 2, hstepB = (size_t)HALF * g.ldb * 2;
    const unsigned ldsw = (unsigned)wid * 1024u;
    const int wu = __builtin_amdgcn_readfirstlane(wid);
    const int aoff = lds_byte(wr * 64 + fr, fq * 8), boff = lds_byte(wc * 32 + fr, fq * 8);
#define PG8_SA(b, h) (((b) * 2 + (h)) * HTB)
#define PG8_SB(b, h) ((4 + (b) * 2 + (h)) * HTB)
#ifndef PG8_ASM_STAGE
#define PG8_ASM_STAGE 1
#endif
#if PG8_ASM_STAGE
    const unsigned ldsb = (unsigned)(size_t)lds + (unsigned)wu * 1024u;
#define PG8_STAGE(bufoff, gbase, voff) do { _Pragma("unroll") for (int _i = 0; _i < 2; ++_i) { const unsigned m0v_ = ldsb + (unsigned)(bufoff) + (unsigned)(_i * 8192); \
        asm volatile("s_mov_b32 m0, %0\n\ts_nop 0\n\tglobal_load_lds_dwordx4 %1, %2" :: "s"(m0v_), "v"((voff)[_i]), "s"((const char*)(gbase)) : "memory", "m0"); } } while (0)
#else
#define PG8_STAGE(bufoff, gbase, voff) do { _Pragma("unroll") for (int _i = 0; _i < 2; ++_i) \
        __builtin_amdgcn_global_load_lds((const unsigned*)((const char*)(gbase) + (voff)[_i]), (LAS unsigned*)(lds + (bufoff) + ldsw + _i * 8192), 16, 0, 0); } while (0)
#endif
#define PG8_LDA(dst, b, h) do { _Pragma("unroll") for (int m = 0; m < 4; ++m) _Pragma("unroll") for (int k = 0; k < 2; ++k) dst[m][k] = *(const LAS bf16x8*)(lds + PG8_SA(b, h) + aoff + m * 2048 + k * 1024); } while (0)
#define PG8_LDB(dst, b, h) do { _Pragma("unroll") for (int n = 0; n < 2; ++n) _Pragma("unroll") for (int k = 0; k < 2; ++k) dst[n][k] = *(const LAS bf16x8*)(lds + PG8_SB(b, h) + boff + n * 2048 + k * 1024); } while (0)
#ifndef PG8_STAGE_FIRST
#define PG8_STAGE_FIRST 0
#endif
#ifndef PG8_PRIO
#define PG8_PRIO 1
#endif
#define PG8_MMA(ai, bj, At, Bt) do { if (PG8_PRIO) __builtin_amdgcn_s_setprio(1); _Pragma("unroll") for (int m = 0; m < 4; ++m) _Pragma("unroll") for (int n = 0; n < 2; ++n) _Pragma("unroll") for (int k = 0; k < 2; ++k) \
        acc[ai][bj][m][n] = __builtin_amdgcn_mfma_f32_16x16x32_bf16(Bt[n][k], At[m][k], acc[ai][bj][m][n], 0, 0, 0); if (PG8_PRIO) __builtin_amdgcn_s_setprio(0); } while (0)
#define PG8_WAIT_V(n) asm volatile("s_waitcnt vmcnt(" #n ")" ::: "memory")
#define PG8_WAIT_L(n) asm volatile("s_waitcnt lgkmcnt(" #n ")" ::: "memory")
#define PG8_BAR __builtin_amdgcn_s_barrier()
#define PG8_SCHED __builtin_amdgcn_sched_barrier(0)
    Unit cur, nxt; int ui = 0;
    if (!S.next(0, cur)) return;
    f32x4 acc[2][2][4][2];
#pragma unroll
    for (int a = 0; a < 2; ++a)
#pragma unroll
        for (int b = 0; b < 2; ++b)
#pragma unroll
            for (int m = 0; m < 4; ++m)
#pragma unroll
                for (int n = 0; n < 2; ++n) acc[a][b][m][n] = (f32x4){0.f, 0.f, 0.f, 0.f};
    bf16x8 At[4][2], B0[2][2], B1[2][2];
    const char* cA = a_ptr(g, cur); const char* cB = b_ptr(g, cur);
    if constexpr (SP2) {
    PG8_STAGE(PG8_SB(0, 0), cB, voffB); PG8_STAGE(PG8_SB(0, 1), cB + hstepB, voffB); PG8_STAGE(PG8_SA(0, 0), cA, voffA); PG8_STAGE(PG8_SA(0, 1), cA + hstepA, voffA);
    if (wr == 1) PG8_BAR;
    PG8_WAIT_V(2); PG8_BAR;
    PG8_STAGE(PG8_SB(1, 0), cB + kstep, voffB); PG8_STAGE(PG8_SA(1, 0), cA + kstep, voffA); PG8_STAGE(PG8_SB(1, 1), cB + hstepB + kstep, voffB);
    PG8_WAIT_V(6); PG8_BAR;
    } else {
    PG8_STAGE(PG8_SB(0, 0), cB, voffB); PG8_STAGE(PG8_SA(0, 0), cA, voffA); PG8_STAGE(PG8_SB(0, 1), cB + hstepB, voffB); PG8_STAGE(PG8_SA(0, 1), cA + hstepA, voffA);
    if (wr == 1) PG8_BAR;
    PG8_WAIT_V(4); PG8_BAR;
    PG8_STAGE(PG8_SB(1, 0), cB + kstep, voffB); PG8_STAGE(PG8_SA(1, 0), cA + kstep, voffA); PG8_STAGE(PG8_SB(1, 1), cB + hstepB + kstep, voffB);
    PG8_WAIT_V(6); PG8_BAR;
    }
    for (;;) {
        const bool has_next = S.next(ui + 1, nxt);
        const char* nA = has_next ? a_ptr(g, nxt) : cA; const char* nB = has_next ? b_ptr(g, nxt) : cB;
        int pf_id = 0; const int pf_sh = (S.WGM == 8) ? (wu < 4 ? 6 : 5) : (wu < 4 ? 5 : 6);
        if constexpr (L2PF) pf_id = (S.WGM == 8) ? (wu < 4 ? (cur.pn & 3) : (cur.pm & 7)) : (wu < 4 ? (cur.pn & 7) : (cur.pm & 3));
        for (int t = 0; t < nt; t += 2) {
            const bool last = (t == nt - 2);
            const char* a1 = cA + (size_t)(t + 1) * kstep;
            const char* a2 = last ? nA : cA + (size_t)(t + 2) * kstep; const char* b2 = last ? nB : cB + (size_t)(t + 2) * kstep;
            const char* a3 = a2 + kstep; const char* b3 = b2 + kstep;
            if constexpr (!SP2) {
            PG8_LDB(B0, 0, 0); PG8_SCHED; PG8_LDA(At, 0, 0); PG8_STAGE(PG8_SA(1, 1), a1 + hstepA, voffA);
            PG8_WAIT_L(8); PG8_BAR; PG8_WAIT_L(0); PG8_MMA(0, 0, At, B0); PG8_BAR; PG8_SCHED;
            PG8_LDB(B1, 0, 1); PG8_STAGE(PG8_SB(0, 0), b2, voffB);
            PG8_BAR; PG8_WAIT_L(0); PG8_MMA(0, 1, At, B1); PG8_BAR;
            PG8_LDA(At, 0, 1); PG8_STAGE(PG8_SA(0, 0), a2, voffA);
            PG8_BAR; PG8_WAIT_L(0); PG8_MMA(1, 0, At, B0); PG8_BAR; PG8_SCHED;
            PG8_STAGE(PG8_SB(0, 1), b2 + hstepB, voffB);
            PG8_WAIT_V(6); PG8_BAR; PG8_MMA(1, 1, At, B1); PG8_BAR;
            PG8_LDB(B0, 1, 0); PG8_SCHED; PG8_LDA(At, 1, 0); PG8_STAGE(PG8_SA(0, 1), a2 + hstepA, voffA);
            PG8_WAIT_L(8); PG8_BAR; PG8_WAIT_L(0); PG8_MMA(0, 0, At, B0); PG8_BAR; PG8_SCHED;
            PG8_LDB(B1, 1, 1); PG8_STAGE(PG8_SB(1, 0), b3, voffB);
            PG8_BAR; PG8_WAIT_L(0); PG8_MMA(0, 1, At, B1); PG8_BAR;
            PG8_LDA(At, 1, 1); PG8_STAGE(PG8_SA(1, 0), a3, voffA);
            PG8_BAR; PG8_WAIT_L(0); PG8_MMA(1, 0, At, B0); PG8_BAR; PG8_SCHED;
            PG8_STAGE(PG8_SB(1, 1), b3 + hstepB, voffB);
            PG8_WAIT_V(6); PG8_BAR; PG8_MMA(1, 1, At, B1); PG8_BAR;
            } else if constexpr (STAGE_IN_MMA) {
            PG8_LDB(B0, 0, 0); PG8_LDB(B1, 0, 1); PG8_SCHED; PG8_LDA(At, 0, 0);
            PG8_WAIT_V(6); PG8_WAIT_L(0); PG8_BAR; PG8_MMA(0, 0, At, B0); PG8_STAGE(PG8_SA(1, 1), a1 + hstepA, voffA); PG8_MMA(0, 1, At, B1); PG8_BAR; PG8_SCHED;
            PG8_LDA(At, 0, 1);
            PG8_WAIT_V(2); PG8_WAIT_L(0); PG8_BAR; PG8_MMA(1, 0, At, B0); PG8_STAGE(PG8_SB(0, 0), b2, voffB); PG8_STAGE(PG8_SB(0, 1), b2 + hstepB, voffB); PG8_STAGE(PG8_SA(0, 0), a2, voffA); PG8_MMA(1, 1, At, B1); PG8_BAR; PG8_SCHED;
            PG8_LDB(B0, 1, 0); PG8_LDB(B1, 1, 1); PG8_SCHED; PG8_LDA(At, 1, 0);
            PG8_WAIT_V(6); PG8_WAIT_L(0); PG8_BAR; PG8_MMA(0, 0, At, B0); PG8_STAGE(PG8_SA(0, 1), a2 + hstepA, voffA); PG8_MMA(0, 1, At, B1); PG8_BAR; PG8_SCHED;
            PG8_LDA(At, 1, 1);
            PG8_WAIT_V(2); PG8_WAIT_L(0); PG8_BAR; PG8_MMA(1, 0, At, B0); PG8_STAGE(PG8_SB(1, 0), b3, voffB); PG8_STAGE(PG8_SB(1, 1), b3 + hstepB, voffB); PG8_STAGE(PG8_SA(1, 0), a3, voffA); PG8_MMA(1, 1, At, B1); PG8_BAR; PG8_SCHED;
            } else {
#if PG8_STAGE_FIRST
            PG8_STAGE(PG8_SA(1, 1), a1 + hstepA, voffA); PG8_SCHED; PG8_LDB(B0, 0, 0); PG8_LDB(B1, 0, 1); PG8_SCHED; PG8_LDA(At, 0, 0);
            PG8_WAIT_V(8); PG8_WAIT_L(0); PG8_BAR; PG8_MMA(0, 0, At, B0); PG8_MMA(0, 1, At, B1); PG8_BAR; PG8_SCHED;
            PG8_STAGE(PG8_SB(0, 0), b2, voffB); PG8_STAGE(PG8_SB(0, 1), b2 + hstepB, voffB); PG8_STAGE(PG8_SA(0, 0), a2, voffA); PG8_SCHED; PG8_LDA(At, 0, 1);
            PG8_WAIT_V(8); PG8_WAIT_L(0); PG8_BAR; PG8_MMA(1, 0, At, B0); PG8_MMA(1, 1, At, B1); PG8_BAR; PG8_SCHED;
            PG8_STAGE(PG8_SA(0, 1), a2 + hstepA, voffA); PG8_SCHED; PG8_LDB(B0, 1, 0); PG8_LDB(B1, 1, 1); PG8_SCHED; PG8_LDA(At, 1, 0);
            PG8_WAIT_V(8); PG8_WAIT_L(0); PG8_BAR; PG8_MMA(0, 0, At, B0); PG8_MMA(0, 1, At, B1); PG8_BAR; PG8_SCHED;
            PG8_STAGE(PG8_SB(1, 0), b3, voffB); PG8_STAGE(PG8_SB(1, 1), b3 + hstepB, voffB); PG8_STAGE(PG8_SA(1, 0), a3, voffA); PG8_SCHED; PG8_LDA(At, 1, 1);
            PG8_WAIT_V(8); PG8_WAIT_L(0); PG8_BAR; PG8_MMA(1, 0, At, B0); PG8_MMA(1, 1, At, B1); PG8_BAR; PG8_SCHED;
#else
#define PG8_PF(tt) do { if constexpr (L2PF) { const int tp_ = (tt) + 4 < nt ? (tt) + 4 : nt - 1; const bool isA_ = wu < 4; \
                const int r_ = (wu & 3) * 64 + opaque_lane(); const unsigned o_ = ((r_ >> pf_sh) == pf_id) ? (unsigned)r_ * ((unsigned)(isA_ ? g.lda : g.ldb) * 2u) : 0u; \
                const unsigned m0v_ = (unsigned)(size_t)lds + 131072u + (unsigned)wu * 256u; \
                asm volatile("s_mov_b32 m0, %0\n\ts_nop 0\n\tglobal_load_lds_dword %1, %2" :: "s"(m0v_), "v"(o_), "s"((isA_ ? cA : cB) + (size_t)tp_ * kstep) : "memory", "m0"); } } while (0)
#define PG8_WAIT_VP() do { if constexpr (L2PF) PG8_WAIT_V(9); else PG8_WAIT_V(8); } while (0)
#define PG8_WAIT_VF() do { if constexpr (Epi::NVM > 0 && !L2PF) { if (t == 0 && ui > 0) asm volatile("s_waitcnt vmcnt(%0)" :: "i"(8 + Epi::NVM) : "memory"); else PG8_WAIT_V(8); } else PG8_WAIT_VP(); } while (0)
            if constexpr (Epi::HAS_PF) { if (t == tpf) { E.prefetch(cur, wu, opaque_lane()); PG8_SCHED; } }
            PG8_PF(t); PG8_SCHED; PG8_LDB(B0, 0, 0); PG8_LDB(B1, 0, 1); PG8_SCHED; PG8_LDA(At, 0, 0); PG8_STAGE(PG8_SA(1, 1), a1 + hstepA, voffA);
            PG8_WAIT_VF(); PG8_WAIT_L(0); PG8_BAR; PG8_MMA(0, 0, At, B0); PG8_MMA(0, 1, At, B1); PG8_BAR; PG8_SCHED;
            PG8_LDA(At, 0, 1); PG8_STAGE(PG8_SB(0, 0), b2, voffB); PG8_STAGE(PG8_SB(0, 1), b2 + hstepB, voffB); PG8_STAGE(PG8_SA(0, 0), a2, voffA);
            PG8_WAIT_VF(); PG8_WAIT_L(0); PG8_BAR; PG8_MMA(1, 0, At, B0); PG8_MMA(1, 1, At, B1); PG8_BAR; PG8_SCHED;
            PG8_PF(t + 1); PG8_SCHED; PG8_LDB(B0, 1, 0); PG8_LDB(B1, 1, 1); PG8_SCHED; PG8_LDA(At, 1, 0); PG8_STAGE(PG8_SA(0, 1), a2 + hstepA, voffA);
            PG8_WAIT_VP(); PG8_WAIT_L(0); PG8_BAR; PG8_MMA(0, 0, At, B0); PG8_MMA(0, 1, At, B1); PG8_BAR; PG8_SCHED;
            PG8_LDA(At, 1, 1); PG8_STAGE(PG8_SB(1, 0), b3, voffB); PG8_STAGE(PG8_SB(1, 1), b3 + hstepB, voffB); PG8_STAGE(PG8_SA(1, 0), a3, voffA);
            PG8_WAIT_VP(); PG8_WAIT_L(0); PG8_BAR; PG8_MMA(1, 0, At, B0); PG8_MMA(1, 1, At, B1); PG8_BAR; PG8_SCHED;
#undef PG8_PF
#undef PG8_WAIT_VP
#undef PG8_WAIT_VF
#endif
            }
        }
        if constexpr (ALIGN_EPI) { if (wr == 0) PG8_BAR; }
        { const int te = opaque_lane(); E(acc, cur, wr, wc, te & 15, (te >> 4) & 3); }
        if (!has_next) break;
#pragma unroll
        for (int a = 0; a < 2; ++a)
#pragma unroll
            for (int b = 0; b < 2; ++b)
#pragma unroll
                for (int m = 0; m < 4; ++m)
#pragma unroll
                    for (int n = 0; n < 2; ++n) acc[a][b][m][n] = (f32x4){0.f, 0.f, 0.f, 0.f};
        cur = nxt; cA = nA; cB = nB; ++ui;
        if constexpr (ALIGN_EPI) { if (wr == 1) PG8_BAR; }
    }
    PG8_WAIT_V(0);
    if constexpr (!ALIGN_EPI) { if (wr == 0) PG8_BAR; }
    PG8_BAR;
#undef PG8_SA
#undef PG8_SB
#undef PG8_STAGE
#undef PG8_LDA
#undef PG8_LDB
#undef PG8_MMA
#undef PG8_WAIT_V
#undef PG8_WAIT_L
#undef PG8_BAR
#undef PG8_SCHED
}

__device__ __forceinline__ u32x4 pack8bf(const f32x4& a, const f32x4& b) { u32x4 w; w.x = cvt_pk_bf16(a[0], a[1]); w.y = cvt_pk_bf16(a[2], a[3]); w.z = cvt_pk_bf16(b[0], b[1]); w.w = cvt_pk_bf16(b[2], b[3]); return w; }
__device__ __forceinline__ float sumsq4(const f32x4& a) { return (a[0] * a[0] + a[1] * a[1]) + (a[2] * a[2] + a[3] * a[3]); }

struct EpiRes {
    const float* xin32; const bf16_t* xin16; float* xout32; bf16_t* xout16; unsigned char* xlo; const float* gate; const float* gm0; bf16_t* a0; const float* gm1; bf16_t* a1; rs_t* rowss;
    unsigned pfl;
    static constexpr bool HAS_PF = EPI_RES_PF != 0;
    static constexpr int NVM = EPI_RELAX ? 36 : 0;
    __device__ __forceinline__ void prefetch(const Unit& u, int wv_  , int ln_) const {
        if (pfl && !xin32 && XBF16 == 2) {
            const unsigned prow = (unsigned)(u.pm * BM + (wv_ & 1) * HALF + (wv_ >> 2) * 64 + ln_);
            const unsigned oh0 = (prow * DM + (unsigned)(u.pn * BM + ((wv_ >> 1) & 1) * 64)) * 2u, oh1 = oh0 + 256u;
            const unsigned ol = prow * DM + (unsigned)(u.pn * BM + ((wv_ >> 1) & 1) * HALF);
            const unsigned m0v = pfl + (unsigned)wv_ * 256u;
            asm volatile("s_mov_b32 m0, %0\n\ts_nop 0\n\tglobal_load_lds_dword %1, %4\n\tglobal_load_lds_dword %2, %4\n\tglobal_load_lds_dword %3, %5"
                         :: "s"(m0v), "v"(oh0), "v"(oh1), "v"(ol), "s"(xin16), "s"(xlo) : "memory", "m0");
        }
    }
    __device__ __forceinline__ void operator()(const f32x4 (&acc)[2][2][4][2], const Unit& u, int wr, int wc, int fr, int fq) const {
        const int b = u.pm >> 4; const int row0 = u.pm * BM + wr * 64 + fr;
        float ss[2][4];
#pragma unroll
        for (int ai = 0; ai < 2; ++ai)
#pragma unroll
            for (int m = 0; m < 4; ++m) ss[ai][m] = 0.f;
#pragma unroll
        for (int bj = 0; bj < 2; ++bj) {
            const int col = u.pn * BM + bj * HALF + wc * 32 + 8 * fq; const int vo = b * DM + col;
            const f32x4 g0 = *(const f32x4*)(gate + vo), g1 = *(const f32x4*)(gate + vo + 4);
            f32x4 m00 = {0, 0, 0, 0}, m01 = {0, 0, 0, 0}, m10 = {0, 0, 0, 0}, m11 = {0, 0, 0, 0};
            if (a0) { m00 = *(const f32x4*)(gm0 + vo); m01 = *(const f32x4*)(gm0 + vo + 4); }
            if (a1) { m10 = *(const f32x4*)(gm1 + vo); m11 = *(const f32x4*)(gm1 + vo + 4); }
#if EPI_RES_2G
            u32x4 xr2[4];
            if (!xin32) {
#pragma unroll
                for (int m = 0; m < 4; ++m) { const size_t off = (size_t)(row0 + HALF + m * 16) * DM + col; xr2[m] = *(const u32x4*)(xin16 + off); }
            }
#endif
#pragma unroll
            for (int ai = 0; ai < 2; ++ai) {
                f32x4 xv[4][2];
                if (xin32) {
#pragma unroll
                    for (int m = 0; m < 4; ++m) { const size_t off = (size_t)(row0 + ai * HALF + m * 16) * DM + col; xv[m][0] = *(const f32x4*)(xin32 + off); xv[m][1] = *(const f32x4*)(xin32 + off + 4); }
                } else {
                    u32x4 xr[4]; u32x2 xl[4];
#if EPI_RES_2G
#pragma unroll
                    for (int m = 0; m < 4; ++m) { const size_t off = (size_t)(row0 + ai * HALF + m * 16) * DM + col; if (ai == 0) xr[m] = *(const u32x4*)(xin16 + off); else xr[m] = xr2[m];
                        if (XBF16 == 2) xl[m] = *(const u32x2*)(xlo + off); }
#else
#pragma unroll
                    for (int m = 0; m < 4; ++m) { const size_t off = (size_t)(row0 + ai * HALF + m * 16) * DM + col; xr[m] = *(const u32x4*)(xin16 + off);
                        if (XBF16 == 2) xl[m] = *(const u32x2*)(xlo + off); }
#endif
#pragma unroll
                    for (int m = 0; m < 4; ++m) { if (XBF16 == 2) x8_unpack24(xr[m], xl[m], xv[m][0], xv[m][1]); else x8_unpack16(xr[m], xv[m][0], xv[m][1]); }
                }
#pragma unroll
                for (int m = 0; m < 4; ++m) {
                    const size_t off = (size_t)(row0 + ai * HALF + m * 16) * DM + col;
                    const f32x4 v0 = xv[m][0] + g0 * acc[ai][bj][m][0], v1 = xv[m][1] + g1 * acc[ai][bj][m][1];
                    if (xout32) { *(f32x4*)(xout32 + off) = v0; *(f32x4*)(xout32 + off + 4) = v1; }
                    else if (XBF16 == 2) { u32x4 hh; u32x2 ll; x8_pack24(v0, v1, hh, ll); st_stream((u32x4*)(xout16 + off), hh); st_stream((u32x2*)(xlo + off), ll); }
                    else *(u32x4*)(xout16 + off) = pack8bf(v0, v1);
                    ss[ai][m] += sumsq4(v0) + sumsq4(v1);
                    if (a0) *(u32x4*)(a0 + off) = pack8bf(v0 * m00, v1 * m01);
                    if (a1) *(u32x4*)(a1 + off) = pack8bf(v0 * m10, v1 * m11);
                }
            }
        }
        if (rowss) {
#pragma unroll
            for (int ai = 0; ai < 2; ++ai)
#pragma unroll
                for (int m = 0; m < 4; ++m) { float s = ss[ai][m]; s += swz_xor16(s); s = add_xor32(s); if (fq == 0) rs_add(rowss + row0 + ai * HALF + m * 16, s); }
        }
    }
};

struct EpiNull { float* sink;
    static constexpr bool HAS_PF = false; __device__ __forceinline__ void prefetch(const Unit&, int, int) const {} static constexpr int NVM = 0;
    __device__ __forceinline__ void operator()(const f32x4 (&acc)[2][2][4][2], const Unit& u, int wr, int wc, int fr, int fq) const {
        f32x4 t = {0.f, 0.f, 0.f, 0.f};
#pragma unroll
        for (int ai = 0; ai < 2; ++ai)
#pragma unroll
            for (int bj = 0; bj < 2; ++bj)
#pragma unroll
                for (int m = 0; m < 4; ++m) t += acc[ai][bj][m][0] + acc[ai][bj][m][1];
        *(f32x4*)(sink + ((size_t)(blockIdx.x * 512 + threadIdx.x) * 4)) = t;
    }
};

struct EpiSwi {
    static constexpr bool HAS_PF = false; __device__ __forceinline__ void prefetch(const Unit&, int, int) const {} static constexpr int NVM = EPI_RELAX ? 20 : 0;
    const rs_t* rowss; const float* bias; bf16_t* act;
    __device__ __forceinline__ void operator()(const f32x4 (&acc)[2][2][4][2], const Unit& u, int wr, int wc, int fr, int fq) const {
        const int b = u.pm >> 4; const int row0 = u.pm * BM + wr * 64 + fr;
        const int vc = u.pn * BM + wc * 32 + 8 * fq; const int ac = u.pn * HALF + wc * 32 + 8 * fq;
        const float* bp = bias + (size_t)b * 11264 + vc;
        const f32x4 bg0 = *(const f32x4*)bp, bg1 = *(const f32x4*)(bp + 4), bu0 = *(const f32x4*)(bp + HALF), bu1 = *(const f32x4*)(bp + HALF + 4);
        const f32x4 bgl0 = bg0 * -1.4426950408889634f, bgl1 = bg1 * -1.4426950408889634f;
        float rsv[8];
#pragma unroll
        for (int r = 0; r < 8; ++r) rsv[r] = rs_get(rowss + row0 + (r >> 2) * HALF + (r & 3) * 16);
#pragma unroll
        for (int ai = 0; ai < 2; ++ai)
#pragma unroll
            for (int m = 0; m < 4; ++m) {
                const int row = row0 + ai * HALF + m * 16;
                const float rstd = rsqrtf(rsv[ai * 4 + m] * (1.f / DM) + EPS);
                const float rl = rstd * -1.4426950408889634f;
                const f32x4 ga = acc[ai][0][m][0] * rstd + bg0, gb = acc[ai][0][m][1] * rstd + bg1, ua = acc[ai][1][m][0] * rstd + bu0, ub = acc[ai][1][m][1] * rstd + bu1;
                f32x4 ea = acc[ai][0][m][0] * rl + bgl0, eb = acc[ai][0][m][1] * rl + bgl1;
#pragma unroll
                for (int j = 0; j < 4; ++j) { ea[j] = __builtin_amdgcn_exp2f(ea[j]); eb[j] = __builtin_amdgcn_exp2f(eb[j]); }
                ea = ea + 1.f; eb = eb + 1.f;
#pragma unroll
                for (int j = 0; j < 4; ++j) { ea[j] = __builtin_amdgcn_rcpf(ea[j]); eb[j] = __builtin_amdgcn_rcpf(eb[j]); }
                const f32x4 r0 = (ga * ua) * ea, r1 = (gb * ub) * eb;
                st_stream((u32x4*)(act + (size_t)row * FF + ac), pack8bf(r0, r1));
            }
    }
};

struct EpiDown {
    static constexpr bool HAS_PF = false; __device__ __forceinline__ void prefetch(const Unit&, int, int) const {} static constexpr int NVM = 0;
    const rs_t* rowss1; const float* bias; int ldbias; int pn_q0;
    unsigned char* ws; rs_t* rsb; int rsq;
    const float2* tab;
    __device__ __forceinline__ void operator()(const f32x4 (&acc)[2][2][4][2], const Unit& u, int wr, int wc, int fr, int fq) const {
        const int b = u.pm >> 4; const int row0 = u.pm * BM + wr * 64 + fr;
        const float* bp = bias + (size_t)b * ldbias + u.pn * BM + wc * 32 + 8 * fq;
        const f32x4 b00 = *(const f32x4*)bp, b01 = *(const f32x4*)(bp + 4), b10 = *(const f32x4*)(bp + HALF), b11 = *(const f32x4*)(bp + HALF + 4);
        const bool is_q = u.pn >= pn_q0;
        if (is_q || u.pn < 2) {
            bf16_t* dst = (bf16_t*)(ws + (is_q ? WS_CQ : WS_CKV)); rs_t* rs = rsb + (size_t)(is_q ? rsq : RS_KV) * 16384;
            const int col = (is_q ? (u.pn - pn_q0) : u.pn) * BM + wc * 32 + 8 * fq;
#pragma unroll
            for (int ai = 0; ai < 2; ++ai)
#pragma unroll
                for (int m = 0; m < 4; ++m) {
                    const int row = row0 + ai * HALF + m * 16;
                    const float rstd = rsqrtf(rs_get(rowss1 + row) * (1.f / DM) + EPS);
                    const f32x4 v00 = acc[ai][0][m][0] * rstd + b00, v01 = acc[ai][0][m][1] * rstd + b01, v10 = acc[ai][1][m][0] * rstd + b10, v11 = acc[ai][1][m][1] * rstd + b11;
                    *(u32x4*)(dst + (size_t)row * 512 + col) = pack8bf(v00, v01);
                    *(u32x4*)(dst + (size_t)row * 512 + col + HALF) = pack8bf(v10, v11);
                    float s = (sumsq4(v00) + sumsq4(v01)) + (sumsq4(v10) + sumsq4(v11));
                    s += swz_xor16(s); s = add_xor32(s); if (fq == 0) rs_add(rs + row, s);
                }
        } else if (wc == 0) {
            bf16_t* kr = (bf16_t*)(ws + WS_KR);
#pragma unroll
            for (int ai = 0; ai < 2; ++ai)
#pragma unroll
                for (int m = 0; m < 4; ++m) {
                    const int row = row0 + ai * HALF + m * 16;
                    const float rstd = rsqrtf(rs_get(rowss1 + row) * (1.f / DM) + EPS);
                    const f32x4 t10 = acc[ai][0][m][0] * rstd + b00, t11 = acc[ai][0][m][1] * rstd + b01, t20 = acc[ai][1][m][0] * rstd + b10, t21 = acc[ai][1][m][1] * rstd + b11;
                    const float2* tp = tab + (size_t)row * 32 + 8 * fq;
                    f32x4 o10, o11, o20, o21;
#pragma unroll
                    for (int j = 0; j < 4; ++j) { const float2 ca = tp[j], cb = tp[4 + j];
                        o10[j] = t10[j] * ca.x - t20[j] * ca.y; o20[j] = t20[j] * ca.x + t10[j] * ca.y;
                        o11[j] = t11[j] * cb.x - t21[j] * cb.y; o21[j] = t21[j] * cb.x + t11[j] * cb.y; }
                    *(u32x4*)(kr + (size_t)row * 64 + 8 * fq) = pack8bf(o10, o11);
                    *(u32x4*)(kr + (size_t)row * 64 + 32 + 8 * fq) = pack8bf(o20, o21);
                }
        }
    }
};

struct EpiUp {
    static constexpr bool HAS_PF = false; __device__ __forceinline__ void prefetch(const Unit&, int, int) const {} static constexpr int NVM = EPI_RELAX ? 24 : 0;
    unsigned char* ws; const rs_t* rsb; int rsq; int pn_q0; const float2* tab;
    __device__ __forceinline__ void operator()(const f32x4 (&acc)[2][2][4][2], const Unit& u, int wr, int wc, int fr, int fq) const {
        const int row0 = u.pm * BM + wr * 64 + fr;
        const bool is_q = u.pn >= pn_q0; const int p = is_q ? u.pn - pn_q0 : u.pn;
        const rs_t* rs = rsb + (size_t)(is_q ? rsq : RS_KV) * 16384;
        if (!(is_q && p >= 8)) {
            bf16_t* dst = (bf16_t*)(ws + (is_q ? WS_QN : (p < 8 ? WS_KN : WS_V)));
            const int col = (p & 7) * BM + wc * 32 + 8 * fq;
#pragma unroll
            for (int ai = 0; ai < 2; ++ai)
#pragma unroll
                for (int m = 0; m < 4; ++m) {
                    const int row = row0 + ai * HALF + m * 16;
                    const float rstd = rsqrtf(rs_get(rs + row) * (1.f / 512.f) + EPS);
                    st_stream((u32x4*)(dst + (size_t)row * DM + col), pack8bf(acc[ai][0][m][0] * rstd, acc[ai][0][m][1] * rstd));
                    st_stream((u32x4*)(dst + (size_t)row * DM + col + HALF), pack8bf(acc[ai][1][m][0] * rstd, acc[ai][1][m][1] * rstd));
                }
        } else {
            bf16_t* qr = (bf16_t*)(ws + WS_QR);
            const int hh = 4 * (p - 8) + wc;
#pragma unroll
            for (int ai = 0; ai < 2; ++ai)
#pragma unroll
                for (int m = 0; m < 4; ++m) {
                    const int row = row0 + ai * HALF + m * 16;
                    const float rstd = rsqrtf(rs_get(rs + row) * (1.f / 512.f) + EPS);
                    const f32x4 t10 = acc[ai][0][m][0] * rstd, t11 = acc[ai][0][m][1] * rstd, t20 = acc[ai][1][m][0] * rstd, t21 = acc[ai][1][m][1] * rstd;
                    const float2* tp = tab + (size_t)row * 32 + 8 * fq;
                    f32x4 o10, o11, o20, o21;
#pragma unroll
                    for (int j = 0; j < 4; ++j) { const float2 ca = tp[j], cb = tp[4 + j];
                        o10[j] = t10[j] * ca.x - t20[j] * ca.y; o20[j] = t20[j] * ca.x + t10[j] * ca.y;
                        o11[j] = t11[j] * cb.x - t21[j] * cb.y; o21[j] = t21[j] * cb.x + t11[j] * cb.y; }
                    st_stream((u32x4*)(qr + (size_t)row * 1024 + hh * 64 + 8 * fq), pack8bf(o10, o11));
                    st_stream((u32x4*)(qr + (size_t)row * 1024 + hh * 64 + 32 + 8 * fq), pack8bf(o20, o21));
                }
        }
    }
};
}
namespace att {
constexpr int D = 128, DQK = 192, NW = 8, QBLK = 32, KVBLK = 64, QB = NW * QBLK;
constexpr int LDQ = 2048, LDQR = 1024, LDKR = 64;
constexpr float SCALE = 0.07216878364870322f;
constexpr float THR = 8.f;
constexpr int KROW = 400;
constexpr int SHM_V = KVBLK * D * 2, SHM_K = KVBLK * KROW;
constexpr int NVS = 3;
constexpr int K_LDS_OFF = NVS * SHM_V, WS_LDS_OFF = K_LDS_OFF + 2 * SHM_K;
constexpr int QR_LDS_OFF = WS_LDS_OFF + NW * 64 * 4;
constexpr int ATT_LDS_BYTES = QR_LDS_OFF + NW * 4096;
constexpr int PF_LDS_OFF = ATT_LDS_BYTES;
static_assert(ATT_LDS_BYTES + 2048 <= MISC_OFF, "attention LDS map");
#ifndef ATT_SKIP
#define ATT_SKIP 1
#endif
#ifndef ATT_SWAP
#define ATT_SWAP 3
#endif
#define SBAR() __builtin_amdgcn_sched_barrier(0)
__device__ __forceinline__ int v_st(int k, int c) { const int kk = (k & ~0xC) | ((k & 4) << 1) | ((k & 8) >> 1); return ((kk >> 3) * 4 + (c >> 5)) * 512 + ((kk & 7) * 32 + (c & 31)) * 2; }
__device__ __forceinline__ int v_rd_base(int lane) { return ((lane & 3) << 3) | (((lane >> 2) & 3) << 6) | (((lane >> 4) & 1) << 5) | (((lane >> 5) & 1) << 8); }
constexpr int v_rd_off(int d0, int ks, int half) { return d0 * 512 + ks * 4096 + half * 2048; }
__device__ __forceinline__ int crow(int r, int hi) { return (r & 3) + 8 * (r >> 2) + 4 * hi; }
__device__ __forceinline__ unsigned cvtpk(float lo, float hi) { unsigned r; asm volatile("v_cvt_pk_bf16_f32 %0, %1, %2" : "=v"(r) : "v"(lo), "v"(hi)); return r; }
__device__ __forceinline__ bf16x8 load8(const bf16_t* p) { return *reinterpret_cast<const bf16x8*>(p); }
__device__ __forceinline__ void mask_tile(f32x16& p0, f32x16& p1, int dq) {
    const float NEG = -__builtin_inff();
#pragma unroll
    for (int r = 0; r < 16; ++r) {
        const int c = (r & 3) + 8 * (r >> 2);
        if (dq - c < 0) p0[r] = NEG;
        if (dq - c - 32 < 0) p1[r] = NEG;
    }
}
__device__ __forceinline__ void partialSM(f32x16& p0, f32x16& p1, float& m_reg, float& mn, float& alpha) {
    float pmax = p0[0]; for (int r = 1; r < 16; ++r) pmax = fmaxf(pmax, p0[r]); for (int r = 0; r < 16; ++r) pmax = fmaxf(pmax, p1[r]);
    { auto rr = __builtin_amdgcn_permlane32_swap(__float_as_uint(pmax), __float_as_uint(pmax), false, false);
      pmax = fmaxf(__uint_as_float(rr[0]), __uint_as_float(rr[1])); }
    constexpr float C2 = 1.4426950408889634f * SCALE;
    if (__builtin_expect(__all((pmax - m_reg) * SCALE <= THR), 1)) { mn = m_reg; alpha = 1.f; }
    else { mn = fmaxf(m_reg, pmax); alpha = __builtin_amdgcn_exp2f((m_reg - mn) * C2); m_reg = mn; }
    const float mnL = -mn * C2;
    for (int r = 0; r < 16; ++r) p0[r] = fmaf(p0[r], C2, mnL); for (int r = 0; r < 16; ++r) p1[r] = fmaf(p1[r], C2, mnL);
    for (int r = 0; r < 16; ++r) p0[r] = __builtin_amdgcn_exp2f(p0[r]);
}
__device__ __forceinline__ void finishSM(f32x16& p0, f32x16& p1, float alpha, float& l_reg, bf16x8& pa0, bf16x8& pa1, bf16x8& pa2, bf16x8& pa3) {
    for (int r = 0; r < 16; ++r) p1[r] = __builtin_amdgcn_exp2f(p1[r]);
    float ps = 0; for (int r = 0; r < 16; ++r) ps += p0[r]; for (int r = 0; r < 16; ++r) ps += p1[r];
    { auto rr = __builtin_amdgcn_permlane32_swap(__float_as_uint(ps), __float_as_uint(ps), false, false);
      ps = __uint_as_float(rr[0]) + __uint_as_float(rr[1]); }
    l_reg = l_reg * alpha + ps;
#define PK4(P, B_, OUT) do { unsigned a0 = cvtpk(P[B_+0], P[B_+1]), a1 = cvtpk(P[B_+2], P[B_+3]);                          \
        unsigned b0 = cvtpk(P[B_+4], P[B_+5]), b1 = cvtpk(P[B_+6], P[B_+7]);                                             \
        auto r0 = __builtin_amdgcn_permlane32_swap(a0, b0, false, false); auto r1 = __builtin_amdgcn_permlane32_swap(a1, b1, false, false); \
        u32x4 w = {r0[0], r1[0], r0[1], r1[1]}; OUT = *reinterpret_cast<bf16x8*>(&w); } while (0)
    PK4(p0, 0, pa0); PK4(p0, 8, pa1); PK4(p1, 0, pa2); PK4(p1, 8, pa3);
#undef PK4
}
template <int KB>
__device__ __forceinline__ void qkt(f32x16& p0, f32x16& p1, const char* K_lds, int r32, int hi, const bf16x8* qr, const char* qrl) {
    p0 = f32x16{}; p1 = f32x16{};
    const int kb0 = (int)(uintptr_t)K_lds + r32 * KROW + hi * 16;
    const int qb = (int)(uintptr_t)qrl;
    bf16x8 ka[12], kc[12], qq[4];
#define QK_LDR(dst, base, off) asm volatile("ds_read_b128 %0, %1 offset:%2" : "=&v"(dst) : "v"(base), "i"(off) : "memory")
#define QK_RD(d0) do { QK_LDR(ka[d0], kb0, KB * SHM_K + (d0) * 32); QK_LDR(kc[d0], kb0, KB * SHM_K + (d0) * 32 + 32 * KROW); \
        if ((d0) >= 8) QK_LDR(qq[(d0) >= 8 ? (d0) - 8 : 0], qb, ((d0) >= 8 ? (d0) - 8 : 0) * 1024); } while (0)
#define QK_N1(j) ((j) <= 11 ? 2 + ((j) >= 8 ? 1 : 0) : 0)
#define QK_STEP(d0) do { if ((d0) + 3 < 12) QK_RD((d0) + 3 < 12 ? (d0) + 3 : 0); \
        if ((d0) >= 8) asm volatile("s_waitcnt lgkmcnt(%3)" : "+v"(ka[d0]), "+v"(kc[d0]), "+v"(qq[(d0) >= 8 ? (d0) - 8 : 0]) : "i"(QK_N1((d0) + 1) + QK_N1((d0) + 2) + QK_N1((d0) + 3)) : "memory"); \
        else asm volatile("s_waitcnt lgkmcnt(%2)" : "+v"(ka[d0]), "+v"(kc[d0]) : "i"(QK_N1((d0) + 1) + QK_N1((d0) + 2) + QK_N1((d0) + 3)) : "memory"); \
        { const bf16x8 q = (d0) < 8 ? qr[(d0) < 8 ? (d0) : 0] : qq[(d0) >= 8 ? (d0) - 8 : 0]; \
          p0 = __builtin_amdgcn_mfma_f32_32x32x16_bf16(ka[d0], q, p0, 0, 0, 0); p1 = __builtin_amdgcn_mfma_f32_32x32x16_bf16(kc[d0], q, p1, 0, 0, 0); } } while (0)
    QK_RD(0); QK_RD(1); QK_RD(2);
    QK_STEP(0); QK_STEP(1); QK_STEP(2); QK_STEP(3); QK_STEP(4); QK_STEP(5); QK_STEP(6); QK_STEP(7); QK_STEP(8); QK_STEP(9); QK_STEP(10); QK_STEP(11);
#undef QK_STEP
#undef QK_N1
#undef QK_RD
#undef QK_LDR
}
__device__ __forceinline__ void pv_tile(f32x16* o, int vb, bf16x8 pa0, bf16x8 pa1, bf16x8 pa2, bf16x8 pa3) {
#define TRRD(dst, off) asm volatile("ds_read_b64_tr_b16 %0, %1 offset:%2" : "=&v"(dst) : "v"(vb), "i"(off) : "memory")
#define PV_RD(d0, S_) do { constexpr int b_ = v_rd_off(d0, 0, 0); \
        TRRD(S_##l0, b_); TRRD(S_##h0, b_ + 2048); TRRD(S_##l1, b_ + 4096); TRRD(S_##h1, b_ + 6144); TRRD(S_##l2, b_ + 8192); TRRD(S_##h2, b_ + 10240); TRRD(S_##l3, b_ + 12288); TRRD(S_##h3, b_ + 14336); } while (0)
#define PV_MM(d0, S_) do { \
        o[d0] = __builtin_amdgcn_mfma_f32_32x32x16_bf16(pa0, (bf16x8){S_##l0[0], S_##l0[1], S_##l0[2], S_##l0[3], S_##h0[0], S_##h0[1], S_##h0[2], S_##h0[3]}, o[d0], 0, 0, 0);   \
        o[d0] = __builtin_amdgcn_mfma_f32_32x32x16_bf16(pa1, (bf16x8){S_##l1[0], S_##l1[1], S_##l1[2], S_##l1[3], S_##h1[0], S_##h1[1], S_##h1[2], S_##h1[3]}, o[d0], 0, 0, 0);   \
        o[d0] = __builtin_amdgcn_mfma_f32_32x32x16_bf16(pa2, (bf16x8){S_##l2[0], S_##l2[1], S_##l2[2], S_##l2[3], S_##h2[0], S_##h2[1], S_##h2[2], S_##h2[3]}, o[d0], 0, 0, 0);   \
        o[d0] = __builtin_amdgcn_mfma_f32_32x32x16_bf16(pa3, (bf16x8){S_##l3[0], S_##l3[1], S_##l3[2], S_##l3[3], S_##h3[0], S_##h3[1], S_##h3[2], S_##h3[3]}, o[d0], 0, 0, 0); } while (0)
#define PV_WAIT(n, S_) asm volatile("s_waitcnt lgkmcnt(%8)" : "+v"(S_##l0), "+v"(S_##h0), "+v"(S_##l1), "+v"(S_##h1), "+v"(S_##l2), "+v"(S_##h2), "+v"(S_##l3), "+v"(S_##h3) : "i"(n) : "memory")
    s16x4 Al0, Al1, Al2, Al3, Ah0, Ah1, Ah2, Ah3, Bl0, Bl1, Bl2, Bl3, Bh0, Bh1, Bh2, Bh3;
    PV_RD(0, A); PV_RD(1, B); PV_WAIT(8, A); PV_MM(0, A);
    PV_RD(2, A); PV_WAIT(8, B); PV_MM(1, B);
    PV_RD(3, B); PV_WAIT(8, A); PV_MM(2, A);
    PV_WAIT(0, B); PV_MM(3, B);
#undef PV_WAIT
#undef PV_MM
#undef PV_RD
#undef TRRD
}

struct BlockRef { unsigned char* wsb; int tok0, row0, h, P0; };
#define T_QN(R_) ((const bf16_t*)((R_).wsb + WS_QN) + (size_t)(R_).row0 * LDQ + (R_).h * 128)
#define T_QR(R_) ((const bf16_t*)((R_).wsb + WS_QR) + (size_t)(R_).row0 * LDQR + (R_).h * 64)
#define T_KN(R_) ((const bf16_t*)((R_).wsb + WS_KN) + (size_t)(R_).tok0 * LDQ + (R_).h * 128)
#define T_KR(R_) ((const bf16_t*)((R_).wsb + WS_KR) + (size_t)(R_).tok0 * LDKR)
#define T_V(R_)  ((const bf16_t*)((R_).wsb + WS_V) + (size_t)(R_).tok0 * LDQ + (R_).h * 128)
#define T_O(R_)  ((bf16_t*)((R_).wsb + WS_O) + (size_t)(R_).row0 * LDQ + (R_).h * 128)
struct Seam { bf16x8 qr[8]; };
#define VMW() asm volatile("s_waitcnt vmcnt(0)" ::: "memory")
#ifndef ATT_PF
#define ATT_PF 1
#endif
#if ATT_PF
#define DMA_ASM(m0v, voff, OP) asm volatile("s_mov_b32 m0, %0\n\ts_nop 0\n\t" OP " %1, %2" :: "s"(m0v), "v"(voff), "s"(cur.wsb) : "memory", "m0")
#define DMA_TILE(k0, kbf, vslot) do { _Pragma("unroll") for (int i_ = 0; i_ < 4; ++i_) if (i_ < 3 || wid == 0) { \
            const unsigned m0_ = ldsb_ + (unsigned)(K_LDS_OFF + (kbf) * SHM_K + (wid + 8 * i_) * 1024); DMA_ASM(m0_, kdo[i_] + (unsigned)(k0) * kds[i_], "global_load_lds_dwordx4"); } \
        _Pragma("unroll") for (int i_ = 0; i_ < 2; ++i_) { const unsigned m0_ = ldsb_ + (unsigned)((vslot) * SHM_V + (wid * 2 + i_) * 1024); DMA_ASM(m0_, vdo[i_] + (unsigned)(k0) * 4096u, "global_load_lds_dwordx4"); } } while (0)
#define DMA_K(k0, kbf) do { _Pragma("unroll") for (int i_ = 0; i_ < 4; ++i_) if (i_ < 3 || wid == 0) { \
            const unsigned m0_ = ldsb_ + (unsigned)(K_LDS_OFF + (kbf) * SHM_K + (wid + 8 * i_) * 1024); DMA_ASM(m0_, kdo[i_] + (unsigned)(k0) * kds[i_], "global_load_lds_dwordx4"); } } while (0)
#define DMA_V(k0, vslot) do { _Pragma("unroll") for (int i_ = 0; i_ < 2; ++i_) { const unsigned m0_ = ldsb_ + (unsigned)((vslot) * SHM_V + (wid * 2 + i_) * 1024); DMA_ASM(m0_, vdo[i_] + (unsigned)(k0) * 4096u, "global_load_lds_dwordx4"); } } while (0)
#if ATT_PF >= 2
#define PF_TILE(k0) do { const unsigned m0_ = ldsb_ + (unsigned)(PF_LDS_OFF + wid * 256); DMA_ASM(m0_, pfo_ + (unsigned)(k0) * pfs_, "global_load_lds_dword"); } while (0)
#define PFN 1
#else
#define PF_TILE(k0) do { (void)pfo_; (void)pfs_; } while (0)
#define PFN 0
#endif
#define VMW1() asm volatile("s_waitcnt vmcnt(%0)" :: "i"(PFN) : "memory")
#define VMW3() asm volatile("s_waitcnt vmcnt(%0)" :: "i"(2 + PFN) : "memory")
#else
#define DMA_TILE(k0, kbf, vslot) do { _Pragma("unroll") for (int i_ = 0; i_ < 4; ++i_) if (i_ < 3 || wid == 0) \
            __builtin_amdgcn_global_load_lds((const unsigned*)(cur.wsb + (size_t)kdo[i_] + (size_t)(k0) * kds[i_]), (LAS unsigned*)(lds + K_LDS_OFF + (kbf) * SHM_K + (wid + 8 * i_) * 1024), 16, 0, 0); \
        _Pragma("unroll") for (int i_ = 0; i_ < 2; ++i_) \
            __builtin_amdgcn_global_load_lds((const unsigned*)(cur.wsb + (size_t)vdo[i_] + (size_t)(k0) * 4096), (LAS unsigned*)(lds + (vslot) * SHM_V + (wid * 2 + i_) * 1024), 16, 0, 0); } while (0)
#define PF_TILE(k0) do { } while (0)
#define VMW1() do { } while (0)
#define VMW3() do { } while (0)
#endif
#define QLOAD(R_) do { _Pragma("unroll") for (int d0 = 0; d0 < 8; ++d0) S.qr[d0] = load8(T_QN(R_) + (size_t)(wid * QBLK + r32) * LDQ + d0 * 16 + hi * 8); \
                       _Pragma("unroll") for (int d0 = 0; d0 < 4; ++d0) *(bf16x8*)(qrl + d0 * 1024) = load8(T_QR(R_) + (size_t)(wid * QBLK + r32) * LDQR + d0 * 16 + hi * 8); } while (0)

template <bool SWAP>
__device__ __forceinline__ void block_t(const BlockRef& cur, char* lds, int wv) {
    const int tid = opaque_tid(wv), wid = wv, lane = tid & 63, r32 = lane & 31, hi = lane >> 5;
    const int NT = cur.P0 / KVBLK + QB / KVBLK;
    const int qlo = cur.P0 + wid * QBLK, qm = qlo + r32 - 4 * hi;
    char* V_lds = lds; char* K_lds = lds + K_LDS_OFF;
    float* ws = (float*)(lds + WS_LDS_OFF) + wid * 64; float* li_l = ws, * al_l = ws + 32;
    Seam S;
    unsigned kdo[4], kds[4], vdo[2];
#pragma unroll
    for (int i = 0; i < 4; ++i) { const int L = (wid + 8 * i) * 1024 + lane * 16, row = (L / KROW) & 63, pos = L % KROW, c = pos < 384 ? pos >> 4 : 0;
        const bool rope = c >= 16;
        kdo[i] = rope ? (unsigned)(WS_KR + ((size_t)(cur.tok0 + row) * LDKR + (c - 16) * 8) * 2) : (unsigned)(WS_KN + ((size_t)(cur.tok0 + row) * LDQ + cur.h * 128 + c * 8) * 2);
        kds[i] = rope ? (unsigned)(LDKR * 2) : (unsigned)(LDQ * 2); }
#pragma unroll
    for (int i = 0; i < 2; ++i) { const int L = (wid * 2 + i) * 1024 + lane * 16, st = L >> 9, in = L & 511, kk = (st >> 2) * 8 + (in >> 6), k = (kk & ~0xC) | ((kk & 4) << 1) | ((kk & 8) >> 1), col = (st & 3) * 32 + ((in & 63) >> 1);
        vdo[i] = (unsigned)(WS_V + ((size_t)(cur.tok0 + k) * LDQ + cur.h * 128 + col) * 2); }
    const int vb0 = (int)(uintptr_t)V_lds + v_rd_base(lane);
#if ATT_PF
    const unsigned ldsb_ = (unsigned)(uintptr_t)lds;
    unsigned pfo_, pfs_;
    { const int j_ = tid & 127, jr_ = tid & 63;
      if (tid < 256) { pfo_ = (unsigned)((tid < 128 ? WS_KN : WS_V) + ((size_t)(cur.tok0 + (j_ >> 1)) * LDQ + cur.h * 128 + (j_ & 1) * 64) * 2); pfs_ = 4096u; }
      else { pfo_ = (unsigned)(WS_KR + ((size_t)(cur.tok0 + jr_) * LDKR) * 2); pfs_ = (unsigned)(LDKR * 2); } }
#endif
    char* qrl = lds + QR_LDS_OFF + wid * 4096 + lane * 16;
    if (wid >= 4) __builtin_amdgcn_s_setprio(1);
    QLOAD(cur);
    DMA_TILE(0, 0, 0); PF_TILE(64);
    VMW3(); __syncthreads();
    float m_reg = -1e30f, l_reg = 0; f32x16 o[4] = {};
    f32x16 pA0, pA1, pB0, pB1; float mnA, mnB, alA, alB; bf16x8 pa0, pa1, pa2, pa3;
#define RESC(a) do { if (__any((a) < 1.f)) { if (hi == 0) al_l[r32] = (a); asm volatile("s_waitcnt lgkmcnt(0)" ::: "memory");              \
                     for (int d_ = 0; d_ < 4; ++d_) for (int r = 0; r < 16; ++r) o[d_][r] *= al_l[crow(r, hi)]; } } while (0)
#define KBASE(t) ((t) * KVBLK)
#define MASKT(P0_, P1_, t) do { const int kb_ = KBASE(t); if (kb_ + KVBLK - 1 > qlo) { asm volatile("" ::: "memory"); mask_tile(P0_, P1_, qm - kb_); } } while (0)
    int vs_prev = 0, vs_cur = 1, vs_next = 2;
    DMA_TILE(KBASE(1), 1, 1); PF_TILE(KBASE(2 < NT ? 2 : NT - 1));
    qkt<0>(pA0, pA1, K_lds, r32, hi, S.qr, qrl);
    MASKT(pA0, pA1, 0); partialSM(pA0, pA1, m_reg, mnA, alA);
    VMW3(); __syncthreads();
    const int tlast = (qlo + QBLK - 1) / KVBLK;
#define TACT(t) (!ATT_SKIP || (t) <= tlast)
#define HALF_STEP(PX0, PX1, mnX, alX, PY0, PY1, alY, t, KB) do {                                                             \
        if ((t) + 1 < NT) DMA_K(KBASE((t) + 1), (KB) ^ 1);                                                                       \
        if constexpr (SWAP) {           \
            if ((t) + 1 < NT) DMA_V(KBASE((t) + 1), vs_next);                                                                    \
            PF_TILE(KBASE((t) + 2 < NT ? (t) + 2 : NT - 1));                                                                     \
            if (TACT((t) - 1)) { finishSM(PY0, PY1, alY, l_reg, pa0, pa1, pa2, pa3);                                             \
                                 pv_tile(o, vb0 + vs_prev * SHM_V, pa0, pa1, pa2, pa3); }                                        \
            if (TACT(t)) qkt<KB>(PX0, PX1, K_lds, r32, hi, S.qr, qrl);                                                          \
        } else {                                                                                                                 \
            if (TACT(t)) qkt<KB>(PX0, PX1, K_lds, r32, hi, S.qr, qrl);                                                          \
            if ((t) + 1 < NT) DMA_V(KBASE((t) + 1), vs_next);        \
            PF_TILE(KBASE((t) + 2 < NT ? (t) + 2 : NT - 1));                                                                     \
            if (TACT((t) - 1)) { finishSM(PY0, PY1, alY, l_reg, pa0, pa1, pa2, pa3);                                             \
                                 pv_tile(o, vb0 + vs_prev * SHM_V, pa0, pa1, pa2, pa3); }                                        \
        }                                                                                                                        \
        if (TACT(t)) { MASKT(PX0, PX1, (t)); partialSM(PX0, PX1, m_reg, mnX, alX); RESC(alX); }                                  \
        { const int tmp_ = vs_prev; vs_prev = vs_cur; vs_cur = vs_next; vs_next = tmp_; }                                        \
        if ((t) + 1 < NT) VMW3(); else VMW1(); __syncthreads(); } while (0)
    for (int t = 1; t + 1 < NT; t += 2) {
        HALF_STEP(pB0, pB1, mnB, alB, pA0, pA1, alA, t, 1);
        HALF_STEP(pA0, pA1, mnA, alA, pB0, pB1, alB, t + 1, 0);
    }
    HALF_STEP(pB0, pB1, mnB, alB, pA0, pA1, alA, NT - 1, 1);
    if (TACT(NT - 1)) { finishSM(pB0, pB1, alB, l_reg, pa0, pa1, pa2, pa3);
                        pv_tile(o, vb0 + vs_prev * SHM_V, pa0, pa1, pa2, pa3); }
#undef HALF_STEP
#undef TACT
    if (hi == 0) li_l[r32] = l_reg; asm volatile("s_waitcnt lgkmcnt(0)" ::: "memory");
    float rli[16];
#pragma unroll
    for (int r = 0; r < 16; ++r) rli[r] = __builtin_amdgcn_rcpf(li_l[crow(r, hi)]);
    bf16_t* Ow = T_O(cur) + (size_t)(wid * QBLK) * LDQ;
    char* ost = lds + QR_LDS_OFF + wid * 4096;
#pragma unroll
    for (int pass = 0; pass < 2; ++pass) {
#pragma unroll
        for (int r8 = 0; r8 < 8; ++r8) { const int r = pass * 8 + r8, rl = crow(r, hi) - 16 * pass;
#pragma unroll
            for (int d0 = 0; d0 < 4; ++d0) { const float v = o[d0][r] * rli[r]; const float vn = dpp_xor1(v);
                if ((r32 & 1) == 0) *(unsigned*)(ost + rl * 256 + (d0 * 32 + r32) * 2) = cvtpk(v, vn); } }
        asm volatile("s_waitcnt lgkmcnt(0)" ::: "memory");
#pragma unroll
        for (int i = 0; i < 4; ++i) { const int c = lane + 64 * i; const u32x4 w = *(const u32x4*)(ost + c * 16);
            *(u32x4*)(Ow + (size_t)(16 * pass + (c >> 4)) * LDQ + (c & 15) * 8) = w; }
        asm volatile("s_waitcnt lgkmcnt(0)" ::: "memory");
    }
    __builtin_amdgcn_s_setprio(0);
    __syncthreads();
#undef RESC
#undef KBASE
#undef MASKT
}
__device__ __forceinline__ void block(const BlockRef& cur, char* lds, int wv) {
    if (ATT_SWAP == 1 && wv >= 4) block_t<true>(cur, lds, wv); else if (ATT_SWAP == 3 && wv < 4) block_t<true>(cur, lds, wv); else block_t<false>(cur, lds, wv);
}
#undef VMW
#undef QLOAD
#undef DMA_TILE

__device__ __forceinline__ void attn_phase(char* lds, unsigned char* wsb, int vcu, int G, int wv) {
    constexpr int total = 512;
    for (int L = vcu; L < total; L += G) {
        for (int pass = 0; pass < 2; ++pass) {
            const int bh = L >> 3, x = L & 7, b = bh >> 4, h = bh & 15, qb = pass ? 15 - x : x;
            BlockRef cur; cur.wsb = wsb; cur.tok0 = b * 4096; cur.row0 = b * 4096 + qb * QB; cur.h = h; cur.P0 = qb * QB;
            block(cur, lds, wv);
        }
    }
}
#undef T_QN
#undef T_QR
#undef T_KN
#undef T_KR
#undef T_V
#undef T_O
#undef SBAR
}
#ifndef PROBE_REP
#define PROBE_REP 0
#endif
#ifndef EPI_STAGGER
#define EPI_STAGGER 0
#endif
#ifndef IDLE_FILL
#define IDLE_FILL 1
#endif
#ifndef L2PF_FFN1
#define L2PF_FFN1 false
#endif
#ifndef L2PF_FFN2
#define L2PF_FFN2 false
#endif
#ifndef FFN1_SIM
#define FFN1_SIM false
#endif
#ifndef FFN1_SP2
#define FFN1_SP2 true
#endif
#ifndef EPI_ALIGN_RES
#define EPI_ALIGN_RES true
#endif
struct Args { const void* in[25]; float* out; unsigned char* ws; int ph_lo, ph_hi; };
struct Frame {
    LAS unsigned char* lds; volatile LAS unsigned* MISC; gu32* ctl; unsigned char* ws;
    int vcu, G, wv;
    const Args* a;
    float* xw;
    rs_t* rs;
    float* modp;
    float* modv; float* kvmod;
    float* dv; float2* tab;
};
__device__ const double kInvFreqTurns[32] = {
1.59154943091895346e-01, 1.19349370211248862e-01, 8.94994016088910133e-02, 6.71150830052272551e-02, 5.03292121044870353e-02, 3.77415847174197711e-02, 2.83021958306233987e-02, 2.12236527647776604e-02,
1.59154943091895339e-02, 1.19349370211248862e-02, 8.94994016088910237e-03, 6.71150830052272534e-03, 5.03292121044870370e-03, 3.77415847174197719e-03, 2.83021958306233987e-03, 2.12236527647776622e-03,
1.59154943091895356e-03, 1.19349370211248849e-03, 8.94994016088910237e-04, 6.71150830052272599e-04, 5.03292121044870326e-04, 3.77415847174197741e-04, 2.83021958306233954e-04, 2.12236527647776605e-04,
1.59154943091895351e-04, 1.19349370211248862e-04, 8.94994016088910182e-05, 6.71150830052272545e-05, 5.03292121044870354e-05, 3.77415847174197768e-05, 2.83021958306233961e-05, 2.12236527647776592e-05};

__device__ __forceinline__ void tr_item(const float* W, int ldw, int col0, int k0, bf16_t* dst, int ldd, int drow0, const float* kscale, LAS float* scr, int lane) {
#pragma unroll 8
    for (int i = 0; i < 32; ++i) { const int kk = 2 * i + (lane >> 5); const float* wp_ = W + (size_t)(k0 + kk) * ldw + col0 + (lane & 31); float v = NT_LOADS0 ? __builtin_nontemporal_load(wp_) : *wp_; if (kscale) v *= kscale[k0 + kk]; scr[kk * 33 + (lane & 31)] = v; }
    LDS_WAIT(); asm volatile("" ::: "memory");
    const int c = lane & 7;
#pragma unroll
    for (int j = 0; j < 4; ++j) { const int n = (lane >> 3) + 8 * j; const LAS float* s = scr + (8 * c) * 33 + n;
        u32x4 o; o.x = pk2(s[0 * 33], s[1 * 33]); o.y = pk2(s[2 * 33], s[3 * 33]); o.z = pk2(s[4 * 33], s[5 * 33]); o.w = pk2(s[6 * 33], s[7 * 33]);
        *(GAS u32x4*)(dst + (size_t)(drow0 + n) * ldd + k0 + 8 * c) = o; }
    LDS_WAIT(); asm volatile("" ::: "memory");
}
__device__ __forceinline__ void modgemv_item(const float* c, const float* W, int N, const float* bias, float* out  , int n0, int kc, LAS float* scr, int lane) {
    const int kb = kc * 256;
#pragma unroll
    for (int j = 0; j < 16; ++j) { const int e = lane + 64 * j; const int b = e >> 8, kk = e & 255; const float v = c[b * 2048 + kb + kk]; scr[e] = v / (1.f + __expf(-v)); }
    LDS_WAIT(); asm volatile("" ::: "memory");
    f32x4 a0 = {0, 0, 0, 0}, a1 = a0, a2 = a0, a3 = a0;
    const float* wp = W + (size_t)kb * N + n0 + 4 * lane;
#pragma unroll 8
    for (int kk = 0; kk < 256; ++kk) { const f32x4 w = NT_LOADS0 ? __builtin_nontemporal_load((const f32x4*)(wp + (size_t)kk * N)) : *(const f32x4*)(wp + (size_t)kk * N);
        a0 += w * scr[kk]; a1 += w * scr[256 + kk]; a2 += w * scr[512 + kk]; a3 += w * scr[768 + kk]; }
    if (kc == 0) { const f32x4 bb = *(const f32x4*)(bias + n0 + 4 * lane); a0 += bb; a1 += bb; a2 += bb; a3 += bb; }
    float* o = out + n0 + 4 * lane;
    *(f32x4*)o = a0; *(f32x4*)(o + N) = a1; *(f32x4*)(o + 2 * N) = a2; *(f32x4*)(o + 3 * N) = a3;
    LDS_WAIT(); asm volatile("" ::: "memory");
}
__device__ __forceinline__ void ph0_prologue(Frame& F) {
    const int tid = opaque_tid(F.wv), lane = tid & 63, wave = F.wv;
    LAS float* scr = (LAS float*)(F.lds + wave * 16384);
    const int gw = F.vcu * NWAVES + wave, NGW = F.G * NWAVES;
    unsigned char* ws = F.ws;
    constexpr int N_MG = 208 * 8, N_F1 = 32 * 352, N_F2 = 88 * 64, N_PL = 128, N_DKV = 512, N_KR = 64, N_DQ = 512, N_UK = 512, N_UQ = 768, N_WO = 2048, N_Z = 192, N_R = 8192;
    constexpr int NITEMS = N_MG + 4 * N_F1 + 4 * N_F2 + 8 * N_PL + N_DKV + N_KR + 2 * N_DQ + 2 * N_UK + 2 * N_UQ + 2 * N_WO + N_Z + N_R;
    for (int rep0 = 0; rep0 < (PROBE_REP == 7 ? 2 : 1); ++rep0)
    for (int it = gw; it < NITEMS; it += NGW) {
        int r = it;
        if (rep0 == 1 && (r < N_MG || r >= NITEMS - N_R)) continue;
        if (r < N_MG) { const int cb = r >> 3, kc = r & 7;
            if (cb < 192) { const int l = cb / 48, n0 = (cb % 48) * 256; modgemv_item(((const float*)F.a->in[1]), ((const float*)F.a->in[3]) + (size_t)l * 2048 * 12288, 12288, ((const float*)F.a->in[4]) + l * 12288, F.modp + (size_t)kc * MODN + (size_t)l * 4 * 12288, n0, kc, scr, lane); }
            else { const int n0 = (cb - 192) * 256; modgemv_item(((const float*)F.a->in[1]), ((const float*)F.a->in[9]), 4096, ((const float*)F.a->in[10]), F.modp + (size_t)kc * MODN + 4 * 4 * 12288, n0, kc, scr, lane); }
            continue; } r -= N_MG;
        if (r < 4 * N_F1) { const int l = r / N_F1, q = r % N_F1, kb = q / 352, nb = q % 352, tile = nb >> 3, qq = nb & 7;
            const float* src = ((qq >> 2) ? ((const float*)F.a->in[22]) : ((const float*)F.a->in[21])) + (size_t)l * 2048 * 5632;
            tr_item(src, 5632, tile * 128 + (qq & 3) * 32, kb * 64, (bf16_t*)(ws + WS_WFFN1 + l * SZ_WFFN1), 2048, nb * 32, nullptr, scr, lane); continue; } r -= 4 * N_F1;
        if (r < 4 * N_F2) { const int l = r / N_F2, q = r % N_F2, kb = q / 64, nb = q % 64;
            tr_item(((const float*)F.a->in[23]) + (size_t)l * 5632 * 2048, 2048, nb * 32, kb * 64, (bf16_t*)(ws + WS_WFFN2 + l * SZ_WFFN2), 5632, nb * 32, nullptr, scr, lane); continue; } r -= 4 * N_F2;
        if (r < 8 * N_PL) { const int lg = r / N_PL, q = r % N_PL, kb = q / 16, nb = q % 16, l = lg >> 2, g = lg & 3;
            tr_item(((const float*)F.a->in[7]) + (size_t)lg * 512 * 512, 512, nb * 32, kb * 64, (bf16_t*)(ws + WS_WPOOL + l * SZ_WPOOL), 512, g * 512 + nb * 32, nullptr, scr, lane); continue; } r -= 8 * N_PL;
        if (r < N_DKV) { const int kb = r / 16, nb = r % 16; tr_item(((const float*)F.a->in[12]), 512, nb * 32, kb * 64, (bf16_t*)(ws + WS_WD2), 2048, nb * 32, nullptr, scr, lane); continue; } r -= N_DKV;
        if (r < N_KR) { const int kb = r / 2, nb = r % 2; tr_item(((const float*)F.a->in[16]), 64, nb * 32, kb * 64, (bf16_t*)(ws + WS_WD2), 2048, 512 + nb * 128, nullptr, scr, lane); continue; } r -= N_KR;
        if (r < 2 * N_DQ) { const int j = r / N_DQ, q = r % N_DQ, kb = q / 16, nb = q % 16;
            tr_item(((const float*)F.a->in[17]) + (size_t)j * 2048 * 512, 512, nb * 32, kb * 64, (bf16_t*)(ws + (j ? WS_WD3 : WS_WD2)), 2048, (j ? 0 : 768) + nb * 32, nullptr, scr, lane); continue; } r -= 2 * N_DQ;
        if (r < 2 * N_UK) { const int j = r / N_UK, q = r % N_UK, kb = q / 64, nb = q % 64;
            tr_item(j ? ((const float*)F.a->in[15]) : ((const float*)F.a->in[14]), 2048, nb * 32, kb * 64, (bf16_t*)(ws + WS_WU2), 512, j * 2048 + nb * 32, ((const float*)F.a->in[13]), scr, lane); continue; } r -= 2 * N_UK;
        if (r < 2 * N_UQ) { const int j = r / N_UQ, q = r % N_UQ, kb = q / 96, db = q % 96; int col0, drow;
            if (db < 64) { col0 = (db >> 2) * 192 + (db & 3) * 32; drow = db * 32; }
            else { const int e = db - 64, tt = e >> 3, r8 = e & 7, bj = r8 >> 2, wcp = r8 & 3; col0 = (4 * tt + wcp) * 192 + 128 + bj * 32; drow = 2048 + e * 32; }
            tr_item(((const float*)F.a->in[19]) + (size_t)j * 512 * 3072, 3072, col0, kb * 64, (bf16_t*)(ws + (j ? WS_WU3 : WS_WU2)), 512, (j ? 0 : 4096) + drow, ((const float*)F.a->in[18]) + j * 512, scr, lane); continue; } r -= 2 * N_UQ;
        if (r < 2 * N_WO) { const int j = r / N_WO, q = r % N_WO, kb = q / 64, nb = q % 64;
            tr_item(((const float*)F.a->in[20]) + (size_t)j * 2048 * 2048, 2048, nb * 32, kb * 64, (bf16_t*)(ws + WS_WO + j * SZ_WO), 2048, nb * 32, nullptr, scr, lane); continue; } r -= 2 * N_WO;
        if (r < N_Z) { const int row = r < 96 ? 544 + r : 672 + (r - 96); GAS u32x4* p = (GAS u32x4*)((bf16_t*)(ws + WS_WD2) + (size_t)row * 2048);
#pragma unroll
            for (int j = 0; j < 4; ++j) p[lane + 64 * j] = (u32x4){0u, 0u, 0u, 0u};
            continue; } r -= N_Z;
        { const int row = r * 2 + (lane >> 5), i = lane & 31;
          const double t = (double)((const int*)F.a->in[2])[row] * kInvFreqTurns[i]; const double fr = t - __builtin_rint(t);
          const float a = (float)(fr * 6.283185307179586476925);
          F.tab[(size_t)row * 32 + i] = make_float2(cosf(a), sinf(a)); }
    }
}

typedef float f32x2 __attribute__((ext_vector_type(2)));
template <int W, bool XB>
__device__ __forceinline__ void pool_cols(const void* xcv, const unsigned char* xlv, const LAS float* rsl, const f32x2 gm, int tb, int start, bf16_t* dp) {
    f32x2 hp[16], hc[16];
    auto ldx = [&](int pos) -> f32x2 { if constexpr (XB) { const unsigned r = *(const unsigned*)((const bf16_t*)xcv + (size_t)pos * DM); unsigned lo = 0u; if (XBF16 == 2) lo = *(const unsigned short*)(xlv + (size_t)pos * DM); return (f32x2){__builtin_bit_cast(float, (r << 16) | ((lo << 8) & 0xff00u)), __builtin_bit_cast(float, (r & 0xffff0000u) | (lo & 0xff00u))}; } else return *(const f32x2*)((const float*)xcv + (size_t)pos * DM); };
#pragma unroll
    for (int i = 0; i < 16; ++i) hp[i] = (f32x2){0.f, 0.f};
    if (tb > 0) {
#pragma unroll
        for (int i = 0; i < 16; ++i) hp[i] = ldx(tb - 16 + i);
#pragma unroll
        for (int i = 0; i < 16; ++i) hp[i] = hp[i] * (gm * rsl[tb - 16 + i - start]);
    }
    f32x2 S = {0.f, 0.f};
#pragma unroll
    for (int i = 16 - W; i < 16; ++i) S += hp[i];
    for (int ch = 0; ch < 4; ++ch) {
        const int p0 = tb + ch * 16;
#pragma unroll
        for (int i = 0; i < 16; ++i) hc[i] = ldx(p0 + i);
#pragma unroll
        for (int i = 0; i < 16; ++i) hc[i] = hc[i] * (gm * rsl[p0 + i - start]);
#pragma unroll
        for (int i = 0; i < 16; ++i) {
            const int pos = p0 + i;
            S += hc[i]; S -= (i >= W) ? hc[i - W] : hp[16 + i - W];
            const float inv = 1.f / (float)(pos + 1 < W ? pos + 1 : W);
            const f32x2 d = S * inv - hc[i];
            *(GAS unsigned*)(dp + (size_t)pos * DM) = cvt_pk_bf16(d[0], d[1]);
        }
#pragma unroll
        for (int i = 0; i < 16; ++i) hp[i] = hc[i];
    }
}
template <bool XB>
__device__ __forceinline__ void pool_unit(Frame& F, const void* xsrc, const float* gnorm, const float* scale_m  , int unit, bf16_t* Dout) {
    LAS float* rsl = (LAS float*)F.lds;
    const int tid = opaque_tid(F.wv), lane = tid & 63, wave = F.wv;
    const int t0 = unit * 64, b = t0 >> 12, tb = t0 & 4095;
    const int start = tb >= 16 ? tb - 16 : 0, nrows = tb + 64 - start;
    const size_t xboff = (size_t)b * 4096 * DM;
    for (int ri = wave; ri < nrows; ri += 2 * NWAVES) {
        const int r2 = ri + NWAVES < nrows ? ri + NWAVES : ri;
        float sa = 0.f, sb = 0.f;
        if constexpr (XB) {
            const GAS u32x4* xa = (const GAS u32x4*)((const bf16_t*)xsrc + xboff + (size_t)(start + ri) * DM) + lane; const GAS u32x4* xq = (const GAS u32x4*)((const bf16_t*)xsrc + xboff + (size_t)(start + r2) * DM) + lane;
            const GAS u32x2* la = (const GAS u32x2*)(F.ws + WS_XL + xboff + (size_t)(start + ri) * DM) + lane; const GAS u32x2* lq = (const GAS u32x2*)(F.ws + WS_XL + xboff + (size_t)(start + r2) * DM) + lane;
            u32x4 va[4], vb[4]; u32x2 wa[4], wb[4];
#pragma unroll
            for (int j = 0; j < 4; ++j) { va[j] = xa[64 * j]; vb[j] = xq[64 * j]; if (XBF16 == 2) { wa[j] = la[64 * j]; wb[j] = lq[64 * j]; } }
#pragma unroll
            for (int j = 0; j < 4; ++j) { f32x4 a0, a1, b0, b1;
                if (XBF16 == 2) { x8_unpack24(va[j], wa[j], a0, a1); x8_unpack24(vb[j], wb[j], b0, b1); } else { x8_unpack16(va[j], a0, a1); x8_unpack16(vb[j], b0, b1); }
                sa += (a0[0] * a0[0] + a0[1] * a0[1]) + (a0[2] * a0[2] + a0[3] * a0[3]) + (a1[0] * a1[0] + a1[1] * a1[1]) + (a1[2] * a1[2] + a1[3] * a1[3]);
                sb += (b0[0] * b0[0] + b0[1] * b0[1]) + (b0[2] * b0[2] + b0[3] * b0[3]) + (b1[0] * b1[0] + b1[1] * b1[1]) + (b1[2] * b1[2] + b1[3] * b1[3]); }
        } else {
            const GAS f32x4* xa = (const GAS f32x4*)((const float*)xsrc + xboff + (size_t)(start + ri) * DM) + lane; const GAS f32x4* xq = (const GAS f32x4*)((const float*)xsrc + xboff + (size_t)(start + r2) * DM) + lane;
            f32x4 va[8], vb[8];
#pragma unroll
            for (int j = 0; j < 8; ++j) { va[j] = xa[64 * j]; vb[j] = xq[64 * j]; }
#pragma unroll
            for (int j = 0; j < 8; ++j) { sa += (va[j][0] * va[j][0] + va[j][1] * va[j][1]) + (va[j][2] * va[j][2] + va[j][3] * va[j][3]); sb += (vb[j][0] * vb[j][0] + vb[j][1] * vb[j][1]) + (vb[j][2] * vb[j][2] + vb[j][3] * vb[j][3]); }
        }
        sa = wave_sum(sa); sb = wave_sum(sb);
        if (lane == 0) { rsl[ri] = rsqrtf(sa * (1.f / DM) + EPS); rsl[r2] = rsqrtf(sb * (1.f / DM) + EPS); }
    }
    __syncthreads();
    for (int pass = 0; pass < 2; ++pass) {
        const int c = pass * 1024 + 2 * tid, g = pass * 2 + __builtin_amdgcn_readfirstlane(tid >> 8);
        f32x2 gm = *(const f32x2*)(gnorm + c); { const f32x2 sm = *(const f32x2*)(scale_m + (size_t)b * 12288 + c); gm = gm * (sm + 1.f); }
        const void* xc = XB ? (const void*)((const bf16_t*)xsrc + xboff + c) : (const void*)((const float*)xsrc + xboff + c); bf16_t* dp = Dout + (size_t)b * 4096 * DM + c; const unsigned char* xl = F.ws + WS_XL + xboff + c;
        if (g == 0) pool_cols<2, XB>(xc, xl, rsl, gm, tb, start, dp);
        else if (g == 1) pool_cols<4, XB>(xc, xl, rsl, gm, tb, start, dp);
        else if (g == 2) pool_cols<8, XB>(xc, xl, rsl, gm, tb, start, dp);
        else pool_cols<16, XB>(xc, xl, rsl, gm, tb, start, dp);
    }
    __syncthreads();
}
__device__ __forceinline__ void modv_convert_phase(Frame& F) {
    const int tid = opaque_tid(F.wv); const int gt = F.vcu * NWAVES * 64 + tid, NGT = F.G * NWAVES * 64;
    for (int i = gt; i < MODN; i += NGT) { float s = F.modp[i];
#pragma unroll
        for (int kc = 1; kc < 8; ++kc) s += F.modp[(size_t)kc * MODN + i];
        F.modv[i] = s; }
}
__device__ __forceinline__ void bias_rows(const bf16_t* W, int nrows, const float* shift, int sstride, float* out, int ostride, int w0, int nw, int lane) {
    if (w0 >= nrows) return;
    f32x4 sh[4][4][2];
#pragma unroll
    for (int bb = 0; bb < 4; ++bb)
#pragma unroll
        for (int j = 0; j < 4; ++j) { const float* sp = shift + (size_t)bb * sstride + (lane + 64 * j) * 8; sh[bb][j][0] = *(const f32x4*)sp; sh[bb][j][1] = *(const f32x4*)(sp + 4); }
    for (int n = w0; n < nrows; n += nw) {
        const bf16_t* wrow = W + (size_t)n * 2048;
        bf16x8 wv[4];
#pragma unroll
        for (int j = 0; j < 4; ++j) wv[j] = *(const bf16x8*)(wrow + (lane + 64 * j) * 8);
        float a[4] = {0.f, 0.f, 0.f, 0.f};
#pragma unroll
        for (int j = 0; j < 4; ++j)
#pragma unroll
            for (int e = 0; e < 8; ++e) { const float w = bf2f((unsigned short)wv[j][e]);
#pragma unroll
                for (int bb = 0; bb < 4; ++bb) a[bb] += sh[bb][j][e >> 2][e & 3] * w; }
#pragma unroll
        for (int bb = 0; bb < 4; ++bb) a[bb] = wave_sum(a[bb]);
        if (lane == 0) { out[n] = a[0]; out[ostride + n] = a[1]; out[2 * ostride + n] = a[2]; out[3 * ostride + n] = a[3]; }
    }
}
__device__ __forceinline__ void ph1_prologue(Frame& F) {
    for (int u = F.vcu; u < 256; u += F.G) pool_unit<false>(F, ((const float*)F.a->in[0]), ((const float*)F.a->in[5]), F.modv + 2048, u, (bf16_t*)(F.ws + WS_AKV));
    const int tid = opaque_tid(F.wv), lane = tid & 63, wave = F.wv;
    const int gt = F.vcu * NWAVES * 64 + tid, NGT = F.G * NWAVES * 64;
    for (int i = gt; i < 4 * 4 * 2048; i += NGT) { const int col = i & 2047, lb = i >> 11, l = lb >> 2;
        const float* mv = F.modv + (size_t)lb * 12288;
        F.dv[DV_GM + i] = ((const float*)F.a->in[5])[l * 2048 + col] * (1.f + mv[2048 + col]);
        F.dv[DV_GF + i] = ((const float*)F.a->in[6])[l * 2048 + col] * (1.f + mv[8192 + col]);
        F.dv[DV_GATEM + i] = mv[4096 + col] * (l < 2 ? ((const float*)F.a->in[8])[l * 2048 + col] : 1.f);
        F.dv[DV_GATEF + i] = mv[10240 + col];
        if (i < 4 * 2048) F.dv[DV_GKV + i] = ((const float*)F.a->in[11])[col] * (1.f + F.kvmod[(size_t)lb * 4096 + 2048 + col]); }
    const int gw = F.vcu * NWAVES + wave, NGW = F.G * NWAVES;
    for (int l = 0; l < (IDLE_FILL ? 2 : 4); ++l)
        bias_rows((const bf16_t*)(F.ws + WS_WFFN1 + l * SZ_WFFN1), 11264, F.modv + (size_t)l * 4 * 12288 + 6144, 12288, F.dv + DV_BFFN + (size_t)l * 4 * 11264, 11264, gw, NGW, lane);
    bias_rows((const bf16_t*)(F.ws + WS_WD2), 768, F.kvmod, 4096, F.dv + DV_BD2, 1280, gw, NGW, lane);
    bias_rows((const bf16_t*)(F.ws + WS_WD2) + (size_t)768 * 2048, 512, F.modv + (size_t)2 * 4 * 12288, 12288, F.dv + DV_BD2 + 768, 1280, gw, NGW, lane);
    bias_rows((const bf16_t*)(F.ws + WS_WD3), 512, F.modv + (size_t)3 * 4 * 12288, 12288, F.dv + DV_BD3, 512, gw, NGW, lane);
}
__device__ __forceinline__ void final_norm_phase(Frame& F) {
    const int tid = opaque_tid(F.wv), lane = tid & 63, wave = F.wv;
    const int gw = F.vcu * NWAVES + wave, NGW = F.G * NWAVES;
    f32x4 g[8];
#pragma unroll
    for (int j = 0; j < 8; ++j) g[j] = *((const GAS f32x4*)((const float*)F.a->in[24]) + lane + 64 * j);
    for (int m = gw; m < MROWS; m += NGW) {
        GAS f32x4* xr = (GAS f32x4*)(F.xw + (size_t)m * DM) + lane; f32x4 v[8]; float s = 0.f;
#if XBF16
        const GAS u32x2* xb = (const GAS u32x2*)((const bf16_t*)(F.ws + WS_XB) + (size_t)m * DM) + lane;
        const GAS unsigned* xlw = (const GAS unsigned*)(F.ws + WS_XL + (size_t)m * DM) + lane;
#pragma unroll
        for (int j = 0; j < 8; ++j) { const u32x2 r = xb[64 * j]; unsigned lo = 0u; if (XBF16 == 2) lo = xlw[64 * j];
            v[j] = (f32x4){__builtin_bit_cast(float, (r.x << 16) | ((lo << 8) & 0xff00u)), __builtin_bit_cast(float, (r.x & 0xffff0000u) | (lo & 0xff00u)),
                           __builtin_bit_cast(float, (r.y << 16) | ((lo >> 8) & 0xff00u)), __builtin_bit_cast(float, (r.y & 0xffff0000u) | ((lo >> 16) & 0xff00u))}; }
#else
#pragma unroll
        for (int j = 0; j < 8; ++j) v[j] = xr[64 * j];
#endif
#pragma unroll
        for (int j = 0; j < 8; ++j) s += (v[j][0] * v[j][0] + v[j][1] * v[j][1]) + (v[j][2] * v[j][2] + v[j][3] * v[j][3]);
        const float rstd = rsqrtf(wave_sum(s) * (1.f / DM) + EPS);
#pragma unroll
        for (int j = 0; j < 8; ++j) xr[64 * j] = v[j] * rstd * g[j];
    }
}

constexpr int NPHASES = 28;
__global__ void __launch_bounds__(NWAVES * 64, 2) fwd_kernel(Args args) {
    extern __shared__ __attribute__((aligned(16))) unsigned char lds_raw[];
    Frame F;
    F.lds = (LAS unsigned char*)lds_raw; F.MISC = (volatile LAS unsigned*)(F.lds + MISC_OFF);
    F.G = gridDim.x; { const int bx = blockIdx.x; F.vcu = (F.G % 8 == 0) ? (bx % 8) * (F.G / 8) + bx / 8 : bx; }
    unsigned char* const ws0_ = args.ws; float* const xw0_ = args.out;
    F.a = &args;
#define FRAME_PTRS(w_) do { F.ws = (w_); F.ctl = (gu32*)((w_) + WS_CTL); F.rs = (rs_t*)((float*)((w_) + WS_CTL) + CW_RS); F.modp = (float*)((w_) + WS_MODP); F.modv = (float*)((w_) + WS_CTL) + CW_MODV; F.kvmod = (float*)((w_) + WS_CTL) + CW_KVMOD; \
        F.dv = (float*)((w_) + WS_DV); F.tab = (float2*)((w_) + WS_TAB); } while (0)
    FRAME_PTRS(ws0_); F.xw = xw0_;
    if (threadIdx.x < 64) F.MISC[threadIdx.x] = 0u;
    __syncthreads();
    F.wv = __builtin_amdgcn_readfirstlane((int)threadIdx.x >> 6);
    XcdBarrier bar = xcd_barrier_post((unsigned*)(F.ctl + CW_BAR), F.MISC, threadIdx.x == 0);
#if MODE == 2
    constexpr int lo = 0, hi = NPHASES;
#else
    const int lo = args.ph_lo, hi = args.ph_hi;
#endif
    bool need_bar = false;
#define REPK(kind) for (int rep_ = 0; rep_ < ((PROBE_REP == (kind)) ? 2 : 1); ++rep_)
#define PH_BEGIN(p) if (lo <= (p) && (p) < hi) { if (need_bar) { XcdBarrier b_ = bar; asm volatile("" : "+s"(b_.bar), "+s"(b_.x)); { const bool t0_ = (F.wv == 0) && (opaque_lane() == 0); xcd_barrier(b_, t0_); if (PROBE_REP == 15) xcd_barrier(b_, t0_); } } need_bar = true; \
        unsigned char* ws = ws0_; float* xw_ = xw0_; asm volatile("" : "+s"(ws), "+s"(xw_)); FRAME_PTRS(ws); F.xw = xw_;
#define PH_END }
#define AQ ((bf16_t*)(ws + WS_AQ))
#define AKV ((bf16_t*)(ws + WS_AKV))
#define ACT ((bf16_t*)(ws + WS_ACT))
#define KN ((bf16_t*)(ws + WS_KN))
#define VV ((bf16_t*)(ws + WS_V))
#define KR ((bf16_t*)(ws + WS_KR))
#define CKV ((bf16_t*)(ws + WS_CKV))
#define CQ ((bf16_t*)(ws + WS_CQ))
#define QN ((bf16_t*)(ws + WS_QN))
#define QR ((bf16_t*)(ws + WS_QR))
#define OO ((bf16_t*)(ws + WS_O))

    #ifndef SK0
    PH_BEGIN(0) ph0_prologue(F); PH_END
#endif
    #ifndef SK1
    PH_BEGIN(27) modv_convert_phase(F); PH_END
    PH_BEGIN(1) REPK(8) ph1_prologue(F); PH_END
#endif
    for (int l = 0; l < 4; ++l) {
        const int base = 2 + 6 * l;
        if (l == 1) {
            PH_BEGIN(base) REPK(9) for (int u = F.vcu; u < 256; u += F.G) pool_unit<XBF16 != 0>(F, XBF16 ? (const void*)(ws + WS_XB) : (const void*)F.xw, ((const float*)F.a->in[5]) + 2048, F.modv + (size_t)4 * 12288 + 2048, u, AKV); PH_END
        }
        if (l >= 2) {
#ifndef SKD
            PH_BEGIN(base) {
                const bool first = (l == 2);
                pg8::Gemm g{first ? AKV : AQ, AQ, first ? 3 : 0, 2048, 0, (const bf16_t*)(ws + (first ? WS_WD2 : WS_WD3)), 2048, 2048, 64, first ? 5 : 2};
                pg8::StaticOrder S; S.init(g.nM, g.nN, F.G, (int)blockIdx.x);
                pg8::EpiDown E{F.rs + (first ? RS_M2 : RS_M3) * 16384, F.dv + (first ? DV_BD2 : DV_BD3), first ? 1280 : 512, first ? 3 : 0, ws, F.rs, first ? RS_Q2 : RS_Q3, F.tab};
                pg8::gemm_phase<pg8::EpiDown>(F.lds, g, S, E, F.wv);
                if (IDLE_FILL) {
                    const int c_ = (int)blockIdx.x, c0_ = (g.nM * g.nN) % F.G;
                    if (c0_ > 0 && c_ >= c0_) { const int lane_ = opaque_lane();
                        bias_rows((const bf16_t*)(ws + WS_WFFN1 + l * SZ_WFFN1), 11264, F.modv + (size_t)l * 4 * 12288 + 6144, 12288, F.dv + DV_BFFN + (size_t)l * 4 * 11264, 11264,
                                  (c_ - c0_) * NWAVES + F.wv, (F.G - c0_) * NWAVES, lane_); }
                }
            } PH_END
#endif
#ifndef SKU
            PH_BEGIN(base + 1) {
                const bool first = (l == 2);
                pg8::Gemm g{first ? CKV : CQ, CQ, first ? 16 : 0, 512, 0, (const bf16_t*)(ws + (first ? WS_WU2 : WS_WU3)), 512, 512, 64, first ? 28 : 12};
                pg8::StaticOrder S; S.init(g.nM, g.nN, F.G, (int)blockIdx.x);
                pg8::EpiUp E{ws, F.rs, first ? RS_Q2 : RS_Q3, first ? 16 : 0, F.tab};
                REPK(5) pg8::gemm_phase<pg8::EpiUp>(F.lds, g, S, E, F.wv);
            } PH_END
#endif
#ifndef SKA
            PH_BEGIN(base + 2) {
                REPK(3) att::attn_phase((char*)lds_raw, ws, F.vcu, F.G, F.wv);
            } PH_END
#endif
        }
#ifndef SKM
        PH_BEGIN(base + 3) {
            const bool pool = l < 2;
            pg8::Gemm g{pool ? AKV : OO, pool ? AKV : OO, 0, 2048, pool ? 1 : 0, (const bf16_t*)(ws + (pool ? WS_WPOOL + l * SZ_WPOOL : WS_WO + (l - 2) * SZ_WO)), pool ? 512 : 2048, pool ? 512 : 2048, 64, 8};
            pg8::StaticOrder S; S.init(g.nM, g.nN, F.G, (int)blockIdx.x, 4);
            pg8::EpiRes E{l == 0 ? ((const float*)F.a->in[0]) : (XBF16 ? nullptr : F.xw), (const bf16_t*)(ws + WS_XB), XBF16 ? nullptr : F.xw, (bf16_t*)(ws + WS_XB), ws + WS_XL, F.dv + DV_GATEM + l * 4 * 2048, F.dv + DV_GF + l * 4 * 2048, AQ, nullptr, nullptr, F.rs + (RS_F0 + l) * 16384, (unsigned)(size_t)(F.lds + 131072)};
            if (PROBE_REP == 4) { pg8::EpiRes E2 = E; E2.xout32 = (float*)(ws + WS_FAST_END); E2.rowss = nullptr; E2.a0 = (bf16_t*)(ws + WS_FAST_END + (size_t)MROWS * DM * 4); pg8::gemm_phase<pg8::EpiRes, EPI_ALIGN_RES>(F.lds, g, S, E2, F.wv); }
            if (EPI_STAGGER && ([&]{ pg8::Unit u0_; return S.next(0, u0_) && (u0_.pm & 1); })()) { for (int i_ = 0; i_ < EPI_STAGGER; ++i_) __builtin_amdgcn_s_sleep(127); }
            pg8::gemm_phase<pg8::EpiRes, EPI_ALIGN_RES>(F.lds, g, S, E, F.wv);
        } PH_END
#endif
#ifndef SKF1
        PH_BEGIN(base + 4) {
            pg8::Gemm g{AQ, AQ, 0, 2048, 0, (const bf16_t*)(ws + WS_WFFN1 + l * SZ_WFFN1), 2048, 2048, 64, 44};
            pg8::StaticOrder S; S.init(g.nM, g.nN, F.G, (int)blockIdx.x);
            pg8::EpiSwi E{F.rs + (RS_F0 + l) * 16384, F.dv + DV_BFFN + (size_t)l * 4 * 11264, ACT};
            REPK(1) pg8::gemm_phase<pg8::EpiSwi, true, FFN1_SP2, FFN1_SIM, L2PF_FFN1>(F.lds, g, S, E, F.wv);
        } PH_END
#endif
#ifndef SKF2
        PH_BEGIN(base + 5) {
            pg8::Gemm g{ACT, ACT, 0, 5632, 0, (const bf16_t*)(ws + WS_WFFN2 + l * SZ_WFFN2), 5632, 5632, 64, 8};
            pg8::StaticOrder S; S.init(g.nM, g.nN, F.G, (int)blockIdx.x, 4);
            const bool hasA = (l == 1 || l == 2);
            pg8::EpiRes E{XBF16 ? nullptr : F.xw, (const bf16_t*)(ws + WS_XB), XBF16 ? nullptr : F.xw, (bf16_t*)(ws + WS_XB), ws + WS_XL, F.dv + DV_GATEF + l * 4 * 2048, hasA ? F.dv + DV_GM + (l + 1) * 4 * 2048 : nullptr, hasA ? AQ : nullptr,
                          l == 1 ? F.dv + DV_GKV : nullptr, l == 1 ? AKV : nullptr, hasA ? F.rs + (l == 1 ? RS_M2 : RS_M3) * 16384 : nullptr, (unsigned)(size_t)(F.lds + 131072)};
            if (PROBE_REP == 10) { pg8::EpiNull E0{(float*)(ws + WS_FAST_END)}; pg8::gemm_phase<pg8::EpiNull, true>(F.lds, g, S, E0, F.wv); }
            if (PROBE_REP == 14) { pg8::EpiNull E0{(float*)(ws + WS_FAST_END)}; pg8::Gemm g2 = g; g2.grouped = 2; pg8::gemm_phase<pg8::EpiNull, true>(F.lds, g2, S, E0, F.wv); }
            if (PROBE_REP == 2) { pg8::EpiRes E2 = E; E2.xout32 = (float*)(ws + WS_FAST_END); E2.rowss = nullptr; pg8::gemm_phase<pg8::EpiRes, EPI_ALIGN_RES>(F.lds, g, S, E2, F.wv); }
            if (EPI_STAGGER && ([&]{ pg8::Unit u0_; return S.next(0, u0_) && (u0_.pm & 1); })()) { for (int i_ = 0; i_ < EPI_STAGGER; ++i_) __builtin_amdgcn_s_sleep(127); }
            pg8::gemm_phase<pg8::EpiRes, EPI_ALIGN_RES, true, false, L2PF_FFN2>(F.lds, g, S, E, F.wv);
        } PH_END
#endif
    }
    PH_BEGIN(26) REPK(12) final_norm_phase(F); PH_END
#undef PH_BEGIN
#undef PH_END
#undef FRAME_PTRS
#undef AQ
#undef AKV
#undef ACT
#undef KN
#undef VV
#undef KR
#undef CKV
#undef CQ
#undef QN
#undef QR
#undef OO
}
#if MODE >= 2
extern "C" void kernel_launch(void* const* d_in, const int* in_sizes, int n_in, void* d_out, int out_size, void* d_ws, size_t ws_size, hipStream_t stream) {
    static int grid = 0;
    if (grid == 0) {
        if (n_in != 25 || out_size != MROWS * DM || ws_size < WS_NEED) { fprintf(stderr, "kernel_launch: unexpected shapes / workspace (%d inputs, out %d, ws %zu < %zu)\n", n_in, out_size, ws_size, (size_t)WS_FAST_END); grid = -1; return; }
        int dev = 0, cus = 0, per_cu = 0;
        if (hipGetDevice(&dev) != hipSuccess || hipDeviceGetAttribute(&cus, hipDeviceAttributeMultiprocessorCount, dev) != hipSuccess) { grid = -1; return; }
        if (hipFuncSetAttribute((const void*)fwd_kernel, hipFuncAttributeMaxDynamicSharedMemorySize, LDS_BYTES) != hipSuccess) { fprintf(stderr, "kernel_launch: hipFuncSetAttribute failed\n"); grid = -1; return; }
        if (hipOccupancyMaxActiveBlocksPerMultiprocessor(&per_cu, (const void*)fwd_kernel, NWAVES * 64, LDS_BYTES) != hipSuccess || per_cu < 1) { fprintf(stderr, "kernel_launch: occupancy query says %d\n", per_cu); }
        (void)hipGetLastError();
        grid = cus;
    }
    if (grid < 0) return;
    (void)hipMemsetAsync((char*)d_ws + WS_CTL, 0, CTL_ZERO_BYTES, stream);
    Args a{};
    for (int i = 0; i < 25; ++i) a.in[i] = d_in[i];
    a.out = (float*)d_out; a.ws = (unsigned char*)d_ws;
#if MODE == 2
    a.ph_lo = 0; a.ph_hi = NPHASES;
    hipLaunchKernelGGL(fwd_kernel, dim3(grid), dim3(NWAVES * 64), LDS_BYTES, stream, a);
#else
    for (int p = 0; p < NPHASES; ++p) {
        const int k = p < 2 ? -1 : (p - 2) % 6, l = p < 2 ? -1 : (p - 2) / 6;
        if (p >= 2 && p < 26) { if (k == 0 && l == 0) continue; if ((k == 1 || k == 2) && l < 2) continue; }
        a.ph_lo = p; a.ph_hi = p + 1;
        hipLaunchKernelGGL(fwd_kernel, dim3(grid), dim3(NWAVES * 64), LDS_BYTES, stream, a);
    }
#endif
}
#endif
```
